# Optimizing an MI355X kernel written in HIP

```python
import jax
import jax.numpy as jnp
from jax import lax

D_MODEL = 2048
BATCH = 8
SEQ = 4096
DEPTH = 4

GRID_W = 64
CTX_LEN = 256
F32 = jnp.float32

FOURIER_W = D_MODEL // 4
FOURIER_GROUPS = 4
FOURIER_GW = FOURIER_W // FOURIER_GROUPS

RWKV_W = D_MODEL // 4
RWKV_HEAD = 64
RWKV_HEADS = RWKV_W // RWKV_HEAD
DECAY_RANK = 64
ICLR_RANK = 64
GATE_RANK = 128
LNX_EPS = 64e-5
NORM_EPS = 1e-12

ATTN_W = D_MODEL // 2
ATTN_HEAD_DIM = 128
ATTN_Q_HEADS = ATTN_W // ATTN_HEAD_DIM
ATTN_KV_HEADS = 2
ATTN_GROUP = ATTN_Q_HEADS // ATTN_KV_HEADS
KV_W = ATTN_KV_HEADS * ATTN_HEAD_DIM
WINDOW = 128
ATTN_BLOCK = 128
ATTN_SCALE = ATTN_HEAD_DIM ** -0.5
ROPE_THETA = 10000.0
ROPE_PAIRS = ATTN_HEAD_DIM // 4
NEG_INF = -1e30

D_FF = 11 * D_MODEL // 4
RMS_EPS = 1e-6

OFF_F = 0
OFF_Q = OFF_F + FOURIER_W
OFF_R = OFF_Q + ATTN_W
OFF_G = OFF_R + RWKV_W
OFF_K = OFF_G + GATE_RANK
OFF_V = OFF_K + RWKV_W
OFF_WD = OFF_V + RWKV_W
OFF_AD = OFF_WD + 2 * DECAY_RANK
OFF_AK = OFF_AD + 2 * ICLR_RANK
OFF_AV = OFF_AK + KV_W
IN_W = OFF_AV + KV_W
RWKV_SHIFT_W = OFF_AK - OFF_R

kernel_name = 'hymba_fnet_rwkv7_swa_flow_block'


def rms_norm(x, g):
    xf = x.astype(F32)
    y = xf * lax.rsqrt(jnp.mean(xf * xf, axis=-1, keepdims=True) + RMS_EPS)
    return (y * g.astype(F32)).astype(x.dtype)


def modulate(h, shift, scale):
    return h * (1.0 + scale) + shift


def neighbours(t):
    zero = jnp.zeros_like(t[:, :1])
    return (jnp.concatenate([zero, t[:, :-1]], axis=1), jnp.concatenate([t[:, 1:], zero], axis=1))


def shift_mix(t, mu):
    prev, nxt = neighbours(t)
    return t + mu[0] * (prev - t) + mu[1] * (nxt - t)


def dwconv3(t, w, b):
    prev, nxt = neighbours(t)
    return prev * w[0] + t * w[1] + nxt * w[2] + b


def axial_rope_tables(n_tokens):
    rows = n_tokens // GRID_W
    row = jnp.repeat(jnp.arange(rows, dtype=F32), GRID_W)
    col = jnp.tile(jnp.arange(GRID_W, dtype=F32), rows)
    inv_freq = ROPE_THETA ** (-jnp.arange(ROPE_PAIRS, dtype=F32) / ROPE_PAIRS)
    ang = jnp.stack([row[:, None] * inv_freq, col[:, None] * inv_freq], axis=1)
    return jnp.cos(ang), jnp.sin(ang)


def apply_axial_rope(t, cos, sin):
    tf = t.astype(F32).reshape(t.shape[:-1] + (2, 2, ROPE_PAIRS))
    a, b = tf[..., 0, :], tf[..., 1, :]
    cs, sn = cos[None, :, None], sin[None, :, None]
    out = jnp.stack([a * cs - b * sn, a * sn + b * cs], axis=-2)
    return out.reshape(t.shape).astype(t.dtype)


def fourier_mix(t):
    B, L, _ = t.shape
    z = t.astype(F32).reshape(B, L, FOURIER_GROUPS, FOURIER_GW).transpose(0, 2, 1, 3)
    y = jnp.fft.fft2(z, norm='ortho').real
    return y.transpose(0, 2, 1, 3).reshape(B, L, FOURIER_W)


def rwkv_heads(t):
    return t.astype(F32).reshape(t.shape[:2] + (RWKV_HEADS, RWKV_HEAD))


def rwkv_state_inputs(k, v, wd, ad, w0, w2, a0, a2, kk_scale, ka):
    B, L = k.shape[:2]
    hshape = (B, L, 2, RWKV_HEADS, RWKV_HEAD)
    k = rwkv_heads(k)
    v = rwkv_heads(v)
    wd = jnp.tanh(wd.astype(F32).reshape(B, L, 2, DECAY_RANK))
    log_w = -jax.nn.softplus(-(w0.astype(F32) + jnp.einsum('bldr,drc->bldc', wd, w2.astype(F32)))) - 0.5
    decay = jnp.exp(-jnp.exp(log_w)).reshape(hshape)
    ad = ad.astype(F32).reshape(B, L, 2, ICLR_RANK)
    a = jax.nn.sigmoid(a0.astype(F32) + jnp.einsum('bldr,drc->bldc', ad, a2.astype(F32))).reshape(hshape)
    kk = k * kk_scale.astype(F32).reshape(RWKV_HEADS, RWKV_HEAD)
    kk = kk / jnp.maximum(jnp.sqrt(jnp.sum(kk * kk, axis=-1, keepdims=True)), NORM_EPS)
    k_dir = k[:, :, None] * (1.0 + (a - 1.0) * ka.astype(F32).reshape(RWKV_HEADS, RWKV_HEAD))
    return decay, k_dir, v, kk, kk[:, :, None] * a


def to_scan(t):
    t = jnp.stack([t[:, :, 0], jnp.flip(t[:, :, 1], axis=1)], axis=0)
    return jnp.moveaxis(t, 2, 0)


def from_scan(ys):
    ys = jnp.moveaxis(ys, 0, 2)
    return ys[0] + jnp.flip(ys[1], axis=1)


def wkv7_scan(s0, decay, k_dir, v, kk, b, r):
    B, L = v.shape[:2]
    full = (B, L, 2, RWKV_HEADS, RWKV_HEAD)
    xs = (to_scan(decay), to_scan(k_dir), to_scan(jnp.broadcast_to(v[:, :, None], full)),
          to_scan(jnp.broadcast_to(kk[:, :, None], full)), to_scan(b))
    if r is not None:
        xs = xs + (to_scan(jnp.broadcast_to(r[:, :, None], full)),)

    def step(s, inp):
        w_t, k_t, v_t, kk_t, b_t = inp[:5]
        sa = jnp.einsum('dbhij,dbhj->dbhi', s, kk_t)
        s = s * w_t[..., None, :] - sa[..., :, None] * b_t[..., None, :] + v_t[..., :, None] * k_t[..., None, :]
        if r is None:
            return s, None
        return s, jnp.einsum('dbhij,dbhj->dbhi', s, inp[5])

    return lax.scan(step, s0, xs)


def rwkv_output(y, r, k_dir, v, gd, g2, rk, lnx_w, lnx_b):
    B, L = y.shape[:2]
    mean = jnp.mean(y, axis=-1, keepdims=True)
    var = jnp.mean(jnp.square(y - mean), axis=-1, keepdims=True)
    yn = ((y - mean) * lax.rsqrt(var + LNX_EPS)).reshape(B, L, RWKV_W) * lnx_w.astype(F32) + lnx_b.astype(F32)
    bonus = jnp.sum(r[:, :, None] * k_dir * rk.astype(F32), axis=(2, 4))[..., None] * v
    g = jax.nn.sigmoid(gd.astype(F32)) @ g2.astype(F32)
    return (yn + bonus.reshape(B, L, RWKV_W)) * g


def window_attention(q, k, v, k_ctx, v_ctx, sink):
    B, L = q.shape[:2]
    C = k_ctx.shape[1]
    nb = L // ATTN_BLOCK
    nk = 3 * ATTN_BLOCK
    qb = q.reshape(B, nb, ATTN_BLOCK, ATTN_KV_HEADS, ATTN_GROUP, ATTN_HEAD_DIM)

    def band(t):
        tp = jnp.pad(t, ((0, 0), (ATTN_BLOCK, ATTN_BLOCK), (0, 0), (0, 0)))
        tp = tp.reshape(B, nb + 2, ATTN_BLOCK, ATTN_KV_HEADS, ATTN_HEAD_DIM)
        return jnp.concatenate([tp[:, :-2], tp[:, 1:-1], tp[:, 2:]], axis=2)

    kb, vb = band(k), band(v)
    s_loc = jnp.einsum('bnqhgd,bnkhd->bnhgqk', qb, kb).astype(F32) * ATTN_SCALE
    blk = jnp.arange(nb)[:, None, None] * ATTN_BLOCK
    qpos = blk + jnp.arange(ATTN_BLOCK)[None, :, None]
    kpos = blk - ATTN_BLOCK + jnp.arange(nk)[None, None, :]
    valid = (jnp.abs(kpos - qpos) <= WINDOW) & (kpos >= 0) & (kpos < L)
    s_loc = jnp.where(valid[None, :, None, None], s_loc, NEG_INF)
    s_ctx = jnp.einsum('bnqhgd,bchd->bnhgqc', qb, k_ctx).astype(F32) * ATTN_SCALE
    s_sink = jnp.broadcast_to(sink.astype(F32).reshape(ATTN_KV_HEADS, ATTN_GROUP, 1, 1), s_loc.shape[:-1] + (1,))
    p = jax.nn.softmax(jnp.concatenate([s_loc, s_ctx, s_sink], axis=-1), axis=-1).astype(v.dtype)
    o = (jnp.einsum('bnhgqk,bnkhd->bnqhgd', p[..., :nk], vb)
         + jnp.einsum('bnhgqc,bchd->bnqhgd', p[..., nk:nk + C], v_ctx))
    return o.reshape(B, L, ATTN_W)


def context_attention(q_ctx, k_ctx, v_ctx, sink):
    B, C = q_ctx.shape[:2]
    qg = q_ctx.reshape(B, C, ATTN_KV_HEADS, ATTN_GROUP, ATTN_HEAD_DIM)
    s = jnp.einsum('bqhgd,bkhd->bhgqk', qg, k_ctx).astype(F32) * ATTN_SCALE
    s_sink = jnp.broadcast_to(sink.astype(F32).reshape(ATTN_KV_HEADS, ATTN_GROUP, 1, 1), s.shape[:-1] + (1,))
    p = jax.nn.softmax(jnp.concatenate([s, s_sink], axis=-1), axis=-1).astype(v_ctx.dtype)
    o = jnp.einsum('bhgqk,bkhd->bqhgd', p[..., :C], v_ctx)
    return o.reshape(B, C, ATTN_W)


def token_mixer(u, uc, w_in, w_out, mu, w0, w2, a0, a2, g2, kk_scale, ka, rk, lnx_w, lnx_b,
                sink, f_g, a_g, cos, sin, ctx_out):
    B, L, _ = u.shape
    C = uc.shape[1]
    dt = u.dtype
    p = u @ w_in
    ps = shift_mix(p[..., OFF_R:OFF_AK], mu)
    base = 0 if ctx_out else OFF_K
    pc = uc @ w_in[:, base:]
    sbase = max(base, OFF_R)
    psc = shift_mix(pc[..., sbase - base:OFF_AK - base], mu[:, sbase - OFF_R:])

    def cols(t, origin, lo, hi):
        return t[..., lo - origin:hi - origin]

    lat = rwkv_state_inputs(cols(ps, OFF_R, OFF_K, OFF_V), cols(ps, OFF_R, OFF_V, OFF_WD),
                            cols(ps, OFF_R, OFF_WD, OFF_AD), cols(ps, OFF_R, OFF_AD, OFF_AK),
                            w0, w2, a0, a2, kk_scale, ka)
    cst = rwkv_state_inputs(cols(psc, sbase, OFF_K, OFF_V), cols(psc, sbase, OFF_V, OFF_WD),
                            cols(psc, sbase, OFF_WD, OFF_AD), cols(psc, sbase, OFF_AD, OFF_AK),
                            w0, w2, a0, a2, kk_scale, ka)
    r = rwkv_heads(cols(ps, OFF_R, OFF_R, OFF_G))
    r_c = rwkv_heads(cols(psc, sbase, OFF_R, OFF_G)) if ctx_out else None
    s_init = jnp.zeros((2, B, RWKV_HEADS, RWKV_HEAD, RWKV_HEAD), F32)
    s_ctx, ys_c = wkv7_scan(s_init, cst[0], cst[1], cst[2], cst[3], cst[4], r_c)
    _, ys = wkv7_scan(s_ctx, lat[0], lat[1], lat[2], lat[3], lat[4], r)
    rw = rwkv_output(from_scan(ys), r, lat[1], lat[2], cols(ps, OFF_R, OFF_G, OFF_K), g2, rk, lnx_w, lnx_b)

    q = apply_axial_rope(cols(p, 0, OFF_Q, OFF_R).reshape(B, L, ATTN_Q_HEADS, ATTN_HEAD_DIM), cos, sin)
    k = apply_axial_rope(cols(p, 0, OFF_AK, OFF_AV).reshape(B, L, ATTN_KV_HEADS, ATTN_HEAD_DIM), cos, sin)
    v = cols(p, 0, OFF_AV, IN_W).reshape(B, L, ATTN_KV_HEADS, ATTN_HEAD_DIM)
    k_c = cols(pc, base, OFF_AK, OFF_AV).reshape(B, C, ATTN_KV_HEADS, ATTN_HEAD_DIM)
    v_c = cols(pc, base, OFF_AV, IN_W).reshape(B, C, ATTN_KV_HEADS, ATTN_HEAD_DIM)
    at = window_attention(q, k, v, k_c, v_c, sink)

    fo = fourier_mix(cols(p, 0, OFF_F, OFF_Q))

    y = jnp.concatenate([rms_norm(fo, f_g).astype(dt), rw.astype(dt), rms_norm(at, a_g).astype(dt)], axis=-1) @ w_out
    if not ctx_out:
        return y, None

    fo_c = fourier_mix(cols(pc, 0, OFF_F, OFF_Q))
    rw_c = rwkv_output(from_scan(ys_c), r_c, cst[1], cst[2], cols(psc, sbase, OFF_G, OFF_K), g2, rk, lnx_w, lnx_b)
    at_c = context_attention(cols(pc, 0, OFF_Q, OFF_R).reshape(B, C, ATTN_Q_HEADS, ATTN_HEAD_DIM), k_c, v_c, sink)
    y_c = jnp.concatenate([rms_norm(fo_c, f_g).astype(dt), rw_c.astype(dt), rms_norm(at_c, a_g).astype(dt)], axis=-1) @ w_out
    return y, y_c


def conv_ffn(u, w_in, conv_w, conv_b, w_out):
    h = u @ w_in
    gate = dwconv3(h[..., :D_FF], conv_w, conv_b)
    return (jax.nn.gelu(gate, approximate=False) * h[..., D_FF:]) @ w_out


def setup_inputs(seed: int = 0) -> dict:
    key = jax.random.key(seed)
    ks = iter(jax.random.split(key, 32))

    def nrm(shape, scale):
        return jax.random.normal(next(ks), shape, F32) * scale

    def unif(shape, lo, hi):
        return jax.random.uniform(next(ks), shape, F32, lo, hi)

    D = D_MODEL
    return {
        'x': nrm((BATCH, SEQ, D), 1.0),
        'c': nrm((BATCH, D), 1.0),
        'ctx': nrm((BATCH, CTX_LEN, D), 1.0),
        'c_ctx': nrm((D,), 1.0),
        'norm1_g': 1.0 + nrm((DEPTH, D), 0.02),
        'norm2_g': 1.0 + nrm((DEPTH, D), 0.02),
        'w_ada': nrm((DEPTH, D, 6 * D), 0.5 * D ** -0.5),
        'b_ada': nrm((DEPTH, 6 * D), 0.01),
        'w_in': nrm((DEPTH, D, IN_W), D ** -0.5),
        'rwkv_mu': unif((DEPTH, 2, RWKV_SHIFT_W), 0.0, 0.5),
        'rwkv_w0': unif((DEPTH, 2, RWKV_W), -6.0, -1.0),
        'rwkv_w2': nrm((DEPTH, 2, DECAY_RANK, RWKV_W), 0.5 * DECAY_RANK ** -0.5),
        'rwkv_a0': nrm((DEPTH, 2, RWKV_W), 0.1),
        'rwkv_a2': nrm((DEPTH, 2, ICLR_RANK, RWKV_W), ICLR_RANK ** -0.5),
        'rwkv_g2': nrm((DEPTH, GATE_RANK, RWKV_W), GATE_RANK ** -0.5),
        'rwkv_kk_scale': 0.85 + nrm((DEPTH, RWKV_W), 0.02),
        'rwkv_ka': 1.0 + nrm((DEPTH, RWKV_W), 0.02),
        'rwkv_rk': nrm((DEPTH, RWKV_HEADS, RWKV_HEAD), 0.1),
        'rwkv_lnx_w': 1.0 + nrm((DEPTH, RWKV_W), 0.02),
        'rwkv_lnx_b': nrm((DEPTH, RWKV_W), 0.01),
        'attn_sink': nrm((DEPTH, ATTN_Q_HEADS), 0.5),
        'fourier_out_g': 1.0 + nrm((DEPTH, FOURIER_W), 0.02),
        'attn_out_g': 1.0 + nrm((DEPTH, ATTN_W), 0.02),
        'w_out': nrm((DEPTH, D, D), D ** -0.5),
        'w_ffn_in': nrm((DEPTH, D, 2 * D_FF), D ** -0.5),
        'ffn_conv_w': nrm((DEPTH, 3, D_FF), 3 ** -0.5),
        'ffn_conv_b': nrm((DEPTH, D_FF), 0.01),
        'w_ffn_out': nrm((DEPTH, D_FF, D), D_FF ** -0.5),
        'final_g': 1.0 + nrm((D,), 0.02),
    }


def reference(x, c, ctx, c_ctx, norm1_g, norm2_g, w_ada, b_ada, w_in, rwkv_mu, rwkv_w0, rwkv_w2,
              rwkv_a0, rwkv_a2, rwkv_g2, rwkv_kk_scale, rwkv_ka, rwkv_rk, rwkv_lnx_w, rwkv_lnx_b,
              attn_sink, fourier_out_g, attn_out_g, w_out, w_ffn_in, ffn_conv_w, ffn_conv_b, w_ffn_out, final_g):
    L = x.shape[1]
    D = D_MODEL
    cos, sin = axial_rope_tables(L)
    silu_c = jax.nn.silu(c)
    silu_cc = jax.nn.silu(c_ctx)
    h_ctx = ctx
    for l in range(DEPTH):
        last = l == DEPTH - 1
        mod = (silu_c @ w_ada[l] + b_ada[l])[:, None, :]
        sh1, sc1, ga1, sh2, sc2, ga2 = jnp.split(mod, 6, axis=-1)
        n_ctx_mod = 2 if last else 6
        mc = jnp.split(silu_cc @ w_ada[l][:, :n_ctx_mod * D] + b_ada[l][:n_ctx_mod * D], n_ctx_mod, axis=-1)

        u = modulate(rms_norm(x, norm1_g[l]), sh1, sc1)
        uc = modulate(rms_norm(h_ctx, norm1_g[l]), mc[0], mc[1])
        y, y_c = token_mixer(u, uc, w_in[l], w_out[l], rwkv_mu[l], rwkv_w0[l], rwkv_w2[l], rwkv_a0[l],
                             rwkv_a2[l], rwkv_g2[l], rwkv_kk_scale[l], rwkv_ka[l], rwkv_rk[l],
                             rwkv_lnx_w[l], rwkv_lnx_b[l], attn_sink[l], fourier_out_g[l], attn_out_g[l],
                             cos, sin, not last)
        x = x + ga1 * y
        x = x + ga2 * conv_ffn(modulate(rms_norm(x, norm2_g[l]), sh2, sc2),
                               w_ffn_in[l], ffn_conv_w[l], ffn_conv_b[l], w_ffn_out[l])
        if not last:
            h_ctx = h_ctx + mc[2] * y_c
            h_ctx = h_ctx + mc[5] * conv_ffn(modulate(rms_norm(h_ctx, norm2_g[l]), mc[3], mc[4]),
                                             w_ffn_in[l], ffn_conv_w[l], ffn_conv_b[l], w_ffn_out[l])
    return rms_norm(x, final_g)
```

```cpp
#include <hip/hip_runtime.h>
#include <stdint.h>
#include <stdio.h>
#define XB_TMO      128
#define XB_XCNT(j)  (256  + 64 * (j))
#define XB_XSUB(j)  (1280 + 64 * (j))
#define XB_XGEN(j)  (2304 + 64 * (j))
#define XB_TOP      3328
#define XB_TOPGEN   3392
#define XCD_BAR_WORDS 3456
#define XB_SPIN_CAP (1u << 18)
#define LAS __attribute__((address_space(3)))

__device__ __forceinline__ unsigned xb_ld(unsigned* p)              { return __hip_atomic_load(p, __ATOMIC_RELAXED, __HIP_MEMORY_SCOPE_AGENT); }
__device__ __forceinline__ unsigned xb_add(unsigned* p, unsigned v) { return __hip_atomic_fetch_add(p, v, __ATOMIC_RELAXED, __HIP_MEMORY_SCOPE_AGENT); }
__device__ __forceinline__ unsigned xb_xcc_id() { return (unsigned)__builtin_amdgcn_s_getreg((3 << 11) | 20) & 0xFu; }
#define XB_SPIN(cond, bar) do { unsigned _sp = 0; while (cond) { __builtin_amdgcn_s_sleep(1); \
    if ((++_sp & 255u) == 0u) { if (xb_ld(&(bar)[XB_TMO])) break; if (_sp > XB_SPIN_CAP) { atomicAdd(&(bar)[XB_TMO], 1u); break; } } } } while (0)

struct XcdBarrier {
    unsigned* bar; unsigned x;
    volatile LAS unsigned* st;
};

__device__ __forceinline__ XcdBarrier xcd_barrier_post(unsigned* bar, volatile LAS unsigned* st) {
    XcdBarrier b; b.bar = bar; b.x = xb_xcc_id(); b.st = st;
    if (threadIdx.x == 0) (void)xb_add(&bar[XB_XCNT(b.x)], 1u);
    return b;
}
__device__ __forceinline__ void xcd_barrier_complete(unsigned* bar, unsigned x, unsigned& nloc, unsigned& nx) {
    const unsigned G = gridDim.x * gridDim.y * gridDim.z;
    unsigned sum, cnt, mine, sp = 0u;
    for (;;) {
        sum = 0u; cnt = 0u; mine = 0u;
#pragma unroll
        for (unsigned j = 0; j < 16; ++j) { const unsigned c = xb_ld(&bar[XB_XCNT(j)]); sum += c; cnt += (c > 0u) ? 1u : 0u; mine = (j == x) ? c : mine; }
        if (sum == G) break;
        __builtin_amdgcn_s_sleep(1);
        if ((++sp & 255u) == 0u) { if (xb_ld(&bar[XB_TMO])) break; if (sp > XB_SPIN_CAP) { atomicAdd(&bar[XB_TMO], 1u); break; } }
    }
    nloc = mine > 0u ? mine : 1u; nx = cnt > 0u ? cnt : 1u;
}

__device__ __forceinline__ void xcd_barrier(const XcdBarrier& b) {
    asm volatile("s_waitcnt vmcnt(0)" ::: "memory");
    __syncthreads();
    if (threadIdx.x == 0) {
        unsigned* bar = b.bar;
        __builtin_amdgcn_s_waitcnt(0);
        unsigned nloc = b.st[0], nx = b.st[1];
        if (nloc == 0u) { xcd_barrier_complete(bar, b.x, nloc, nx); b.st[0] = nloc; b.st[1] = nx; }
        const unsigned old = xb_add(&bar[XB_XSUB(b.x)], 1u);
        const unsigned gen = old / nloc;
        if (old + 1u == (gen + 1u) * nloc) {
            __builtin_amdgcn_fence(__ATOMIC_RELEASE, "agent");
            asm volatile("s_waitcnt vmcnt(0)" ::: "memory");
            const unsigned og = xb_add(&bar[XB_TOP], 1u);
            const unsigned tg = og / nx;
            if (og + 1u == (tg + 1u) * nx) xb_add(&bar[XB_TOPGEN], 1u);
            else XB_SPIN(xb_ld(&bar[XB_TOPGEN]) == tg, bar);
            __builtin_amdgcn_fence(__ATOMIC_ACQUIRE, "agent");
            xb_add(&bar[XB_XGEN(b.x)], 1u);
            asm volatile("s_waitcnt vmcnt(0)" ::: "memory");
        } else {
            XB_SPIN(xb_ld(&bar[XB_XGEN(b.x)]) == gen, bar);
            __builtin_amdgcn_fence(__ATOMIC_ACQUIRE, "agent");
            asm volatile("s_waitcnt vmcnt(0)" ::: "memory");
        }
    }
    __syncthreads();
}

namespace pg8 {
#define PG8_LAS __attribute__((address_space(3)))
typedef unsigned short bf16_t;
typedef short bf16x8 __attribute__((ext_vector_type(8)));
typedef float f32x4 __attribute__((ext_vector_type(4)));
typedef unsigned u32x4 __attribute__((ext_vector_type(4)));
constexpr int BM = 256, BK = 64, HALF = 128, HTB = HALF * BK * 2  , STAGE_BYTES = 8 * HTB, NXCD = 8, WGM = 8;

__host__ __device__ __forceinline__ int lds_byte(int r, int c) { const int st = (r >> 4) * 2 + (c >> 5), rr = r & 15, cc = c & 31, ob = rr * 64 + cc * 2; return st * 1024 + (ob ^ (((ob >> 9) & 1) << 5)); }
__host__ __device__ __forceinline__ void stage_rc(int b, int& R, int& C) { const int st = b / 1024, sb = b % 1024, swz = sb ^ (((sb >> 9) & 1) << 5); R = (st >> 1) * 16 + swz / 64; C = (st & 1) * 32 + (swz % 64) / 2; }
__host__ __device__ __forceinline__ int perm32(int rho) { const int n = rho >> 4, i = rho & 15; return 8 * (i >> 2) + 4 * n + (i & 3); }

struct Unit { int pm, pn; };
struct Gemm { const bf16_t* A; const bf16_t* Bt; int M, N, K; };

struct StaticOrder {
    int nM, nN, nwg, G, c;
    __host__ __device__ void init(int M, int N, int G_, int c_) { nM = M / BM; nN = N / BM; nwg = nM * nN; G = G_; c = c_; }
    __host__ __device__ bool next(int i, Unit& u) const {
        const long L = (long)i * G + c; if (L >= nwg) return false;
        int wgid = (int)L; { const int q = nwg / NXCD, r = nwg % NXCD, xcd = wgid % NXCD, off = wgid / NXCD; wgid = (xcd < r ? xcd * (q + 1) : r * (q + 1) + (xcd - r) * q) + off; }
        const int nig = WGM * nN, gid = wgid / nig, fm = gid * WGM, gsz = (nM - fm) < WGM ? (nM - fm) : WGM;
        u.pm = fm + ((wgid % nig) % gsz); u.pn = (wgid % nig) / gsz; return true;
    }
    __device__ __forceinline__ void a_ready(const Unit&) const {}
    __device__ __forceinline__ void done(const Unit&) const {}
};
__device__ __forceinline__ unsigned cvt_pk_bf16(float lo, float hi) { unsigned r; asm volatile("v_cvt_pk_bf16_f32 %0, %1, %2" : "=v"(r) : "v"(lo), "v"(hi)); return r; }
typedef float f32x2 __attribute__((ext_vector_type(2)));
__device__ __forceinline__ f32x2 gelu_pk(f32x2 v) {
    const f32x2 av = __builtin_elementwise_abs(v), d = av * 0.2316418882f + 1.0f;
    f32x2 t; t.x = __builtin_amdgcn_rcpf(d.x); t.y = __builtin_amdgcn_rcpf(d.y);
    f32x2 q = t * 0.5307027145f + (-0.7265760135f); q = q * t + 0.7107068705f; q = q * t + (-0.142248368f); q = q * t + 0.127414796f; q = q * t;
    const f32x2 s = (v * v) * (-0.72134752044f);
    f32x2 e; e.x = __builtin_amdgcn_exp2f(s.x); e.y = __builtin_amdgcn_exp2f(s.y);
    const f32x2 m = v * (q * e), r = v - m;
    f32x2 o; o.x = v.x < 0.f ? m.x : r.x; o.y = v.y < 0.f ? m.y : r.y; return o;
}

template <class Epi, class Sched, bool STAMP = false>
__device__ __forceinline__ void gemm_phase(PG8_LAS unsigned char* lds, const Gemm g, const Sched& S, const Epi& E, unsigned long long* stamps) {
    int tid_ = threadIdx.x; asm volatile("" : "+v"(tid_));
    const int tid = tid_, wid = __builtin_amdgcn_readfirstlane(tid >> 6), lane = tid & 63, wr = wid >> 2, wc = wid & 3, fr = lane & 15, fq = lane >> 4;
    const int K = g.K, nt = K / BK;
    int ts_lo = 0, ts_hi = 0, nts = 0; const unsigned long long rt_entry = STAMP ? (unsigned long long)wall_clock64() : 0ull;
#define PG8_STAMP() do { if (STAMP && wid == 0 && nts < 64) { const unsigned long long _c = (unsigned long long)clock64(); \
        ts_lo = (lane == nts) ? (int)(unsigned)_c : ts_lo; ts_hi = (lane == nts) ? (int)(unsigned)(_c >> 32) : ts_hi; ++nts; } } while (0)
    PG8_STAMP();
    unsigned voffA[2], voffB[2];
#pragma unroll
    for (int i = 0; i < 2; ++i) { int R, C; stage_rc(tid * 16 + i * 8192, R, C); const int Rb = Epi::PERM ? ((R & ~31) + perm32(R & 31)) : R;
        voffA[i] = (unsigned)(R * K + C) * 2u; voffB[i] = (unsigned)(Rb * K + C) * 2u; }
    const size_t kstep = (size_t)(BK * 2);
    const size_t hstep = (size_t)HALF * K * 2;
    const size_t tstep = 2 * hstep;
    const unsigned ldsw = (unsigned)wid * 1024u;
    const int aoff = lds_byte(wr * 64 + fr, fq * 8), boff = lds_byte(wc * 32 + fr, fq * 8);
#define PG8_SA(b, h) (((b) * 2 + (h)) * HTB)
#define PG8_SB(b, h) ((4 + (b) * 2 + (h)) * HTB)
#define PG8_STAGE(bufoff, gbase, voff) do { _Pragma("unroll") for (int _i = 0; _i < 2; ++_i) \
        __builtin_amdgcn_global_load_lds((const unsigned*)((const char*)(gbase) + (voff)[_i]), (PG8_LAS unsigned*)(lds + (bufoff) + ldsw + _i * 8192), 16, 0, 0); } while (0)
#define PG8_LDA(dst, b, h) do { _Pragma("unroll") for (int m = 0; m < 4; ++m) _Pragma("unroll") for (int k = 0; k < 2; ++k) dst[m][k] = *(const PG8_LAS bf16x8*)(lds + PG8_SA(b, h) + aoff + m * 2048 + k * 1024); } while (0)
#define PG8_LDB(dst, b, h) do { _Pragma("unroll") for (int n = 0; n < 2; ++n) _Pragma("unroll") for (int k = 0; k < 2; ++k) dst[n][k] = *(const PG8_LAS bf16x8*)(lds + PG8_SB(b, h) + boff + n * 2048 + k * 1024); } while (0)
#define PG8_MMA(ai, bj, At, Bt) do { __builtin_amdgcn_s_setprio(1); _Pragma("unroll") for (int m = 0; m < 4; ++m) _Pragma("unroll") for (int n = 0; n < 2; ++n) _Pragma("unroll") for (int k = 0; k < 2; ++k) \
        acc[ai][bj][m][n] = __builtin_amdgcn_mfma_f32_16x16x32_bf16(Bt[n][k], At[m][k], acc[ai][bj][m][n], 0, 0, 0); __builtin_amdgcn_s_setprio(0); } while (0)
#define PG8_WAIT_V(n) asm volatile("s_waitcnt vmcnt(" #n ")" ::: "memory")
#define PG8_WAIT_L(n) asm volatile("s_waitcnt lgkmcnt(" #n ")" ::: "memory")
#define PG8_BAR __builtin_amdgcn_s_barrier()
#define PG8_SCHED __builtin_amdgcn_sched_barrier(0)
    Unit cur, nxt; int ui = 0;
    if (!S.next(0, cur)) return;
    f32x4 acc[2][2][4][2];
#pragma unroll
    for (int a = 0; a < 2; ++a)
#pragma unroll
        for (int b = 0; b < 2; ++b)
#pragma unroll
            for (int m = 0; m < 4; ++m)
#pragma unroll
                for (int n = 0; n < 2; ++n) acc[a][b][m][n] = (f32x4){0.f, 0.f, 0.f, 0.f};
    bf16x8 At[4][2], B0[2][2], B1[2][2];
    const char* cA = (const char*)g.A + (size_t)cur.pm * tstep; const char* cB = (const char*)g.Bt + (size_t)cur.pn * tstep;
    S.a_ready(cur);
    PG8_STAGE(PG8_SB(0, 0), cB, voffB); PG8_STAGE(PG8_SA(0, 0), cA, voffA); PG8_STAGE(PG8_SB(0, 1), cB + hstep, voffB); PG8_STAGE(PG8_SA(0, 1), cA + hstep, voffA);
    if (wr == 1) PG8_BAR;
    PG8_WAIT_V(4); PG8_BAR;
    PG8_STAGE(PG8_SB(1, 0), cB + kstep, voffB); PG8_STAGE(PG8_SA(1, 0), cA + kstep, voffA); PG8_STAGE(PG8_SB(1, 1), cB + hstep + kstep, voffB);
    PG8_WAIT_V(6); PG8_BAR;
    PG8_STAMP();
    for (;;) {
        const bool has_next = S.next(ui + 1, nxt);
        const char* nA = has_next ? (const char*)g.A + (size_t)nxt.pm * tstep : cA; const char* nB = has_next ? (const char*)g.Bt + (size_t)nxt.pn * tstep : cB;
        for (int t = 0; t < nt; t += 2) {
            const bool last = (t == nt - 2);
            const char* a1 = cA + (size_t)(t + 1) * kstep;
            const char* a2 = last ? nA : cA + (size_t)(t + 2) * kstep; const char* b2 = last ? nB : cB + (size_t)(t + 2) * kstep;
            const char* a3 = a2 + kstep; const char* b3 = b2 + kstep;
            if (last && has_next) S.a_ready(nxt);
            PG8_LDB(B0, 0, 0); PG8_SCHED; PG8_LDA(At, 0, 0); PG8_STAGE(PG8_SA(1, 1), a1 + hstep, voffA);
            PG8_WAIT_L(8); PG8_BAR; PG8_WAIT_L(0); PG8_MMA(0, 0, At, B0); PG8_BAR; PG8_SCHED;
            PG8_LDB(B1, 0, 1); PG8_STAGE(PG8_SB(0, 0), b2, voffB);
            PG8_BAR; PG8_WAIT_L(0); PG8_MMA(0, 1, At, B1); PG8_BAR;
            PG8_LDA(At, 0, 1); PG8_STAGE(PG8_SA(0, 0), a2, voffA);
            PG8_BAR; PG8_WAIT_L(0); PG8_MMA(1, 0, At, B0); PG8_BAR; PG8_SCHED;
            PG8_STAGE(PG8_SB(0, 1), b2 + hstep, voffB);
            PG8_WAIT_V(6); PG8_BAR; PG8_MMA(1, 1, At, B1); PG8_BAR;
            PG8_LDB(B0, 1, 0); PG8_SCHED; PG8_LDA(At, 1, 0); PG8_STAGE(PG8_SA(0, 1), a2 + hstep, voffA);
            PG8_WAIT_L(8); PG8_BAR; PG8_WAIT_L(0); PG8_MMA(0, 0, At, B0); PG8_BAR; PG8_SCHED;
            PG8_LDB(B1, 1, 1); PG8_STAGE(PG8_SB(1, 0), b3, voffB);
            PG8_BAR; PG8_WAIT_L(0); PG8_MMA(0, 1, At, B1); PG8_BAR;
            PG8_LDA(At, 1, 1); PG8_STAGE(PG8_SA(1, 0), a3, voffA);
            PG8_BAR; PG8_WAIT_L(0); PG8_MMA(1, 0, At, B0); PG8_BAR; PG8_SCHED;
            PG8_STAGE(PG8_SB(1, 1), b3 + hstep, voffB);
            PG8_WAIT_V(6); PG8_BAR; PG8_MMA(1, 1, At, B1); PG8_BAR;
        }
        PG8_STAMP();
        if constexpr (!Epi::AFTER_DRAIN) { E(acc, cur, wr, wc, fr, fq); S.done(cur); }
        PG8_STAMP();
        if (!has_next) break;
#pragma unroll
        for (int a = 0; a < 2; ++a)
#pragma unroll
            for (int b = 0; b < 2; ++b)
#pragma unroll
                for (int m = 0; m < 4; ++m)
#pragma unroll
                    for (int n = 0; n < 2; ++n) acc[a][b][m][n] = (f32x4){0.f, 0.f, 0.f, 0.f};
        cur = nxt; cA = nA; cB = nB; ++ui;
    }
    PG8_WAIT_V(0);
    if (wr == 0) PG8_BAR;
    PG8_BAR;
    if constexpr (Epi::AFTER_DRAIN) { E.fused(acc, cur, wr, wc, fr, fq, lds, wid, lane); S.done(cur); }
    PG8_STAMP();
    if (STAMP && wid == 0) { stamps[lane] = lane < nts ? (((unsigned long long)(unsigned)ts_hi << 32) | (unsigned)ts_lo) : 0ull;
        if (lane == 62) stamps[62] = rt_entry; if (lane == 63) stamps[63] = (unsigned long long)wall_clock64(); }
#undef PG8_STAMP
#undef PG8_SA
#undef PG8_SB
#undef PG8_STAGE
#undef PG8_LDA
#undef PG8_LDB
#undef PG8_MMA
#undef PG8_WAIT_V
#undef PG8_WAIT_L
#undef PG8_BAR
#undef PG8_SCHED
}
}

using pg8::bf16_t; using pg8::f32x4; using pg8::bf16x8; using pg8::Unit; using pg8::Gemm; using pg8::StaticOrder;
#define MT 34816
#define ML 32768
#define NIN 4608
#define DFF 5632
#define MODL (9 * 12288)

struct Params {
    const float *x, *c, *ctx, *c_ctx, *norm1_g, *norm2_g, *w_ada, *b_ada, *w_in, *mu, *w0, *w2, *a0, *a2, *g2, *kk_scale, *ka, *rk, *lnx_w, *lnx_b, *sink, *f_g, *a_g, *w_out, *w_ffn_in, *conv_w, *conv_b, *w_ffn_out, *final_g;
    float* out; unsigned* bar; float* mod; float* rope; float* xc;
    bf16_t *wt_in, *wt_out, *wt_f1, *wt_f2, *wt_lr, *wf, *wfc, *u, *q, *ak, *vt, *vtc, *rw, *ft, *ftc, *dec, *aa, *gg, *y, *a2b, *fo, *at, *h, *act;
};

__device__ __forceinline__ int otid() { int t = threadIdx.x; asm volatile("" : "+v"(t)); return t; }
__device__ __forceinline__ bf16_t f2bf(float f) { unsigned u = __float_as_uint(f); u += 0x7FFFu + ((u >> 16) & 1u); return (bf16_t)(u >> 16); }
__device__ __forceinline__ float bf2f(bf16_t h) { return __uint_as_float(((unsigned)h) << 16); }
__device__ __forceinline__ unsigned pk2(float a, float b) { return (unsigned)f2bf(a) | ((unsigned)f2bf(b) << 16); }
__device__ __forceinline__ float lo_bf(unsigned w) { return __uint_as_float(w << 16); }
__device__ __forceinline__ float hi_bf(unsigned w) { return __uint_as_float(w & 0xffff0000u); }
__device__ __forceinline__ float wave_sum(float v) { v += __shfl_xor(v, 32); v += __shfl_xor(v, 16); v += __shfl_xor(v, 8); v += __shfl_xor(v, 4); v += __shfl_xor(v, 2); v += __shfl_xor(v, 1); return v; }
__device__ __forceinline__ float sigmoidf_(float x) { return 1.0f / (1.0f + __expf(-x)); }
template <int CTRL> __device__ __forceinline__ float dpp_add(float x) { return x + __int_as_float(__builtin_amdgcn_update_dpp(0, __float_as_int(x), CTRL, 0xf, 0xf, true)); }
__device__ __forceinline__ float sum8(float x) { x = dpp_add<0xB1>(x); x = dpp_add<0x4E>(x); x = dpp_add<0x141>(x); return x; }

__device__ __forceinline__ int srccol_in(int n) {
    if (n < 1024) return -1;
    if (n < 2304) { const int base = n < 2048 ? 512 : 3456; const int cq = n < 2048 ? n - 1024 : n - 2048; const int head = cq >> 7, pp = cq & 127, axis = pp >> 6, i = (pp & 63) >> 1, half = pp & 1; return base + head * 128 + axis * 64 + half * 32 + i; }
    if (n < 2560) return 3712 + (n - 2304);
    if (n < 3072) return 1536 + (n - 2560);
    if (n < 3584) return 2176 + (n - 3072);
    if (n < 4096) return 2688 + (n - 3584);
    if (n < 4224) return 2048 + (n - 4096);
    if (n < 4352) return 3200 + (n - 4224);
    if (n < 4480) return 3328 + (n - 4352);
    return -1;
}
__device__ __forceinline__ void xpose_tile(const float* src, int Nsrc, bf16_t* dst, int K, int n0, int k0, int mode, float* tile) {
    const int tid = otid(), nn = tid & 63, kk = tid >> 6;
    const int sc = mode ? srccol_in(n0 + nn) : (n0 + nn);
#pragma unroll
    for (int pp = 0; pp < 8; ++pp) { const int k = kk + 8 * pp; tile[k * 65 + nn] = sc >= 0 ? src[(size_t)(k0 + k) * Nsrc + sc] : 0.f; }
    __syncthreads();
    const int rn = tid >> 3, kc = tid & 7;
    uint4 w;
    w.x = pk2(tile[(kc * 8 + 0) * 65 + rn], tile[(kc * 8 + 1) * 65 + rn]); w.y = pk2(tile[(kc * 8 + 2) * 65 + rn], tile[(kc * 8 + 3) * 65 + rn]);
    w.z = pk2(tile[(kc * 8 + 4) * 65 + rn], tile[(kc * 8 + 5) * 65 + rn]); w.w = pk2(tile[(kc * 8 + 6) * 65 + rn], tile[(kc * 8 + 7) * 65 + rn]);
    *(uint4*)(dst + (size_t)(n0 + rn) * K + k0 + kc * 8) = w;
    __syncthreads();
}

__device__ __forceinline__ void prologue(const Params& p, unsigned char* shm) {
    const int tid = otid(), G = gridDim.x, bid = blockIdx.x;
    float* fl = (float*)shm;
#pragma unroll 1
    for (int it = bid; it < 4 * 11264; it += G) {
        const int l = it / 11264; int r = it % 11264;
        if (r < 1792) xpose_tile(p.w_in + (size_t)l * 2048 * 3968, 3968, p.wt_in + (size_t)l * NIN * 2048, 2048, 1024 + (r >> 5) * 64, (r & 31) * 64, 1, fl);
        else if (r < 2816) { r -= 1792; xpose_tile(p.w_out + (size_t)l * 2048 * 2048, 2048, p.wt_out + (size_t)l * 2048 * 2048, 2048, (r >> 5) * 64, (r & 31) * 64, 0, fl); }
        else if (r < 8448) { r -= 2816; xpose_tile(p.w_ffn_in + (size_t)l * 2048 * 11264, 11264, p.wt_f1 + (size_t)l * 11264 * 2048, 2048, (r >> 5) * 64, (r & 31) * 64, 0, fl); }
        else { r -= 8448; xpose_tile(p.w_ffn_out + (size_t)l * DFF * 2048, 2048, p.wt_f2 + (size_t)l * 2048 * DFF, DFF, (r / 88) * 64, (r % 88) * 64, 0, fl); }
    }
    {
        float* wt = fl; float* ctab = fl + 64 * 129;
        if (tid < 128) ctab[tid] = cospif((float)tid / 64.0f) * 0.08838834764831845f;
        __syncthreads();
#pragma unroll 1
        for (int it = bid; it < 512; it += G) {
            const int l = it >> 7, g = (it >> 5) & 3, k0 = (it & 31) * 64;
            const float* src = p.w_in + (size_t)l * 2048 * 3968;
#pragma unroll
            for (int pp = 0; pp < 16; ++pp) { const int idx = tid + 512 * pp, kk = idx >> 7, c = idx & 127; wt[kk * 129 + c] = src[(size_t)(k0 + kk) * 3968 + g * 128 + c]; }
            __syncthreads();
            const int cp = tid & 127, kq = tid >> 7;
            unsigned oc[8], os[8];
#pragma unroll 1
            for (int k2 = 0; k2 < 8; ++k2) {
                float c0 = 0.f, s0 = 0.f, c1 = 0.f, s1 = 0.f;
                const float* r0 = wt + (kq * 16 + 2 * k2) * 129; const float* r1 = r0 + 129;
                for (int c = 0; c < 128; ++c) { const int j = (c * cp) & 127; const float cv = ctab[j], sv = ctab[(j - 32) & 127]; c0 += r0[c] * cv; s0 += r0[c] * sv; c1 += r1[c] * cv; s1 += r1[c] * sv; }
                oc[k2] = pk2(c0, c1); os[k2] = pk2(s0, s1);
            }
            bf16_t* dc = p.wt_in + (size_t)l * NIN * 2048 + (size_t)(g * 128 + cp) * 2048 + k0 + kq * 16;
            bf16_t* ds = dc + (size_t)512 * 2048;
            *(uint4*)dc = make_uint4(oc[0], oc[1], oc[2], oc[3]); *(uint4*)(dc + 8) = make_uint4(oc[4], oc[5], oc[6], oc[7]);
            *(uint4*)ds = make_uint4(os[0], os[1], os[2], os[3]); *(uint4*)(ds + 8) = make_uint4(os[4], os[5], os[6], os[7]);
            __syncthreads();
        }
    }
    {
        float* ct = fl;
        __syncthreads();
        for (int i = tid; i < 4096; i += 512) ct[i] = cospif((float)i / 2048.0f) * (1.0f / 64.0f);
        __syncthreads();
#pragma unroll 1
        for (int idx = bid * 512 + tid; idx < 4096 * 1024; idx += G * 512) {
            const int kf = idx >> 10, gi = idx & 1023, half = gi >> 9, t0 = (gi & 511) * 8;
            float v[8];
#pragma unroll
            for (int e = 0; e < 8; ++e) { const int j = (kf * (t0 + e)) & 4095; v[e] = half ? -ct[(j - 1024) & 4095] : ct[j]; }
            *(uint4*)(p.wf + (size_t)kf * 8192 + half * 4096 + t0) = make_uint4(pk2(v[0], v[1]), pk2(v[2], v[3]), pk2(v[4], v[5]), pk2(v[6], v[7]));
        }
#pragma unroll 1
        for (int idx = bid * 512 + tid; idx < 256 * 64; idx += G * 512) {
            const int kf = idx >> 6, gi = idx & 63, half = gi >> 5, t0 = (gi & 31) * 8;
            float v[8];
#pragma unroll
            for (int e = 0; e < 8; ++e) { const int j = ((kf * (t0 + e)) & 255) * 16; v[e] = 4.0f * (half ? -ct[(j - 1024) & 4095] : ct[j]); }
            *(uint4*)(p.wfc + (size_t)kf * 512 + half * 256 + t0) = make_uint4(pk2(v[0], v[1]), pk2(v[2], v[3]), pk2(v[4], v[5]), pk2(v[6], v[7]));
        }
#pragma unroll 1
        for (int idx = bid * 512 + tid; idx < 4096 * 64; idx += G * 512) {
            const int t = idx >> 6, axis = (idx >> 5) & 1, i = idx & 31;
            const float inv = powf(10000.0f, -(float)i / 32.0f); const float pos = (float)(axis ? (t & 63) : (t >> 6)); const float ang = pos * inv;
            p.rope[(size_t)idx * 2] = cosf(ang); p.rope[(size_t)idx * 2 + 1] = sinf(ang);
        }
#pragma unroll 1
        for (int idx = bid * 512 + tid; idx < 4 * 2560 * 384; idx += G * 512) {
            const int l = idx / (2560 * 384), rem = idx % (2560 * 384), n = rem / 384, k = rem % 384;
            float v = 0.f;
            if (n < 1024) { const int dir = n >> 9, ch = n & 511; if (k < 128 && (k >> 6) == dir) v = p.w2[(((size_t)l * 2 + dir) * 64 + (k & 63)) * 512 + ch]; }
            else if (n < 2048) { const int nn = n - 1024, dir = nn >> 9, ch = nn & 511; if (k >= 128 && k < 256 && ((k - 128) >> 6) == dir) v = p.a2[(((size_t)l * 2 + dir) * 64 + ((k - 128) & 63)) * 512 + ch]; }
            else { const int ch = n - 2048; if (k >= 256) v = p.g2[((size_t)l * 128 + (k - 256)) * 512 + ch]; }
            p.wt_lr[idx] = f2bf(v);
        }
        __syncthreads();
    }
    {
        float* sv = fl; float* red = fl + 9 * 2048;
        for (int i = tid; i < 9 * 2048; i += 512) { const int s = i >> 11, k = i & 2047; const float xv = s < 8 ? p.c[s * 2048 + k] : p.c_ctx[k]; sv[i] = xv / (1.0f + expf(-xv)); }
        __syncthreads();
#pragma unroll 1
        for (int it = bid; it < 768; it += G) {
            const int l = it / 192, col0 = (it % 192) * 64, cx = tid & 63, ks = tid >> 6;
            float acc[9];
#pragma unroll
            for (int s = 0; s < 9; ++s) acc[s] = 0.f;
            const float* wp = p.w_ada + (size_t)l * 2048 * 12288 + col0 + cx;
#pragma unroll 4
            for (int k = ks * 256; k < ks * 256 + 256; ++k) { const float w = wp[(size_t)k * 12288];
#pragma unroll
                for (int s = 0; s < 9; ++s) acc[s] += sv[s * 2048 + k] * w; }
#pragma unroll
            for (int s = 0; s < 9; ++s) red[(ks * 9 + s) * 64 + cx] = acc[s];
            __syncthreads();
            for (int o = tid; o < 576; o += 512) { const int s = o >> 6, cc = o & 63; float t = 0.f;
#pragma unroll
                for (int k8 = 0; k8 < 8; ++k8) t += red[(k8 * 9 + s) * 64 + cc];
                p.mod[((size_t)l * 9 + s) * 12288 + col0 + cc] = t + p.b_ada[(size_t)l * 12288 + col0 + cc]; }
            __syncthreads();
        }
    }
}

__device__ __forceinline__ void norm_mod(const float* xl, const float* xc, const float* gain, const float* modl, int shOff, int scOff, bf16_t* U) {
    const int wave = otid() >> 6, lane = otid() & 63;
#pragma unroll 1
    for (int row = blockIdx.x * 8 + wave; row < MT; row += gridDim.x * 8) {
        const float4* src = (const float4*)(row < ML ? xl + (size_t)row * 2048 : xc + (size_t)(row - ML) * 2048);
        const int s = row < ML ? (row >> 12) : 8;
        float4 v[8]; float ss = 0.f;
#pragma unroll
        for (int i = 0; i < 8; ++i) { v[i] = src[lane + 64 * i]; ss += v[i].x * v[i].x + v[i].y * v[i].y + v[i].z * v[i].z + v[i].w * v[i].w; }
        ss = wave_sum(ss);
        const float rs = rsqrtf(ss * (1.0f / 2048.0f) + 1e-6f);
        const float4* g4 = (const float4*)gain; const float4* sh4 = (const float4*)(modl + s * 12288 + shOff); const float4* sc4 = (const float4*)(modl + s * 12288 + scOff);
#pragma unroll
        for (int i = 0; i < 8; ++i) { const int ci = lane + 64 * i; const float4 g = g4[ci], sh = sh4[ci], sc = sc4[ci];
            const float o0 = v[i].x * rs * g.x * (1.0f + sc.x) + sh.x, o1 = v[i].y * rs * g.y * (1.0f + sc.y) + sh.y, o2 = v[i].z * rs * g.z * (1.0f + sc.z) + sh.z, o3 = v[i].w * rs * g.w * (1.0f + sc.w) + sh.w;
            *(uint2*)(U + (size_t)row * 2048 + ci * 4) = make_uint2(pk2(o0, o1), pk2(o2, o3)); }
    }
}

struct EpiIn {
    static constexpr bool PERM = false, AFTER_DRAIN = false;
    bf16_t *q, *ak, *vt, *vtc, *rw, *ft, *ftc; const float* rope;
    __device__ __forceinline__ void operator()(const f32x4 (&acc)[2][2][4][2], const Unit& u, int wr, int wc, int fr, int fq) const {
        asm volatile("" : "+v"(fr), "+v"(fq));
        const int pn = u.pn; const int cb = wc * 32 + 4 * fq;
#pragma unroll
        for (int ai = 0; ai < 2; ++ai)
#pragma unroll
            for (int m = 0; m < 4; ++m) {
                const int r = u.pm * 256 + ai * 128 + wr * 64 + m * 16 + fr;
                const bool lat = r < ML; const int b = lat ? (r >> 12) : ((r - ML) >> 8); const int t = lat ? (r & 4095) : ((r - ML) & 255);
                if (pn < 4) {
                    const int half = pn >> 1; const int ch0 = (pn & 1) * 256 + cb;
                    bf16_t* d = lat ? ft + ((unsigned)(b * 512 + ch0) * 8192u + half * 4096 + t) : ftc + ((unsigned)(b * 512 + ch0) * 512u + half * 256 + t);
                    const unsigned sd = lat ? 8192u : 512u;
#pragma unroll
                    for (int bj = 0; bj < 2; ++bj)
#pragma unroll
                        for (int n = 0; n < 2; ++n) { const f32x4 v = acc[ai][bj][m][n]; bf16_t* dd = d + (unsigned)(bj * 128 + n * 16) * sd;
                            dd[0] = f2bf(v[0]); dd[sd] = f2bf(v[1]); dd[2 * sd] = f2bf(v[2]); dd[3 * sd] = f2bf(v[3]); }
                } else if (pn < 9) {
                    bf16_t* d = pn < 8 ? q + ((unsigned)r * 1024u + (pn - 4) * 256 + cb) : ak + ((unsigned)r * 256u + cb);
                    const float* rp = rope + (unsigned)t * 128u;
#pragma unroll
                    for (int bj = 0; bj < 2; ++bj)
#pragma unroll
                        for (int n = 0; n < 2; ++n) { f32x4 v = acc[ai][bj][m][n];
                            if (lat) { const int pp = (cb + n * 16) & 127, axis = pp >> 6, i = (pp & 63) >> 1;
                                const float4 cs = *(const float4*)(rp + (axis * 32 + i) * 2);
                                const float a0 = v[0], b0 = v[1], a1 = v[2], b1 = v[3];
                                v[0] = a0 * cs.x - b0 * cs.y; v[1] = a0 * cs.y + b0 * cs.x; v[2] = a1 * cs.z - b1 * cs.w; v[3] = a1 * cs.w + b1 * cs.z; }
                            *(uint2*)(d + bj * 128 + n * 16) = make_uint2(pk2(v[0], v[1]), pk2(v[2], v[3])); }
                } else if (pn == 9) {
                    bf16_t* d = lat ? vt + ((unsigned)(b * 256 + cb) * 4096u + t) : vtc + ((unsigned)(b * 256 + cb) * 256u + t);
                    const unsigned sd = lat ? 4096u : 256u;
#pragma unroll
                    for (int bj = 0; bj < 2; ++bj)
#pragma unroll
                        for (int n = 0; n < 2; ++n) { const f32x4 v = acc[ai][bj][m][n]; bf16_t* dd = d + (unsigned)(bj * 128 + n * 16) * sd;
                            dd[0] = f2bf(v[0]); dd[sd] = f2bf(v[1]); dd[2 * sd] = f2bf(v[2]); dd[3 * sd] = f2bf(v[3]); }
                } else {
                    bf16_t* d = rw + ((unsigned)r * 2048u + (pn - 10) * 256 + cb);
#pragma unroll
                    for (int bj = 0; bj < 2; ++bj)
#pragma unroll
                        for (int n = 0; n < 2; ++n) { const f32x4 v = acc[ai][bj][m][n]; *(uint2*)(d + bj * 128 + n * 16) = make_uint2(pk2(v[0], v[1]), pk2(v[2], v[3])); }
                }
                __builtin_amdgcn_sched_barrier(0);
            }
    }
};
struct EpiLR {
    static constexpr bool PERM = false, AFTER_DRAIN = false;
    bf16_t *dec, *aa, *gg; const float *w0, *a0;
    __device__ __forceinline__ void operator()(const f32x4 (&acc)[2][2][4][2], const Unit& u, int wr, int wc, int fr, int fq) const {
        asm volatile("" : "+v"(fr), "+v"(fq));
        const int pn = u.pn; const int cb = wc * 32 + 4 * fq;
#pragma unroll
        for (int ai = 0; ai < 2; ++ai)
#pragma unroll
            for (int m = 0; m < 4; ++m) {
                const int r = u.pm * 256 + ai * 128 + wr * 64 + m * 16 + fr;
                if (pn < 8) {
                    const int c0 = (pn & 3) * 256 + cb;
                    const float* bias = (pn < 4 ? w0 : a0) + c0;
                    bf16_t* d = (pn < 4 ? dec : aa) + ((unsigned)((c0 >> 9) * MT + r) * 512u + (c0 & 511));
#pragma unroll
                    for (int bj = 0; bj < 2; ++bj)
#pragma unroll
                        for (int n = 0; n < 2; ++n) { f32x4 v = acc[ai][bj][m][n]; const float4 wb = *(const float4*)(bias + bj * 128 + n * 16);
                            v[0] += wb.x; v[1] += wb.y; v[2] += wb.z; v[3] += wb.w;
#pragma unroll
                            for (int e = 0; e < 4; ++e) { const float ex = __expf(-v[e]);
                                v[e] = pn < 4 ? -__expf(-(v[e] < -20.f ? -v[e] : __logf(1.0f + ex)) - 0.5f) : 1.0f / (1.0f + ex); }
                            *(uint2*)(d + bj * 128 + n * 16) = make_uint2(pk2(v[0], v[1]), pk2(v[2], v[3])); }
                } else {
                    bf16_t* d = gg + ((unsigned)r * 512u + (pn - 8) * 256 + cb);
#pragma unroll
                    for (int bj = 0; bj < 2; ++bj)
#pragma unroll
                        for (int n = 0; n < 2; ++n) { const f32x4 v = acc[ai][bj][m][n]; *(uint2*)(d + bj * 128 + n * 16) = make_uint2(pk2(v[0], v[1]), pk2(v[2], v[3])); }
                }
                __builtin_amdgcn_sched_barrier(0);
            }
    }
};
struct EpiFO {
    static constexpr bool PERM = false, AFTER_DRAIN = false;
    bf16_t* fo; int base, seqlen;
    __device__ __forceinline__ void operator()(const f32x4 (&acc)[2][2][4][2], const Unit& u, int wr, int wc, int fr, int fq) const {
        asm volatile("" : "+v"(fr), "+v"(fq));
#pragma unroll
        for (int ai = 0; ai < 2; ++ai)
#pragma unroll
            for (int m = 0; m < 4; ++m) {
                const int r = u.pm * 256 + ai * 128 + wr * 64 + m * 16 + fr;
#pragma unroll
                for (int bj = 0; bj < 2; ++bj)
#pragma unroll
                    for (int n = 0; n < 2; ++n) {
                        const int c = u.pn * 256 + bj * 128 + wc * 32 + n * 16 + 4 * fq; const f32x4 v = acc[ai][bj][m][n];
                        *(uint2*)(fo + (unsigned)(base + (c >> 9) * seqlen + r) * 512u + (c & 511)) = make_uint2(pk2(v[0], v[1]), pk2(v[2], v[3]));
                    }
                __builtin_amdgcn_sched_barrier(0);
            }
    }
};
struct EpiRes {
    static constexpr bool PERM = false, AFTER_DRAIN = false;
    const float *xl_in, *xc_in; float *xl_out, *xc_out; const float* ga; int row_off;
    __device__ __forceinline__ void operator()(const f32x4 (&acc)[2][2][4][2], const Unit& u, int wr, int wc, int fr, int fq) const {
        asm volatile("" : "+v"(fr), "+v"(fq));
#pragma unroll
        for (int ai = 0; ai < 2; ++ai)
#pragma unroll
            for (int m = 0; m < 4; ++m) {
                const int r = row_off + u.pm * 256 + ai * 128 + wr * 64 + m * 16 + fr;
                const bool lat = r < ML; const int s = lat ? (r >> 12) : 8;
                const float* xi = lat ? xl_in + (size_t)r * 2048 : xc_in + (size_t)(r - ML) * 2048;
                float* xo = lat ? xl_out + (size_t)r * 2048 : xc_out + (size_t)(r - ML) * 2048;
#pragma unroll
                for (int bj = 0; bj < 2; ++bj)
#pragma unroll
                    for (int n = 0; n < 2; ++n) {
                        const int c = u.pn * 256 + bj * 128 + wc * 32 + n * 16 + 4 * fq; const f32x4 v = acc[ai][bj][m][n];
                        const float4 xv = *(const float4*)(xi + c); const float4 g = *(const float4*)(ga + s * 12288 + c);
                        *(float4*)(xo + c) = make_float4(xv.x + g.x * v[0], xv.y + g.y * v[1], xv.z + g.z * v[2], xv.w + g.w * v[3]);
                    }
                __builtin_amdgcn_sched_barrier(0);
            }
    }
};
struct EpiH {
    static constexpr bool PERM = false, AFTER_DRAIN = false;
    bf16_t* o; int ld;
    __device__ __forceinline__ void operator()(const f32x4 (&acc)[2][2][4][2], const Unit& u, int wr, int wc, int fr, int fq) const {
        asm volatile("" : "+v"(fr), "+v"(fq));
#pragma unroll
        for (int ai = 0; ai < 2; ++ai)
#pragma unroll
            for (int m = 0; m < 4; ++m) {
                const int r = u.pm * 256 + ai * 128 + wr * 64 + m * 16 + fr;
#pragma unroll
                for (int bj = 0; bj < 2; ++bj)
#pragma unroll
                    for (int n = 0; n < 2; ++n) {
                        const int c = u.pn * 256 + bj * 128 + wc * 32 + n * 16 + 4 * fq; const f32x4 v = acc[ai][bj][m][n];
                        *(uint2*)(o + (size_t)r * ld + c) = make_uint2(pk2(v[0], v[1]), pk2(v[2], v[3]));
                    }
                __builtin_amdgcn_sched_barrier(0);
            }
    }
};

__device__ __forceinline__ void seq_of(int row, int& t, int& L) { if (row < ML) { t = row & 4095; L = 4096; } else { t = (row - ML) & 255; L = 256; } }
__device__ __forceinline__ void prep_phase(const Params& p, int l) {
    const float* mu0 = p.mu + (size_t)l * 2 * 1920; const float* mu1 = mu0 + 1920;
#pragma unroll 1
    for (int idx = blockIdx.x * 512 + otid(); idx < MT * 384; idx += gridDim.x * 512) {
        const int row = idx / 384, cc = idx % 384; int t, L; seq_of(row, t, L);
        int rc, mc; if (cc < 128) { rc = 1664 + cc; mc = 1664 + cc; } else if (cc < 256) { rc = 1792 + (cc - 128); mc = 1792 + (cc - 128); } else { rc = 1536 + (cc - 256); mc = 512 + (cc - 256); }
        const bf16_t* bp = p.rw + (size_t)row * 2048 + rc;
        const float xv = bf2f(bp[0]); const float pv = t > 0 ? bf2f(bp[-2048]) : 0.f; const float nv = t < L - 1 ? bf2f(bp[2048]) : 0.f;
        const float sm = xv + mu0[mc] * (pv - xv) + mu1[mc] * (nv - xv);
        const float val = cc < 128 ? tanhf(sm) : (cc < 256 ? sm : sigmoidf_(sm));
        p.a2b[idx] = f2bf(val);
    }
}

__device__ __forceinline__ int scan_row(int st, int dir, int b, int& t, int& L) {
    if (st < 256) { t = dir ? 255 - st : st; L = 256; return ML + b * 256 + t; }
    const int s2 = st - 256; t = dir ? 4095 - s2 : s2; L = 4096; return b * 4096 + t;
}
__device__ __forceinline__ void scan_fill(const Params& p, int l, int chunk, float* buf, int dir, int b, int h, int pw, int lane) {
    const float* mu0 = p.mu + (size_t)l * 2 * 1920; const float* mu1 = mu0 + 1920;
    const int col = h * 64 + lane;
    const float mr0 = mu0[col], mr1 = mu1[col], mk0 = mu0[640 + col], mk1 = mu1[640 + col], mv0 = mu0[1152 + col], mv1 = mu1[1152 + col];
    const float ksc = p.kk_scale[l * 512 + col], kav = p.ka[l * 512 + col];
#pragma unroll 2
    for (int i = 0; i < 8; ++i) {
        const int sl = pw * 8 + i, st = chunk * 32 + sl; int t, L; const int row = scan_row(st, dir, b, t, L);
        const bf16_t* bp = p.rw + (size_t)row * 2048 + col; const bool hp = t > 0, hn = t < L - 1;
        const float rx = bf2f(bp[0]), kx = bf2f(bp[512]), vx = bf2f(bp[1024]);
        const float rp = hp ? bf2f(bp[-2048]) : 0.f, kp = hp ? bf2f(bp[512 - 2048]) : 0.f, vp = hp ? bf2f(bp[1024 - 2048]) : 0.f;
        const float rn = hn ? bf2f(bp[2048]) : 0.f, kn = hn ? bf2f(bp[512 + 2048]) : 0.f, vn = hn ? bf2f(bp[1024 + 2048]) : 0.f;
        const float a = bf2f(p.aa[((size_t)dir * MT + row) * 512 + col]), e = bf2f(p.dec[((size_t)dir * MT + row) * 512 + col]);
        const float r = rx + mr0 * (rp - rx) + mr1 * (rn - rx), k = kx + mk0 * (kp - kx) + mk1 * (kn - kx), v = vx + mv0 * (vp - vx) + mv1 * (vn - vx);
        float kk = k * ksc; const float n2 = wave_sum(kk * kk); kk = kk / fmaxf(sqrtf(n2), 1e-12f);
        float* o = buf + sl * 384;
        o[lane] = expf(e); o[64 + lane] = kk; o[128 + lane] = kk * a; o[192 + lane] = k * (1.0f + (a - 1.0f) * kav); o[256 + lane] = r; o[320 + lane] = v;
    }
}
__device__ __forceinline__ void scan_phase(const Params& p, int l, unsigned char* shm) {
    const int tid = otid(), wave = tid >> 6, lane = tid & 63;
    float* buf0 = (float*)shm; float* buf1 = buf0 + 32 * 384;
#pragma unroll 1
    for (int wi = blockIdx.x; wi < 256; wi += gridDim.x) {
        const int dir = wi >> 7, b = (wi >> 4) & 7, h = (wi >> 1) & 7, half = wi & 1;
        const int ri = lane >> 3, cj = lane & 7, irow = half * 32 + (wave & 3) * 8 + ri;
        float s[8];
#pragma unroll
        for (int e = 0; e < 8; ++e) s[e] = 0.f;
        __syncthreads();
        if (wave >= 4) scan_fill(p, l, 0, buf0, dir, b, h, wave - 4, lane);
        __syncthreads();
#pragma unroll 1
        for (int c = 0; c < 136; ++c) {
            float* cur = (c & 1) ? buf1 : buf0; float* nxt = (c & 1) ? buf0 : buf1;
            if (wave >= 4) { if (c + 1 < 136) scan_fill(p, l, c + 1, nxt, dir, b, h, wave - 4, lane); }
            else {
#pragma unroll 2
                for (int sl = 0; sl < 32; ++sl) {
                    const float* o = cur + sl * 384 + cj * 8;
                    const float4 w0 = *(const float4*)(o), w1 = *(const float4*)(o + 4), k0 = *(const float4*)(o + 64), k1 = *(const float4*)(o + 68), b0 = *(const float4*)(o + 128), b1 = *(const float4*)(o + 132);
                    const float4 d0 = *(const float4*)(o + 192), d1 = *(const float4*)(o + 196), r0 = *(const float4*)(o + 256), r1 = *(const float4*)(o + 260);
                    const float vv = cur[sl * 384 + 320 + irow];
                    float sa = s[0] * k0.x + s[1] * k0.y + s[2] * k0.z + s[3] * k0.w + s[4] * k1.x + s[5] * k1.y + s[6] * k1.z + s[7] * k1.w;
                    sa = sum8(sa);
                    s[0] = s[0] * w0.x - sa * b0.x + vv * d0.x; s[1] = s[1] * w0.y - sa * b0.y + vv * d0.y; s[2] = s[2] * w0.z - sa * b0.z + vv * d0.z; s[3] = s[3] * w0.w - sa * b0.w + vv * d0.w;
                    s[4] = s[4] * w1.x - sa * b1.x + vv * d1.x; s[5] = s[5] * w1.y - sa * b1.y + vv * d1.y; s[6] = s[6] * w1.z - sa * b1.z + vv * d1.z; s[7] = s[7] * w1.w - sa * b1.w + vv * d1.w;
                    float yv = s[0] * r0.x + s[1] * r0.y + s[2] * r0.z + s[3] * r0.w + s[4] * r1.x + s[5] * r1.y + s[6] * r1.z + s[7] * r1.w;
                    yv = sum8(yv);
                    int t, L; const int row = scan_row(c * 32 + sl, dir, b, t, L);
                    if (cj == 0) p.y[((size_t)dir * MT + row) * 512 + h * 64 + irow] = f2bf(yv);
                }
            }
            __syncthreads();
        }
    }
}

__device__ __forceinline__ void attn_phase(const Params& p, int l, unsigned char* shm) {
    const int tid = otid(), wave = tid >> 6, lane = tid & 63, fr = lane & 15, fq = lane >> 4;
    const int g = wave >> 1, qh = wave & 1;
    bf16_t* Ks = (bf16_t*)shm;
    bf16_t* Vs = (bf16_t*)(shm + 64 * 136 * 2);
    const float scale = 0.08838834764831845f;
#pragma unroll 1
    for (int un = blockIdx.x; un < 1088; un += gridDim.x) {
        const bool lat = un < 1024; int b, qb, hk;
        if (lat) { b = un >> 7; qb = (un >> 1) & 63; hk = un & 1; } else { const int v = un - 1024; b = v >> 3; qb = (v >> 1) & 3; hk = v & 1; }
        const int q0 = qb * 64, rowbase = lat ? b * 4096 : ML + b * 256, hq = hk * 4 + g;
        bf16x8 Qf[2][4];
#pragma unroll
        for (int qt = 0; qt < 2; ++qt)
#pragma unroll
            for (int ks = 0; ks < 4; ++ks) Qf[qt][ks] = *(const bf16x8*)(p.q + (size_t)(rowbase + q0 + qh * 32 + qt * 16 + fr) * 1024 + hq * 128 + ks * 32 + fq * 8);
        const float sinkv = p.sink[l * 8 + hq];
        float mrun[2] = {sinkv, sinkv}, lsum[2]; lsum[0] = lsum[1] = (fq == 0) ? 1.0f : 0.0f;
        f32x4 O[8][2];
#pragma unroll
        for (int dt = 0; dt < 8; ++dt) { O[dt][0] = (f32x4){0.f, 0.f, 0.f, 0.f}; O[dt][1] = (f32x4){0.f, 0.f, 0.f, 0.f}; }
        const int nkb = lat ? 9 : 4;
#pragma unroll 1
        for (int kb = 0; kb < nkb; ++kb) {
            const bool local = lat && kb < 5; const int kp0 = local ? q0 - 128 + 64 * kb : 0;
            if (local && (kp0 < 0 || kp0 >= 4096)) continue;
            const int cb = lat ? kb - 5 : kb;
            const int krow0 = local ? b * 4096 + kp0 : ML + b * 256 + cb * 64;
            const bf16_t* vsrc = local ? p.vt + (size_t)(b * 256 + hk * 128) * 4096 + kp0 : p.vtc + (size_t)(b * 256 + hk * 128) * 256 + cb * 64;
            const int vstride = local ? 4096 : 256;
            __syncthreads();
            {
                const int key = tid >> 3, ch = tid & 7; const uint4* s1 = (const uint4*)(p.ak + (size_t)(krow0 + key) * 256 + hk * 128 + ch * 16);
                const uint4 a = s1[0], c = s1[1];
                const int dd = tid >> 2, c4 = tid & 3; const uint4* s2 = (const uint4*)(vsrc + (size_t)dd * vstride + c4 * 16);
                const uint4 v0 = s2[0], v1 = s2[1];
                uint4* d1 = (uint4*)(Ks + key * 136 + ch * 16); d1[0] = a; d1[1] = c;
                uint2* d2 = (uint2*)(Vs + dd * 68 + c4 * 16); d2[0] = make_uint2(v0.x, v0.y); d2[1] = make_uint2(v0.z, v0.w); d2[2] = make_uint2(v1.x, v1.y); d2[3] = make_uint2(v1.z, v1.w);
            }
            __syncthreads();
            f32x4 S[4][2];
#pragma unroll
            for (int kt = 0; kt < 4; ++kt) { S[kt][0] = (f32x4){0.f, 0.f, 0.f, 0.f}; S[kt][1] = (f32x4){0.f, 0.f, 0.f, 0.f};
#pragma unroll
                for (int ks = 0; ks < 4; ++ks) { const bf16x8 Kf = *(const bf16x8*)(Ks + (kt * 16 + fr) * 136 + ks * 32 + fq * 8);
                    S[kt][0] = __builtin_amdgcn_mfma_f32_16x16x32_bf16(Kf, Qf[0][ks], S[kt][0], 0, 0, 0); S[kt][1] = __builtin_amdgcn_mfma_f32_16x16x32_bf16(Kf, Qf[1][ks], S[kt][1], 0, 0, 0); } }
#pragma unroll
            for (int qt = 0; qt < 2; ++qt) {
                const int qp = q0 + qh * 32 + qt * 16 + fr; float mx = -1e30f;
#pragma unroll
                for (int kt = 0; kt < 4; ++kt)
#pragma unroll
                    for (int e = 0; e < 4; ++e) { float sv = S[kt][qt][e] * scale; if (local) { const int dlt = kp0 + kt * 16 + 4 * fq + e - qp; if (dlt > 128 || dlt < -128) sv = -1e30f; } S[kt][qt][e] = sv; mx = fmaxf(mx, sv); }
                mx = fmaxf(mx, __shfl_xor(mx, 16)); mx = fmaxf(mx, __shfl_xor(mx, 32));
                const float mnew = fmaxf(mrun[qt], mx), alpha = __expf(mrun[qt] - mnew); mrun[qt] = mnew;
                float ps = 0.f;
#pragma unroll
                for (int kt = 0; kt < 4; ++kt)
#pragma unroll
                    for (int e = 0; e < 4; ++e) { const float pv = __expf(S[kt][qt][e] - mnew); S[kt][qt][e] = pv; ps += pv; }
                lsum[qt] = lsum[qt] * alpha + ps;
#pragma unroll
                for (int dt = 0; dt < 8; ++dt) O[dt][qt] *= alpha;
            }
#pragma unroll
            for (int kg = 0; kg < 2; ++kg) {
                bf16x8 Pf[2];
#pragma unroll
                for (int qt = 0; qt < 2; ++qt) { const uint4 w = make_uint4(pk2(S[2 * kg][qt][0], S[2 * kg][qt][1]), pk2(S[2 * kg][qt][2], S[2 * kg][qt][3]), pk2(S[2 * kg + 1][qt][0], S[2 * kg + 1][qt][1]), pk2(S[2 * kg + 1][qt][2], S[2 * kg + 1][qt][3])); Pf[qt] = *(const bf16x8*)&w; }
#pragma unroll
                for (int dt = 0; dt < 8; ++dt) {
                    const uint2 lo = *(const uint2*)(Vs + (dt * 16 + fr) * 68 + kg * 32 + 4 * fq), hi = *(const uint2*)(Vs + (dt * 16 + fr) * 68 + kg * 32 + 16 + 4 * fq);
                    const uint4 w = make_uint4(lo.x, lo.y, hi.x, hi.y); const bf16x8 Vf = *(const bf16x8*)&w;
                    O[dt][0] = __builtin_amdgcn_mfma_f32_16x16x32_bf16(Vf, Pf[0], O[dt][0], 0, 0, 0); O[dt][1] = __builtin_amdgcn_mfma_f32_16x16x32_bf16(Vf, Pf[1], O[dt][1], 0, 0, 0);
                }
            }
        }
#pragma unroll
        for (int qt = 0; qt < 2; ++qt) {
            float lt = lsum[qt]; lt += __shfl_xor(lt, 16); lt += __shfl_xor(lt, 32); const float inv = 1.0f / lt;
            bf16_t* d = p.at + (size_t)(rowbase + q0 + qh * 32 + qt * 16 + fr) * 1024 + hq * 128 + 4 * fq;
#pragma unroll
            for (int dt = 0; dt < 8; ++dt) { const f32x4 o = O[dt][qt] * inv; *(uint2*)(d + dt * 16) = make_uint2(pk2(o[0], o[1]), pk2(o[2], o[3])); }
        }
    }
    __syncthreads();
}

__device__ __forceinline__ void ld8(const bf16_t* ptr, float (&o)[8]) { const uint4 w = *(const uint4*)ptr; o[0] = lo_bf(w.x); o[1] = hi_bf(w.x); o[2] = lo_bf(w.y); o[3] = hi_bf(w.y); o[4] = lo_bf(w.z); o[5] = hi_bf(w.z); o[6] = lo_bf(w.w); o[7] = hi_bf(w.w); }
__device__ __forceinline__ void ld8f(const float* ptr, float (&o)[8]) { const float4 a = *(const float4*)ptr, b = *(const float4*)(ptr + 4); o[0] = a.x; o[1] = a.y; o[2] = a.z; o[3] = a.w; o[4] = b.x; o[5] = b.y; o[6] = b.z; o[7] = b.w; }
__device__ __forceinline__ void st8(bf16_t* ptr, const float (&o)[8]) { *(uint4*)ptr = make_uint4(pk2(o[0], o[1]), pk2(o[2], o[3]), pk2(o[4], o[5]), pk2(o[6], o[7])); }
__device__ __forceinline__ void smix8(const bf16_t* bp, bool hp, bool hn, const float* m0, const float* m1, float (&o)[8]) {
    float x[8], pv[8], nv[8], a[8], b[8]; ld8(bp, x); ld8f(m0, a); ld8f(m1, b);
    if (hp) ld8(bp - 2048, pv); else {
#pragma unroll
        for (int e = 0; e < 8; ++e) pv[e] = 0.f; }
    if (hn) ld8(bp + 2048, nv); else {
#pragma unroll
        for (int e = 0; e < 8; ++e) nv[e] = 0.f; }
#pragma unroll
    for (int e = 0; e < 8; ++e) o[e] = x[e] + a[e] * (pv[e] - x[e]) + b[e] * (nv[e] - x[e]);
}
__device__ __forceinline__ void fin_phase(const Params& p, int l, bf16_t* cat) {
    const int wave = otid() >> 6, lane = otid() & 63;
    const float* mu0 = p.mu + (size_t)l * 2 * 1920; const float* mu1 = mu0 + 1920;
#pragma unroll 1
    for (int row = blockIdx.x * 8 + wave; row < MT; row += gridDim.x * 8) {
        int t, L; seq_of(row, t, L); const bool hp = t > 0, hn = t < L - 1;
        bf16_t* co = cat + (size_t)row * 2048;
        {
            float v[8], g[8]; ld8(p.fo + (size_t)row * 512 + lane * 8, v); ld8f(p.f_g + l * 512 + lane * 8, g);
            float ss = 0.f;
#pragma unroll
            for (int e = 0; e < 8; ++e) ss += v[e] * v[e];
            ss = wave_sum(ss); const float rs = rsqrtf(ss * (1.0f / 512.0f) + 1e-6f);
#pragma unroll
            for (int e = 0; e < 8; ++e) v[e] = v[e] * rs * g[e];
            st8(co + lane * 8, v);
        }
        __builtin_amdgcn_sched_barrier(0);
        {
            float v0[8], v1[8], g0[8], g1[8]; ld8(p.at + (size_t)row * 1024 + lane * 16, v0); ld8(p.at + (size_t)row * 1024 + lane * 16 + 8, v1); ld8f(p.a_g + l * 1024 + lane * 16, g0); ld8f(p.a_g + l * 1024 + lane * 16 + 8, g1);
            float ss = 0.f;
#pragma unroll
            for (int e = 0; e < 8; ++e) ss += v0[e] * v0[e] + v1[e] * v1[e];
            ss = wave_sum(ss); const float rs = rsqrtf(ss * (1.0f / 1024.0f) + 1e-6f);
#pragma unroll
            for (int e = 0; e < 8; ++e) { v0[e] = v0[e] * rs * g0[e]; v1[e] = v1[e] * rs * g1[e]; }
            st8(co + 1024 + lane * 16, v0); st8(co + 1024 + lane * 16 + 8, v1);
        }
        __builtin_amdgcn_sched_barrier(0);
        {
            const int col = lane * 8;
            const bf16_t* bp = p.rw + (size_t)row * 2048 + col;
            float bs = 0.f;
            {   float r[8], k[8], a0[8], a1[8], kav[8], rkv[8];
                smix8(bp, hp, hn, mu0 + col, mu1 + col, r); smix8(bp + 512, hp, hn, mu0 + 640 + col, mu1 + 640 + col, k);
                ld8(p.aa + (size_t)row * 512 + col, a0); ld8(p.aa + ((size_t)MT + row) * 512 + col, a1); ld8f(p.ka + l * 512 + col, kav); ld8f(p.rk + l * 512 + col, rkv);
#pragma unroll
                for (int e = 0; e < 8; ++e) { const float kd = k[e] * (2.0f + (a0[e] + a1[e] - 2.0f) * kav[e]); bs += r[e] * kd * rkv[e]; }
                bs += __shfl_xor(bs, 1); bs += __shfl_xor(bs, 2); bs += __shfl_xor(bs, 4); }
            __builtin_amdgcn_sched_barrier(0);
            float y0[8];
            {   float y1[8]; ld8(p.y + (size_t)row * 512 + col, y0); ld8(p.y + ((size_t)MT + row) * 512 + col, y1);
                float sm = 0.f;
#pragma unroll
                for (int e = 0; e < 8; ++e) { y0[e] += y1[e]; sm += y0[e]; }
                sm += __shfl_xor(sm, 1); sm += __shfl_xor(sm, 2); sm += __shfl_xor(sm, 4);
                const float mean = sm * (1.0f / 64.0f); float vs = 0.f;
#pragma unroll
                for (int e = 0; e < 8; ++e) { y0[e] -= mean; vs += y0[e] * y0[e]; }
                vs += __shfl_xor(vs, 1); vs += __shfl_xor(vs, 2); vs += __shfl_xor(vs, 4);
                const float rs = rsqrtf(vs * (1.0f / 64.0f) + 64e-5f);
#pragma unroll
                for (int e = 0; e < 8; ++e) y0[e] *= rs; }
            __builtin_amdgcn_sched_barrier(0);
            {   float v[8], lw[8], lb[8], gv[8], o[8];
                smix8(bp + 1024, hp, hn, mu0 + 1152 + col, mu1 + 1152 + col, v);
                ld8f(p.lnx_w + l * 512 + col, lw); ld8f(p.lnx_b + l * 512 + col, lb); ld8(p.gg + (size_t)row * 512 + col, gv);
#pragma unroll
                for (int e = 0; e < 8; ++e) o[e] = (y0[e] * lw[e] + lb[e] + bs * v[e]) * gv[e];
                st8(co + 512 + col, o); }
        }
        __builtin_amdgcn_sched_barrier(0);
    }
}

__device__ __forceinline__ void conv_phase(const Params& p, int l, int r0, int Mp) {
    const float* cw = p.conv_w + (size_t)l * 3 * DFF; const float* cb = p.conv_b + (size_t)l * DFF;
#pragma unroll 1
    for (int idx = blockIdx.x * 512 + otid(); idx < Mp * 704; idx += gridDim.x * 512) {
        const int rl = idx / 704, ch = (idx % 704) * 8; int t, L; seq_of(r0 + rl, t, L);
        const bf16_t* hp_ = p.h + (size_t)rl * 11264 + ch;
        float x[8], pv[8], nv[8], up[8], w0[8], w1[8], w2[8], bb[8], o[8];
        ld8(hp_, x); ld8(hp_ + DFF, up); ld8f(cw + ch, w0); ld8f(cw + DFF + ch, w1); ld8f(cw + 2 * DFF + ch, w2); ld8f(cb + ch, bb);
        if (t > 0) ld8(hp_ - 11264, pv); else {
#pragma unroll
            for (int e = 0; e < 8; ++e) pv[e] = 0.f; }
        if (t < L - 1) ld8(hp_ + 11264, nv); else {
#pragma unroll
            for (int e = 0; e < 8; ++e) nv[e] = 0.f; }
#pragma unroll
        for (int e = 0; e < 8; ++e) { const float gt = pv[e] * w0[e] + x[e] * w1[e] + nv[e] * w2[e] + bb[e]; o[e] = 0.5f * gt * (1.0f + erff(gt * 0.70710678118f)) * up[e]; }
        st8(p.act + (size_t)rl * DFF + ch, o);
    }
}

__device__ __forceinline__ void final_norm(const Params& p) {
    const int wave = otid() >> 6, lane = otid() & 63;
#pragma unroll 1
    for (int row = blockIdx.x * 8 + wave; row < ML; row += gridDim.x * 8) {
        float4* src = (float4*)(p.out + (size_t)row * 2048);
        float4 v[8]; float ss = 0.f;
#pragma unroll
        for (int i = 0; i < 8; ++i) { v[i] = src[lane + 64 * i]; ss += v[i].x * v[i].x + v[i].y * v[i].y + v[i].z * v[i].z + v[i].w * v[i].w; }
        ss = wave_sum(ss); const float rs = rsqrtf(ss * (1.0f / 2048.0f) + 1e-6f);
        const float4* g4 = (const float4*)p.final_g;
#pragma unroll
        for (int i = 0; i < 8; ++i) { const float4 g = g4[lane + 64 * i]; src[lane + 64 * i] = make_float4(v[i].x * rs * g.x, v[i].y * rs * g.y, v[i].z * rs * g.z, v[i].w * rs * g.w); }
    }
}

#define LDS_BYTES (131072 + 256)
#define GBAR() xcd_barrier(bar)
__device__ __forceinline__ int opq(int v) { asm volatile("" : "+s"(v)); return v; }
__global__ void __launch_bounds__(512, 2) hymba_fwd(Params p) {
    extern __shared__ __attribute__((aligned(16))) unsigned char shm[];
    PG8_LAS unsigned char* lds = (PG8_LAS unsigned char*)shm;
    volatile LAS unsigned* st = (volatile LAS unsigned*)(lds + 131072);
    if (threadIdx.x == 0) { st[0] = 0u; st[1] = 0u; st[2] = 0u; st[3] = 0u; }
    __syncthreads();
    XcdBarrier bar = xcd_barrier_post(p.bar, st);
    const int G = gridDim.x, bid = blockIdx.x;
#ifndef SK_PRO
    prologue(p, shm);
#endif
    GBAR();
#pragma unroll 1
    for (int l = 0; l < 4; ++l) {
        const float* modl = p.mod + (size_t)l * MODL;
        const float* xl_in = l == 0 ? p.x : p.out; const float* xc_in = l == 0 ? p.ctx : p.xc;
#ifndef SK_NORM
        norm_mod(xl_in, xc_in, p.norm1_g + l * 2048, modl, 0, 2048, p.u);
#endif
        GBAR();
        { EpiIn E; E.q = p.q; E.ak = p.ak; E.vt = p.vt; E.vtc = p.vtc; E.rw = p.rw; E.ft = p.ft; E.ftc = p.ftc; E.rope = p.rope;
          StaticOrder S; S.init(opq(MT), opq(NIN), G, bid); Gemm g; g.A = p.u; g.Bt = p.wt_in + (size_t)l * NIN * 2048; g.M = opq(MT); g.N = opq(NIN); g.K = opq(2048);

#ifndef SK_GIN
          pg8::gemm_phase<EpiIn, StaticOrder, false>(lds, g, S, E, nullptr);
#endif
 }
        GBAR();
#ifndef SK_PREP
        prep_phase(p, l);
#endif
        GBAR();
        { EpiLR E; E.dec = p.dec; E.aa = p.aa; E.gg = p.gg; E.w0 = p.w0 + l * 1024; E.a0 = p.a0 + l * 1024;
          StaticOrder S; S.init(opq(MT), opq(2560), G, bid); Gemm g; g.A = p.a2b; g.Bt = p.wt_lr + (size_t)l * 2560 * 384; g.M = opq(MT); g.N = opq(2560); g.K = opq(384);

#ifndef SK_GLR
          pg8::gemm_phase<EpiLR, StaticOrder, false>(lds, g, S, E, nullptr);
#endif
 }
        __syncthreads();
        { EpiFO E; E.fo = p.fo; E.base = 0; E.seqlen = 4096;
          StaticOrder S; S.init(opq(4096), opq(4096), G, bid); Gemm g; g.A = p.wf; g.Bt = p.ft; g.M = opq(4096); g.N = opq(4096); g.K = opq(8192);

#ifndef SK_GFO
          pg8::gemm_phase<EpiFO, StaticOrder, false>(lds, g, S, E, nullptr);
#endif
 }
        __syncthreads();
        { EpiFO E; E.fo = p.fo; E.base = ML; E.seqlen = 256;
          StaticOrder S; S.init(opq(256), opq(4096), G, bid); Gemm g; g.A = p.wfc; g.Bt = p.ftc; g.M = opq(256); g.N = opq(4096); g.K = opq(512);

#ifndef SK_GFO
          pg8::gemm_phase<EpiFO, StaticOrder, false>(lds, g, S, E, nullptr);
#endif
 }
        __syncthreads();
#ifndef SK_ATT
        attn_phase(p, l, shm);
#endif
        GBAR();
#ifndef SK_SCAN
        scan_phase(p, l, shm);
#endif
        GBAR();
#ifndef SK_FIN
        fin_phase(p, l, p.u);
#endif
        GBAR();
        { EpiRes E; E.xl_in = xl_in; E.xc_in = xc_in; E.xl_out = p.out; E.xc_out = p.xc; E.ga = modl + 4096; E.row_off = 0;
          StaticOrder S; S.init(opq(MT), opq(2048), G, bid); Gemm g; g.A = p.u; g.Bt = p.wt_out + (size_t)l * 2048 * 2048; g.M = opq(MT); g.N = opq(2048); g.K = opq(2048);

#ifndef SK_GRES
          pg8::gemm_phase<EpiRes, StaticOrder, false>(lds, g, S, E, nullptr);
#endif
 }
        GBAR();
        norm_mod(p.out, p.xc, p.norm2_g + l * 2048, modl, 6144, 8192, p.u);
        GBAR();
#pragma unroll 1
        for (int part = 0; part < 2; ++part) {
            const int r0 = part ? 16384 : 0, Mp = part ? 18432 : 16384;
            { EpiH E; E.o = p.h; E.ld = 11264;
              StaticOrder S; S.init(opq(Mp), opq(11264), G, bid); Gemm g; g.A = p.u + (size_t)r0 * 2048; g.Bt = p.wt_f1 + (size_t)l * 11264 * 2048; g.M = opq(Mp); g.N = opq(11264); g.K = opq(2048);

#ifndef SK_GH
              pg8::gemm_phase<EpiH, StaticOrder, false>(lds, g, S, E, nullptr);
#endif
 }
            GBAR();
#ifndef SK_CONV
            conv_phase(p, l, r0, Mp);
#endif
            GBAR();
            { EpiRes E; E.xl_in = p.out; E.xc_in = p.xc; E.xl_out = p.out; E.xc_out = p.xc; E.ga = modl + 10240; E.row_off = r0;
              StaticOrder S; S.init(opq(Mp), opq(2048), G, bid); Gemm g; g.A = p.act; g.Bt = p.wt_f2 + (size_t)l * 2048 * DFF; g.M = opq(Mp); g.N = opq(2048); g.K = opq(DFF);

#ifndef SK_GRES
          pg8::gemm_phase<EpiRes, StaticOrder, false>(lds, g, S, E, nullptr);
#endif
 }
            GBAR();
        }
    }
    final_norm(p);
}

extern "C" void kernel_launch(void* const* d_in, const int* in_sizes, int n_in, void* d_out, int out_size, void* d_ws, size_t ws_size, hipStream_t stream) {
    (void)in_sizes; (void)n_in; (void)out_size; (void)ws_size;
    Params p{};
    const float** pf = (const float**)&p;
    for (int i = 0; i < 29; ++i) pf[i] = (const float*)d_in[i];
    p.out = (float*)d_out;
    char* w = (char*)d_ws; size_t off = 0;
    auto take = [&](size_t bytes) { char* r = w + off; off += (bytes + 255) & ~(size_t)255; return r; };
    p.bar = (unsigned*)take(XCD_BAR_WORDS * 4);
    p.mod = (float*)take((size_t)4 * MODL * 4);
    p.rope = (float*)take((size_t)4096 * 64 * 2 * 4);
    p.xc = (float*)take((size_t)2048 * 2048 * 4);
    p.wt_in = (bf16_t*)take((size_t)4 * NIN * 2048 * 2);
    p.wt_out = (bf16_t*)take((size_t)4 * 2048 * 2048 * 2);
    p.wt_f1 = (bf16_t*)take((size_t)4 * 11264 * 2048 * 2);
    p.wt_f2 = (bf16_t*)take((size_t)4 * 2048 * DFF * 2);
    p.wt_lr = (bf16_t*)take((size_t)4 * 2560 * 384 * 2);
    p.wf = (bf16_t*)take((size_t)4096 * 8192 * 2);
    p.wfc = (bf16_t*)take((size_t)256 * 512 * 2);
    p.u = (bf16_t*)take((size_t)MT * 2048 * 2);
    const size_t mix0 = off;
    p.q = (bf16_t*)take((size_t)MT * 1024 * 2);
    p.ak = (bf16_t*)take((size_t)MT * 256 * 2);
    p.vt = (bf16_t*)take((size_t)8 * 256 * 4096 * 2);
    p.vtc = (bf16_t*)take((size_t)8 * 256 * 256 * 2);
    p.rw = (bf16_t*)take((size_t)MT * 2048 * 2);
    p.ft = (bf16_t*)take((size_t)8 * 512 * 8192 * 2);
    p.ftc = (bf16_t*)take((size_t)8 * 512 * 512 * 2);
    p.dec = (bf16_t*)take((size_t)2 * MT * 512 * 2);
    p.aa = (bf16_t*)take((size_t)2 * MT * 512 * 2);
    p.gg = (bf16_t*)take((size_t)MT * 512 * 2);
    p.y = (bf16_t*)take((size_t)2 * MT * 512 * 2);
    p.a2b = p.y;
    p.fo = (bf16_t*)take((size_t)MT * 512 * 2);
    p.at = (bf16_t*)take((size_t)MT * 1024 * 2);
    p.h = (bf16_t*)(w + mix0);
    p.act = p.h + (size_t)18432 * 11264;
    static int grid = 0;
    if (!grid) {
        int dev = 0, cus = 0, per_cu = 0;
        hipGetDevice(&dev); hipDeviceGetAttribute(&cus, hipDeviceAttributeMultiprocessorCount, dev);
        if (hipFuncSetAttribute((const void*)hymba_fwd, hipFuncAttributeMaxDynamicSharedMemorySize, LDS_BYTES) != hipSuccess) fprintf(stderr, "hipFuncSetAttribute failed\n");
        if (hipOccupancyMaxActiveBlocksPerMultiprocessor(&per_cu, (const void*)hymba_fwd, 512, LDS_BYTES) != hipSuccess || per_cu < 1) { fprintf(stderr, "occupancy query failed\n"); per_cu = 1; }
        grid = cus > 0 ? cus : 256;
    }
    hipMemsetAsync(p.bar, 0, XCD_BAR_WORDS * 4, stream);
    hipLaunchKernelGGL(hymba_fwd, dim3(grid), dim3(512), LDS_BYTES, stream, p);
}
```

```cpp
#include <hip/hip_runtime.h>
#include <stdint.h>
#include <stdio.h>
#define XB_TMO      128
#define XB_XCNT(j)  (256  + 64 * (j))
#define XB_XSUB(j)  (1280 + 64 * (j))
#define XB_XGEN(j)  (2304 + 64 * (j))
#define XB_TOP      3328
#define XB_TOPGEN   3392
#define XCD_BAR_WORDS 3456
#define XB_SPIN_CAP (1u << 18)
#define LAS __attribute__((address_space(3)))

__device__ __forceinline__ unsigned xb_ld(unsigned* p)              { return __hip_atomic_load(p, __ATOMIC_RELAXED, __HIP_MEMORY_SCOPE_AGENT); }
__device__ __forceinline__ unsigned xb_add(unsigned* p, unsigned v) { return __hip_atomic_fetch_add(p, v, __ATOMIC_RELAXED, __HIP_MEMORY_SCOPE_AGENT); }
__device__ __forceinline__ unsigned xb_xcc_id() { return (unsigned)__builtin_amdgcn_s_getreg((3 << 11) | 20) & 0xFu; }
#define XB_SPIN(cond, bar) do { unsigned _sp = 0; while (cond) { __builtin_amdgcn_s_sleep(1); \
    if ((++_sp & 255u) == 0u) { if (xb_ld(&(bar)[XB_TMO])) break; if (_sp > XB_SPIN_CAP) { atomicAdd(&(bar)[XB_TMO], 1u); break; } } } } while (0)

struct XcdBarrier {
    unsigned* bar; unsigned x;
    volatile LAS unsigned* st;
};

__device__ __forceinline__ XcdBarrier xcd_barrier_post(unsigned* bar, volatile LAS unsigned* st) {
    XcdBarrier b; b.bar = bar; b.x = xb_xcc_id(); b.st = st;
    if (threadIdx.x == 0) (void)xb_add(&bar[XB_XCNT(b.x)], 1u);
    return b;
}
__device__ __forceinline__ void xcd_barrier_complete(unsigned* bar, unsigned x, unsigned& nloc, unsigned& nx) {
    const unsigned G = gridDim.x * gridDim.y * gridDim.z;
    unsigned sum, cnt, mine, sp = 0u;
    for (;;) {
        sum = 0u; cnt = 0u; mine = 0u;
#pragma unroll
        for (unsigned j = 0; j < 16; ++j) { const unsigned c = xb_ld(&bar[XB_XCNT(j)]); sum += c; cnt += (c > 0u) ? 1u : 0u; mine = (j == x) ? c : mine; }
        if (sum == G) break;
        __builtin_amdgcn_s_sleep(1);
        if ((++sp & 255u) == 0u) { if (xb_ld(&bar[XB_TMO])) break; if (sp > XB_SPIN_CAP) { atomicAdd(&bar[XB_TMO], 1u); break; } }
    }
    nloc = mine > 0u ? mine : 1u; nx = cnt > 0u ? cnt : 1u;
}

__device__ __forceinline__ void xcd_barrier(const XcdBarrier& b) {
    asm volatile("s_waitcnt vmcnt(0)" ::: "memory");
    __syncthreads();
    if (threadIdx.x == 0) {
        unsigned* bar = b.bar;
        __builtin_amdgcn_s_waitcnt(0);
        unsigned nloc = b.st[0], nx = b.st[1];
        if (nloc == 0u) { xcd_barrier_complete(bar, b.x, nloc, nx); b.st[0] = nloc; b.st[1] = nx; }
        const unsigned old = xb_add(&bar[XB_XSUB(b.x)], 1u);
        const unsigned gen = old / nloc;
        if (old + 1u == (gen + 1u) * nloc) {
            __builtin_amdgcn_fence(__ATOMIC_RELEASE, "agent");
            asm volatile("s_waitcnt vmcnt(0)" ::: "memory");
            const unsigned og = xb_add(&bar[XB_TOP], 1u);
            const unsigned tg = og / nx;
            if (og + 1u == (tg + 1u) * nx) xb_add(&bar[XB_TOPGEN], 1u);
            else XB_SPIN(xb_ld(&bar[XB_TOPGEN]) == tg, bar);
            __builtin_amdgcn_fence(__ATOMIC_ACQUIRE, "agent");
            xb_add(&bar[XB_XGEN(b.x)], 1u);
            asm volatile("s_waitcnt vmcnt(0)" ::: "memory");
        } else {
            XB_SPIN(xb_ld(&bar[XB_XGEN(b.x)]) == gen, bar);
            __builtin_amdgcn_fence(__ATOMIC_ACQUIRE, "agent");
            asm volatile("s_waitcnt vmcnt(0)" ::: "memory");
        }
    }
    __syncthreads();
}

namespace pg8 {
#define PG8_LAS __attribute__((address_space(3)))
typedef unsigned short bf16_t;
typedef short bf16x8 __attribute__((ext_vector_type(8)));
typedef float f32x4 __attribute__((ext_vector_type(4)));
typedef unsigned u32x4 __attribute__((ext_vector_type(4)));
constexpr int BM = 256, BK = 64, HALF = 128, HTB = HALF * BK * 2  , STAGE_BYTES = 8 * HTB, NXCD = 8, WGM = 8;

__host__ __device__ __forceinline__ int lds_byte(int r, int c) { const int st = (r >> 4) * 2 + (c >> 5), rr = r & 15, cc = c & 31, ob = rr * 64 + cc * 2; return st * 1024 + (ob ^ (((ob >> 9) & 1) << 5)); }
__host__ __device__ __forceinline__ void stage_rc(int b, int& R, int& C) { const int st = b / 1024, sb = b % 1024, swz = sb ^ (((sb >> 9) & 1) << 5); R = (st >> 1) * 16 + swz / 64; C = (st & 1) * 32 + (swz % 64) / 2; }
__host__ __device__ __forceinline__ int perm32(int rho) { const int n = rho >> 4, i = rho & 15; return 8 * (i >> 2) + 4 * n + (i & 3); }

struct Unit { int pm, pn; };
struct Gemm { const bf16_t* A; const bf16_t* Bt; int M, N, K; };

struct StaticOrder {
    int nM, nN, nwg, G, c;
    __host__ __device__ void init(int M, int N, int G_, int c_) { nM = M / BM; nN = N / BM; nwg = nM * nN; G = G_; c = c_; }
    __host__ __device__ bool next(int i, Unit& u) const {
        const long L = (long)i * G + c; if (L >= nwg) return false;
        int wgid = (int)L; { const int q = nwg / NXCD, r = nwg % NXCD, xcd = wgid % NXCD, off = wgid / NXCD; wgid = (xcd < r ? xcd * (q + 1) : r * (q + 1) + (xcd - r) * q) + off; }
        const int nig = WGM * nN, gid = wgid / nig, fm = gid * WGM, gsz = (nM - fm) < WGM ? (nM - fm) : WGM;
        u.pm = fm + ((wgid % nig) % gsz); u.pn = (wgid % nig) / gsz; return true;
    }
    __device__ __forceinline__ void a_ready(const Unit&) const {}
    __device__ __forceinline__ void done(const Unit&) const {}
};
__device__ __forceinline__ unsigned cvt_pk_bf16(float lo, float hi) { unsigned r; asm volatile("v_cvt_pk_bf16_f32 %0, %1, %2" : "=v"(r) : "v"(lo), "v"(hi)); return r; }
typedef float f32x2 __attribute__((ext_vector_type(2)));
__device__ __forceinline__ f32x2 gelu_pk(f32x2 v) {
    const f32x2 av = __builtin_elementwise_abs(v), d = av * 0.2316418882f + 1.0f;
    f32x2 t; t.x = __builtin_amdgcn_rcpf(d.x); t.y = __builtin_amdgcn_rcpf(d.y);
    f32x2 q = t * 0.5307027145f + (-0.7265760135f); q = q * t + 0.7107068705f; q = q * t + (-0.142248368f); q = q * t + 0.127414796f; q = q * t;
    const f32x2 s = (v * v) * (-0.72134752044f);
    f32x2 e; e.x = __builtin_amdgcn_exp2f(s.x); e.y = __builtin_amdgcn_exp2f(s.y);
    const f32x2 m = v * (q * e), r = v - m;
    f32x2 o; o.x = v.x < 0.f ? m.x : r.x; o.y = v.y < 0.f ? m.y : r.y; return o;
}

template <class Epi, class Sched, bool STAMP = false>
__device__ __forceinline__ void gemm_phase(PG8_LAS unsigned char* lds, const Gemm g, const Sched& S, const Epi& E, unsigned long long* stamps) {
    int tid_ = threadIdx.x; asm volatile("" : "+v"(tid_));
    const int tid = tid_, wid = __builtin_amdgcn_readfirstlane(tid >> 6), lane = tid & 63, wr = wid >> 2, wc = wid & 3, fr = lane & 15, fq = lane >> 4;
    const int K = g.K, nt = K / BK;
    int ts_lo = 0, ts_hi = 0, nts = 0; const unsigned long long rt_entry = STAMP ? (unsigned long long)wall_clock64() : 0ull;
#define PG8_STAMP() do { if (STAMP && wid == 0 && nts < 64) { const unsigned long long _c = (unsigned long long)clock64(); \
        ts_lo = (lane == nts) ? (int)(unsigned)_c : ts_lo; ts_hi = (lane == nts) ? (int)(unsigned)(_c >> 32) : ts_hi; ++nts; } } while (0)
    PG8_STAMP();
    unsigned voffA[2], voffB[2];
#pragma unroll
    for (int i = 0; i < 2; ++i) { int R, C; stage_rc(tid * 16 + i * 8192, R, C); const int Rb = Epi::PERM ? ((R & ~31) + perm32(R & 31)) : R;
        voffA[i] = (unsigned)(R * K + C) * 2u; voffB[i] = (unsigned)(Rb * K + C) * 2u; }
    const size_t kstep = (size_t)(BK * 2);
    const size_t hstep = (size_t)HALF * K * 2;
    const size_t tstep = 2 * hstep;
    const unsigned ldsw = (unsigned)wid * 1024u;
    const int aoff = lds_byte(wr * 64 + fr, fq * 8), boff = lds_byte(wc * 32 + fr, fq * 8);
#define PG8_SA(b, h) (((b) * 2 + (h)) * HTB)
#define PG8_SB(b, h) ((4 + (b) * 2 + (h)) * HTB)
#define PG8_STAGE(bufoff, gbase, voff) do { _Pragma("unroll") for (int _i = 0; _i < 2; ++_i) \
        __builtin_amdgcn_global_load_lds((const unsigned*)((const char*)(gbase) + (voff)[_i]), (PG8_LAS unsigned*)(lds + (bufoff) + ldsw + _i * 8192), 16, 0, 0); } while (0)
#define PG8_LDA(dst, b, h) do { _Pragma("unroll") for (int m = 0; m < 4; ++m) _Pragma("unroll") for (int k = 0; k < 2; ++k) dst[m][k] = *(const PG8_LAS bf16x8*)(lds + PG8_SA(b, h) + aoff + m * 2048 + k * 1024); } while (0)
#define PG8_LDB(dst, b, h) do { _Pragma("unroll") for (int n = 0; n < 2; ++n) _Pragma("unroll") for (int k = 0; k < 2; ++k) dst[n][k] = *(const PG8_LAS bf16x8*)(lds + PG8_SB(b, h) + boff + n * 2048 + k * 1024); } while (0)
#define PG8_MMA(ai, bj, At, Bt) do { __builtin_amdgcn_s_setprio(1); _Pragma("unroll") for (int m = 0; m < 4; ++m) _Pragma("unroll") for (int n = 0; n < 2; ++n) _Pragma("unroll") for (int k = 0; k < 2; ++k) \
        acc[ai][bj][m][n] = __builtin_amdgcn_mfma_f32_16x16x32_bf16(Bt[n][k], At[m][k], acc[ai][bj][m][n], 0, 0, 0); __builtin_amdgcn_s_setprio(0); } while (0)
#define PG8_WAIT_V(n) asm volatile("s_waitcnt vmcnt(" #n ")" ::: "memory")
#define PG8_WAIT_L(n) asm volatile("s_waitcnt lgkmcnt(" #n ")" ::: "memory")
#define PG8_BAR __builtin_amdgcn_s_barrier()
#define PG8_SCHED __builtin_amdgcn_sched_barrier(0)
    Unit cur, nxt; int ui = 0;
    if (!S.next(0, cur)) return;
    f32x4 acc[2][2][4][2];
#pragma unroll
    for (int a = 0; a < 2; ++a)
#pragma unroll
        for (int b = 0; b < 2; ++b)
#pragma unroll
            for (int m = 0; m < 4; ++m)
#pragma unroll
                for (int n = 0; n < 2; ++n) acc[a][b][m][n] = (f32x4){0.f, 0.f, 0.f, 0.f};
    bf16x8 At[4][2], B0[2][2], B1[2][2];
    const char* cA = (const char*)g.A + (size_t)cur.pm * tstep; const char* cB = (const char*)g.Bt + (size_t)cur.pn * tstep;
    S.a_ready(cur);
    PG8_STAGE(PG8_SB(0, 0), cB, voffB); PG8_STAGE(PG8_SA(0, 0), cA, voffA); PG8_STAGE(PG8_SB(0, 1), cB + hstep, voffB); PG8_STAGE(PG8_SA(0, 1), cA + hstep, voffA);
    if (wr == 1) PG8_BAR;
    PG8_WAIT_V(4); PG8_BAR;
    PG8_STAGE(PG8_SB(1, 0), cB + kstep, voffB); PG8_STAGE(PG8_SA(1, 0), cA + kstep, voffA); PG8_STAGE(PG8_SB(1, 1), cB + hstep + kstep, voffB);
    PG8_WAIT_V(6); PG8_BAR;
    PG8_STAMP();
    for (;;) {
        const bool has_next = S.next(ui + 1, nxt);
        const char* nA = has_next ? (const char*)g.A + (size_t)nxt.pm * tstep : cA; const char* nB = has_next ? (const char*)g.Bt + (size_t)nxt.pn * tstep : cB;
        for (int t = 0; t < nt; t += 2) {
            const bool last = (t == nt - 2);
            const char* a1 = cA + (size_t)(t + 1) * kstep;
            const char* a2 = last ? nA : cA + (size_t)(t + 2) * kstep; const char* b2 = last ? nB : cB + (size_t)(t + 2) * kstep;
            const char* a3 = a2 + kstep; const char* b3 = b2 + kstep;
            if (last && has_next) S.a_ready(nxt);
            PG8_LDB(B0, 0, 0); PG8_SCHED; PG8_LDA(At, 0, 0); PG8_STAGE(PG8_SA(1, 1), a1 + hstep, voffA);
            PG8_WAIT_L(8); PG8_BAR; PG8_WAIT_L(0); PG8_MMA(0, 0, At, B0); PG8_BAR; PG8_SCHED;
            PG8_LDB(B1, 0, 1); PG8_STAGE(PG8_SB(0, 0), b2, voffB);
            PG8_BAR; PG8_WAIT_L(0); PG8_MMA(0, 1, At, B1); PG8_BAR;
            PG8_LDA(At, 0, 1); PG8_STAGE(PG8_SA(0, 0), a2, voffA);
            PG8_BAR; PG8_WAIT_L(0); PG8_MMA(1, 0, At, B0); PG8_BAR; PG8_SCHED;
            PG8_STAGE(PG8_SB(0, 1), b2 + hstep, voffB);
            PG8_WAIT_V(6); PG8_BAR; PG8_MMA(1, 1, At, B1); PG8_BAR;
            PG8_LDB(B0, 1, 0); PG8_SCHED; PG8_LDA(At, 1, 0); PG8_STAGE(PG8_SA(0, 1), a2 + hstep, voffA);
            PG8_WAIT_L(8); PG8_BAR; PG8_WAIT_L(0); PG8_MMA(0, 0, At, B0); PG8_BAR; PG8_SCHED;
            PG8_LDB(B1, 1, 1); PG8_STAGE(PG8_SB(1, 0), b3, voffB);
            PG8_BAR; PG8_WAIT_L(0); PG8_MMA(0, 1, At, B1); PG8_BAR;
            PG8_LDA(At, 1, 1); PG8_STAGE(PG8_SA(1, 0), a3, voffA);
            PG8_BAR; PG8_WAIT_L(0); PG8_MMA(1, 0, At, B0); PG8_BAR; PG8_SCHED;
            PG8_STAGE(PG8_SB(1, 1), b3 + hstep, voffB);
            PG8_WAIT_V(6); PG8_BAR; PG8_MMA(1, 1, At, B1); PG8_BAR;
        }
        PG8_STAMP();
        if constexpr (!Epi::AFTER_DRAIN) { E(acc, cur, wr, wc, fr, fq); S.done(cur); }
        PG8_STAMP();
        if (!has_next) break;
#pragma unroll
        for (int a = 0; a < 2; ++a)
#pragma unroll
            for (int b = 0; b < 2; ++b)
#pragma unroll
                for (int m = 0; m < 4; ++m)
#pragma unroll
                    for (int n = 0; n < 2; ++n) acc[a][b][m][n] = (f32x4){0.f, 0.f, 0.f, 0.f};
        cur = nxt; cA = nA; cB = nB; ++ui;
    }
    PG8_WAIT_V(0);
    if (wr == 0) PG8_BAR;
    PG8_BAR;
    if constexpr (Epi::AFTER_DRAIN) { E.fused(acc, cur, wr, wc, fr, fq, lds, wid, lane); S.done(cur); }
    PG8_STAMP();
    if (STAMP && wid == 0) { stamps[lane] = lane < nts ? (((unsigned long long)(unsigned)ts_hi << 32) | (unsigned)ts_lo) : 0ull;
        if (lane == 62) stamps[62] = rt_entry; if (lane == 63) stamps[63] = (unsigned long long)wall_clock64(); }
#undef PG8_STAMP
#undef PG8_SA
#undef PG8_SB
#undef PG8_STAGE
#undef PG8_LDA
#undef PG8_LDB
#undef PG8_MMA
#undef PG8_WAIT_V
#undef PG8_WAIT_L
#undef PG8_BAR
#undef PG8_SCHED
}
}

using pg8::bf16_t; using pg8::f32x4; using pg8::bf16x8; using pg8::Unit; using pg8::Gemm; using pg8::StaticOrder;
#define MT 34816
#define ML 32768
#define NIN 4608
#define DFF 5632
#define MODL (9 * 12288)

struct Params {
    const float *x, *c, *ctx, *c_ctx, *norm1_g, *norm2_g, *w_ada, *b_ada, *w_in, *mu, *w0, *w2, *a0, *a2, *g2, *kk_scale, *ka, *rk, *lnx_w, *lnx_b, *sink, *f_g, *a_g, *w_out, *w_ffn_in, *conv_w, *conv_b, *w_ffn_out, *final_g;
    float* out; unsigned* bar; float* mod; float* rope; float* xc;
    bf16_t *wt_in, *wt_out, *wt_f1, *wt_f2, *wt_lr, *wf, *wfc, *u, *q, *ak, *vt, *vtc, *rw, *ft, *ftc, *dec, *aa, *gg, *y, *a2b, *fo, *at, *h, *act;
};

__device__ __forceinline__ int otid() { int t = threadIdx.x; asm volatile("" : "+v"(t)); return t; }
__device__ __forceinline__ bf16_t f2bf(float f) { unsigned u = __float_as_uint(f); u += 0x7FFFu + ((u >> 16) & 1u); return (bf16_t)(u >> 16); }
__device__ __forceinline__ float bf2f(bf16_t h) { return __uint_as_float(((unsigned)h) << 16); }
__device__ __forceinline__ unsigned pk2(float a, float b) { return (unsigned)f2bf(a) | ((unsigned)f2bf(b) << 16); }
__device__ __forceinline__ float lo_bf(unsigned w) { return __uint_as_float(w << 16); }
__device__ __forceinline__ float hi_bf(unsigned w) { return __uint_as_float(w & 0xffff0000u); }
__device__ __forceinline__ float wave_sum(float v) { v += __shfl_xor(v, 32); v += __shfl_xor(v, 16); v += __shfl_xor(v, 8); v += __shfl_xor(v, 4); v += __shfl_xor(v, 2); v += __shfl_xor(v, 1); return v; }
__device__ __forceinline__ float sigmoidf_(float x) { return 1.0f / (1.0f + __expf(-x)); }
template <int CTRL> __device__ __forceinline__ float dpp_add(float x) { return x + __int_as_float(__builtin_amdgcn_update_dpp(0, __float_as_int(x), CTRL, 0xf, 0xf, true)); }
__device__ __forceinline__ float sum8(float x) { x = dpp_add<0xB1>(x); x = dpp_add<0x4E>(x); x = dpp_add<0x141>(x); return x; }

__device__ __forceinline__ int srccol_in(int n) {
    if (n < 1024) return -1;
    if (n < 2304) { const int base = n < 2048 ? 512 : 3456; const int cq = n < 2048 ? n - 1024 : n - 2048; const int head = cq >> 7, pp = cq & 127, axis = pp >> 6, i = (pp & 63) >> 1, half = pp & 1; return base + head * 128 + axis * 64 + half * 32 + i; }
    if (n < 2560) return 3712 + (n - 2304);
    if (n < 3072) return 1536 + (n - 2560);
    if (n < 3584) return 2176 + (n - 3072);
    if (n < 4096) return 2688 + (n - 3584);
    if (n < 4224) return 2048 + (n - 4096);
    if (n < 4352) return 3200 + (n - 4224);
    if (n < 4480) return 3328 + (n - 4352);
    return -1;
}
__device__ __forceinline__ void xpose_tile(const float* src, int Nsrc, bf16_t* dst, int K, int n0, int k0, int mode, float* tile) {
    const int tid = otid(), nn = tid & 63, kk = tid >> 6;
    const int sc = mode ? srccol_in(n0 + nn) : (n0 + nn);
    float v[16];
#pragma unroll
    for (int pp = 0; pp < 16; ++pp) v[pp] = sc >= 0 ? src[(size_t)(k0 + kk + 8 * pp) * Nsrc + sc] : 0.f;
#pragma unroll
    for (int pp = 0; pp < 16; ++pp) tile[(kk + 8 * pp) * 65 + nn] = v[pp];
    __syncthreads();
    const int rn = tid >> 3, kc = tid & 7;
#pragma unroll
    for (int hh = 0; hh < 2; ++hh) { const int kb = hh * 64 + kc * 8; uint4 w;
        w.x = pk2(tile[(kb + 0) * 65 + rn], tile[(kb + 1) * 65 + rn]); w.y = pk2(tile[(kb + 2) * 65 + rn], tile[(kb + 3) * 65 + rn]);
        w.z = pk2(tile[(kb + 4) * 65 + rn], tile[(kb + 5) * 65 + rn]); w.w = pk2(tile[(kb + 6) * 65 + rn], tile[(kb + 7) * 65 + rn]);
        *(uint4*)(dst + (size_t)(n0 + rn) * K + k0 + kb) = w; }
    __syncthreads();
}

__device__ __forceinline__ void prologue(const Params& p, unsigned char* shm) {
    const int tid = otid(), G = gridDim.x, bid = blockIdx.x;
    float* fl = (float*)shm;
#pragma unroll 1
    for (int it = bid; it < 4 * 5632; it += G) {
        const int l = it / 5632; int r = it % 5632;
        if (r < 896) xpose_tile(p.w_in + (size_t)l * 2048 * 3968, 3968, p.wt_in + (size_t)l * NIN * 2048, 2048, 1024 + (r >> 4) * 64, (r & 15) * 128, 1, fl);
        else if (r < 1408) { r -= 896; xpose_tile(p.w_out + (size_t)l * 2048 * 2048, 2048, p.wt_out + (size_t)l * 2048 * 2048, 2048, (r >> 4) * 64, (r & 15) * 128, 0, fl); }
        else if (r < 4224) { r -= 1408; xpose_tile(p.w_ffn_in + (size_t)l * 2048 * 11264, 11264, p.wt_f1 + (size_t)l * 11264 * 2048, 2048, (r >> 4) * 64, (r & 15) * 128, 0, fl); }
        else { r -= 4224; xpose_tile(p.w_ffn_out + (size_t)l * DFF * 2048, 2048, p.wt_f2 + (size_t)l * 2048 * DFF, DFF, (r / 44) * 64, (r % 44) * 128, 0, fl); }
    }
    {
        float* wt = fl; float* ctab = fl + 64 * 129;
        if (tid < 128) ctab[tid] = cospif((float)tid / 64.0f) * 0.08838834764831845f;
        __syncthreads();
#pragma unroll 1
        for (int it = bid; it < 512; it += G) {
            const int l = it >> 7, g = (it >> 5) & 3, k0 = (it & 31) * 64;
            const float* src = p.w_in + (size_t)l * 2048 * 3968;
#pragma unroll
            for (int pp = 0; pp < 16; ++pp) { const int idx = tid + 512 * pp, kk = idx >> 7, c = idx & 127; wt[kk * 129 + c] = src[(size_t)(k0 + kk) * 3968 + g * 128 + c]; }
            __syncthreads();
            const int cp = tid & 127, kq = tid >> 7;
            unsigned oc[8], os[8];
#pragma unroll 1
            for (int k2 = 0; k2 < 8; ++k2) {
                float c0 = 0.f, s0 = 0.f, c1 = 0.f, s1 = 0.f;
                const float* r0 = wt + (kq * 16 + 2 * k2) * 129; const float* r1 = r0 + 129;
                for (int c = 0; c < 128; ++c) { const int j = (c * cp) & 127; const float cv = ctab[j], sv = ctab[(j - 32) & 127]; c0 += r0[c] * cv; s0 += r0[c] * sv; c1 += r1[c] * cv; s1 += r1[c] * sv; }
                oc[k2] = pk2(c0, c1); os[k2] = pk2(s0, s1);
            }
            bf16_t* dc = p.wt_in + (size_t)l * NIN * 2048 + (size_t)(g * 128 + cp) * 2048 + k0 + kq * 16;
            bf16_t* ds = dc + (size_t)512 * 2048;
            *(uint4*)dc = make_uint4(oc[0], oc[1], oc[2], oc[3]); *(uint4*)(dc + 8) = make_uint4(oc[4], oc[5], oc[6], oc[7]);
            *(uint4*)ds = make_uint4(os[0], os[1], os[2], os[3]); *(uint4*)(ds + 8) = make_uint4(os[4], os[5], os[6], os[7]);
            __syncthreads();
        }
    }
    {
        float* ct = fl;
        __syncthreads();
        for (int i = tid; i < 4096; i += 512) ct[i] = cospif((float)i / 2048.0f) * (1.0f / 64.0f);
        __syncthreads();
#pragma unroll 1
        for (int idx = bid * 512 + tid; idx < 4096 * 1024; idx += G * 512) {
            const int kf = idx >> 10, gi = idx & 1023, half = gi >> 9, t0 = (gi & 511) * 8;
            float v[8];
#pragma unroll
            for (int e = 0; e < 8; ++e) { const int j = (kf * (t0 + e)) & 4095; v[e] = half ? -ct[(j - 1024) & 4095] : ct[j]; }
            *(uint4*)(p.wf + (size_t)kf * 8192 + half * 4096 + t0) = make_uint4(pk2(v[0], v[1]), pk2(v[2], v[3]), pk2(v[4], v[5]), pk2(v[6], v[7]));
        }
#pragma unroll 1
        for (int idx = bid * 512 + tid; idx < 256 * 64; idx += G * 512) {
            const int kf = idx >> 6, gi = idx & 63, half = gi >> 5, t0 = (gi & 31) * 8;
            float v[8];
#pragma unroll
            for (int e = 0; e < 8; ++e) { const int j = ((kf * (t0 + e)) & 255) * 16; v[e] = 4.0f * (half ? -ct[(j - 1024) & 4095] : ct[j]); }
            *(uint4*)(p.wfc + (size_t)kf * 512 + half * 256 + t0) = make_uint4(pk2(v[0], v[1]), pk2(v[2], v[3]), pk2(v[4], v[5]), pk2(v[6], v[7]));
        }
#pragma unroll 1
        for (int idx = bid * 512 + tid; idx < 4096 * 64; idx += G * 512) {
            const int t = idx >> 6, axis = (idx >> 5) & 1, i = idx & 31;
            const float inv = powf(10000.0f, -(float)i / 32.0f); const float pos = (float)(axis ? (t & 63) : (t >> 6)); const float ang = pos * inv;
            p.rope[(size_t)idx * 2] = cosf(ang); p.rope[(size_t)idx * 2 + 1] = sinf(ang);
        }
#pragma unroll 1
        for (int idx = bid * 512 + tid; idx < 4 * 2560 * 384; idx += G * 512) {
            const int l = idx / (2560 * 384), rem = idx % (2560 * 384), n = rem / 384, k = rem % 384;
            float v = 0.f;
            if (n < 1024) { const int dir = n >> 9, ch = n & 511; if (k < 128 && (k >> 6) == dir) v = p.w2[(((size_t)l * 2 + dir) * 64 + (k & 63)) * 512 + ch]; }
            else if (n < 2048) { const int nn = n - 1024, dir = nn >> 9, ch = nn & 511; if (k >= 128 && k < 256 && ((k - 128) >> 6) == dir) v = p.a2[(((size_t)l * 2 + dir) * 64 + ((k - 128) & 63)) * 512 + ch]; }
            else { const int ch = n - 2048; if (k >= 256) v = p.g2[((size_t)l * 128 + (k - 256)) * 512 + ch]; }
            p.wt_lr[idx] = f2bf(v);
        }
        __syncthreads();
    }
    {
        float* sv = fl; float* red = fl + 9 * 2048;
        for (int i = tid; i < 9 * 2048; i += 512) { const int s = i >> 11, k = i & 2047; const float xv = s < 8 ? p.c[s * 2048 + k] : p.c_ctx[k]; sv[i] = xv / (1.0f + expf(-xv)); }
        __syncthreads();
#pragma unroll 1
        for (int it = bid; it < 768; it += G) {
            const int l = it / 192, col0 = (it % 192) * 64, cx = tid & 63, ks = tid >> 6;
            float acc[9];
#pragma unroll
            for (int s = 0; s < 9; ++s) acc[s] = 0.f;
            const float* wp = p.w_ada + (size_t)l * 2048 * 12288 + col0 + cx;
#pragma unroll 16
            for (int k = ks * 256; k < ks * 256 + 256; ++k) { const float w = wp[(size_t)k * 12288];
#pragma unroll
                for (int s = 0; s < 9; ++s) acc[s] += sv[s * 2048 + k] * w; }
#pragma unroll
            for (int s = 0; s < 9; ++s) red[(ks * 9 + s) * 64 + cx] = acc[s];
            __syncthreads();
            for (int o = tid; o < 576; o += 512) { const int s = o >> 6, cc = o & 63; float t = 0.f;
#pragma unroll
                for (int k8 = 0; k8 < 8; ++k8) t += red[(k8 * 9 + s) * 64 + cc];
                p.mod[((size_t)l * 9 + s) * 12288 + col0 + cc] = t + p.b_ada[(size_t)l * 12288 + col0 + cc]; }
            __syncthreads();
        }
    }
}

__device__ __forceinline__ void norm_mod(const float* xl, const float* xc, const float* gain, const float* modl, int shOff, int scOff, bf16_t* U) {
    const int wave = otid() >> 6, lane = otid() & 63;
#pragma unroll 1
    for (int row = blockIdx.x * 8 + wave; row < MT; row += gridDim.x * 8) {
        const float4* src = (const float4*)(row < ML ? xl + (size_t)row * 2048 : xc + (size_t)(row - ML) * 2048);
        const int s = row < ML ? (row >> 12) : 8;
        float4 v[8]; float ss = 0.f;
#pragma unroll
        for (int i = 0; i < 8; ++i) { v[i] = src[lane + 64 * i]; ss += v[i].x * v[i].x + v[i].y * v[i].y + v[i].z * v[i].z + v[i].w * v[i].w; }
        ss = wave_sum(ss);
        const float rs = rsqrtf(ss * (1.0f / 2048.0f) + 1e-6f);
        const float4* g4 = (const float4*)gain; const float4* sh4 = (const float4*)(modl + s * 12288 + shOff); const float4* sc4 = (const float4*)(modl + s * 12288 + scOff);
#pragma unroll
        for (int i = 0; i < 8; ++i) { const int ci = lane + 64 * i; const float4 g = g4[ci], sh = sh4[ci], sc = sc4[ci];
            const float o0 = v[i].x * rs * g.x * (1.0f + sc.x) + sh.x, o1 = v[i].y * rs * g.y * (1.0f + sc.y) + sh.y, o2 = v[i].z * rs * g.z * (1.0f + sc.z) + sh.z, o3 = v[i].w * rs * g.w * (1.0f + sc.w) + sh.w;
            *(uint2*)(U + (size_t)row * 2048 + ci * 4) = make_uint2(pk2(o0, o1), pk2(o2, o3)); }
    }
}

struct EpiIn {
    static constexpr bool PERM = false, AFTER_DRAIN = false;
    bf16_t *q, *ak, *vt, *vtc, *rw, *ft, *ftc; const float* rope;
    __device__ __forceinline__ void operator()(const f32x4 (&acc)[2][2][4][2], const Unit& u, int wr, int wc, int fr, int fq) const {
        asm volatile("" : "+v"(fr), "+v"(fq));
        const int pn = u.pn; const int cb = wc * 32 + 4 * fq;
#pragma unroll
        for (int ai = 0; ai < 2; ++ai)
#pragma unroll
            for (int m = 0; m < 4; ++m) {
                const int r = u.pm * 256 + ai * 128 + wr * 64 + m * 16 + fr;
                const bool lat = r < ML; const int b = lat ? (r >> 12) : ((r - ML) >> 8); const int t = lat ? (r & 4095) : ((r - ML) & 255);
                if (pn < 4) {
                    const int half = pn >> 1; const int ch0 = (pn & 1) * 256 + cb;
                    bf16_t* d = lat ? ft + ((unsigned)(b * 512 + ch0) * 8192u + half * 4096 + t) : ftc + ((unsigned)(b * 512 + ch0) * 512u + half * 256 + t);
                    const unsigned sd = lat ? 8192u : 512u;
#pragma unroll
                    for (int bj = 0; bj < 2; ++bj)
#pragma unroll
                        for (int n = 0; n < 2; ++n) { const f32x4 v = acc[ai][bj][m][n]; bf16_t* dd = d + (unsigned)(bj * 128 + n * 16) * sd;
                            dd[0] = f2bf(v[0]); dd[sd] = f2bf(v[1]); dd[2 * sd] = f2bf(v[2]); dd[3 * sd] = f2bf(v[3]); }
                } else if (pn < 9) {
                    bf16_t* d = pn < 8 ? q + ((unsigned)r * 1024u + (pn - 4) * 256 + cb) : ak + ((unsigned)r * 256u + cb);
                    const float* rp = rope + (unsigned)t * 128u;
#pragma unroll
                    for (int bj = 0; bj < 2; ++bj)
#pragma unroll
                        for (int n = 0; n < 2; ++n) { f32x4 v = acc[ai][bj][m][n];
                            if (lat) { const int pp = (cb + n * 16) & 127, axis = pp >> 6, i = (pp & 63) >> 1;
                                const float4 cs = *(const float4*)(rp + (axis * 32 + i) * 2);
                                const float a0 = v[0], b0 = v[1], a1 = v[2], b1 = v[3];
                                v[0] = a0 * cs.x - b0 * cs.y; v[1] = a0 * cs.y + b0 * cs.x; v[2] = a1 * cs.z - b1 * cs.w; v[3] = a1 * cs.w + b1 * cs.z; }
                            *(uint2*)(d + bj * 128 + n * 16) = make_uint2(pk2(v[0], v[1]), pk2(v[2], v[3])); }
                } else if (pn == 9) {
                    bf16_t* d = lat ? vt + ((unsigned)(b * 256 + cb) * 4096u + t) : vtc + ((unsigned)(b * 256 + cb) * 256u + t);
                    const unsigned sd = lat ? 4096u : 256u;
#pragma unroll
                    for (int bj = 0; bj < 2; ++bj)
#pragma unroll
                        for (int n = 0; n < 2; ++n) { const f32x4 v = acc[ai][bj][m][n]; bf16_t* dd = d + (unsigned)(bj * 128 + n * 16) * sd;
                            dd[0] = f2bf(v[0]); dd[sd] = f2bf(v[1]); dd[2 * sd] = f2bf(v[2]); dd[3 * sd] = f2bf(v[3]); }
                } else {
                    bf16_t* d = rw + ((unsigned)r * 2048u + (pn - 10) * 256 + cb);
#pragma unroll
                    for (int bj = 0; bj < 2; ++bj)
#pragma unroll
                        for (int n = 0; n < 2; ++n) { const f32x4 v = acc[ai][bj][m][n]; *(uint2*)(d + bj * 128 + n * 16) = make_uint2(pk2(v[0], v[1]), pk2(v[2], v[3])); }
                }
                __builtin_amdgcn_sched_barrier(0);
            }
    }
};
struct EpiLR {
    static constexpr bool PERM = false, AFTER_DRAIN = false;
    bf16_t *dec, *aa, *gg; const float *w0, *a0;
    __device__ __forceinline__ void operator()(const f32x4 (&acc)[2][2][4][2], const Unit& u, int wr, int wc, int fr, int fq) const {
        asm volatile("" : "+v"(fr), "+v"(fq));
        const int pn = u.pn; const int cb = wc * 32 + 4 * fq;
#pragma unroll
        for (int ai = 0; ai < 2; ++ai)
#pragma unroll
            for (int m = 0; m < 4; ++m) {
                const int r = u.pm * 256 + ai * 128 + wr * 64 + m * 16 + fr;
                if (pn < 8) {
                    const int c0 = (pn & 3) * 256 + cb;
                    const float* bias = (pn < 4 ? w0 : a0) + c0;
                    bf16_t* d = (pn < 4 ? dec : aa) + ((unsigned)((c0 >> 9) * MT + r) * 512u + (c0 & 511));
#pragma unroll
                    for (int bj = 0; bj < 2; ++bj)
#pragma unroll
                        for (int n = 0; n < 2; ++n) { f32x4 v = acc[ai][bj][m][n]; const float4 wb = *(const float4*)(bias + bj * 128 + n * 16);
                            v[0] += wb.x; v[1] += wb.y; v[2] += wb.z; v[3] += wb.w;
#pragma unroll
                            for (int e = 0; e < 4; ++e) { const float ex = __expf(-v[e]);
                                v[e] = pn < 4 ? -__expf(-(v[e] < -20.f ? -v[e] : __logf(1.0f + ex)) - 0.5f) : 1.0f / (1.0f + ex); }
                            *(uint2*)(d + bj * 128 + n * 16) = make_uint2(pk2(v[0], v[1]), pk2(v[2], v[3])); }
                } else {
                    bf16_t* d = gg + ((unsigned)r * 512u + (pn - 8) * 256 + cb);
#pragma unroll
                    for (int bj = 0; bj < 2; ++bj)
#pragma unroll
                        for (int n = 0; n < 2; ++n) { const f32x4 v = acc[ai][bj][m][n]; *(uint2*)(d + bj * 128 + n * 16) = make_uint2(pk2(v[0], v[1]), pk2(v[2], v[3])); }
                }
                __builtin_amdgcn_sched_barrier(0);
            }
    }
};
struct EpiFO {
    static constexpr bool PERM = false, AFTER_DRAIN = false;
    bf16_t* fo; int base, seqlen;
    __device__ __forceinline__ void operator()(const f32x4 (&acc)[2][2][4][2], const Unit& u, int wr, int wc, int fr, int fq) const {
        asm volatile("" : "+v"(fr), "+v"(fq));
#pragma unroll
        for (int ai = 0; ai < 2; ++ai)
#pragma unroll
            for (int m = 0; m < 4; ++m) {
                const int r = u.pm * 256 + ai * 128 + wr * 64 + m * 16 + fr;
#pragma unroll
                for (int bj = 0; bj < 2; ++bj)
#pragma unroll
                    for (int n = 0; n < 2; ++n) {
                        const int c = u.pn * 256 + bj * 128 + wc * 32 + n * 16 + 4 * fq; const f32x4 v = acc[ai][bj][m][n];
                        *(uint2*)(fo + (unsigned)(base + (c >> 9) * seqlen + r) * 512u + (c & 511)) = make_uint2(pk2(v[0], v[1]), pk2(v[2], v[3]));
                    }
                __builtin_amdgcn_sched_barrier(0);
            }
    }
};
struct EpiRes {
    static constexpr bool PERM = false, AFTER_DRAIN = false;
    const float *xl_in, *xc_in; float *xl_out, *xc_out; const float* ga; int row_off;
    __device__ __forceinline__ void operator()(const f32x4 (&acc)[2][2][4][2], const Unit& u, int wr, int wc, int fr, int fq) const {
        asm volatile("" : "+v"(fr), "+v"(fq));
#pragma unroll
        for (int ai = 0; ai < 2; ++ai)
#pragma unroll
            for (int m = 0; m < 4; ++m) {
                const int r = row_off + u.pm * 256 + ai * 128 + wr * 64 + m * 16 + fr;
                const bool lat = r < ML; const int s = lat ? (r >> 12) : 8;
                const float* xi = lat ? xl_in + (size_t)r * 2048 : xc_in + (size_t)(r - ML) * 2048;
                float* xo = lat ? xl_out + (size_t)r * 2048 : xc_out + (size_t)(r - ML) * 2048;
#pragma unroll
                for (int bj = 0; bj < 2; ++bj)
#pragma unroll
                    for (int n = 0; n < 2; ++n) {
                        const int c = u.pn * 256 + bj * 128 + wc * 32 + n * 16 + 4 * fq; const f32x4 v = acc[ai][bj][m][n];
                        const float4 xv = *(const float4*)(xi + c); const float4 g = *(const float4*)(ga + s * 12288 + c);
                        *(float4*)(xo + c) = make_float4(xv.x + g.x * v[0], xv.y + g.y * v[1], xv.z + g.z * v[2], xv.w + g.w * v[3]);
                    }
                __builtin_amdgcn_sched_barrier(0);
            }
    }
};
struct EpiH {
    static constexpr bool PERM = false, AFTER_DRAIN = false;
    bf16_t* o; int ld;
    __device__ __forceinline__ void operator()(const f32x4 (&acc)[2][2][4][2], const Unit& u, int wr, int wc, int fr, int fq) const {
        asm volatile("" : "+v"(fr), "+v"(fq));
#pragma unroll
        for (int ai = 0; ai < 2; ++ai)
#pragma unroll
            for (int m = 0; m < 4; ++m) {
                const int r = u.pm * 256 + ai * 128 + wr * 64 + m * 16 + fr;
#pragma unroll
                for (int bj = 0; bj < 2; ++bj)
#pragma unroll
                    for (int n = 0; n < 2; ++n) {
                        const int c = u.pn * 256 + bj * 128 + wc * 32 + n * 16 + 4 * fq; const f32x4 v = acc[ai][bj][m][n];
                        *(uint2*)(o + (size_t)r * ld + c) = make_uint2(pk2(v[0], v[1]), pk2(v[2], v[3]));
                    }
                __builtin_amdgcn_sched_barrier(0);
            }
    }
};

__device__ __forceinline__ void ld8(const bf16_t* ptr, float (&o)[8]) { const uint4 w = *(const uint4*)ptr; o[0] = lo_bf(w.x); o[1] = hi_bf(w.x); o[2] = lo_bf(w.y); o[3] = hi_bf(w.y); o[4] = lo_bf(w.z); o[5] = hi_bf(w.z); o[6] = lo_bf(w.w); o[7] = hi_bf(w.w); }
__device__ __forceinline__ void ld8f(const float* ptr, float (&o)[8]) { const float4 a = *(const float4*)ptr, b = *(const float4*)(ptr + 4); o[0] = a.x; o[1] = a.y; o[2] = a.z; o[3] = a.w; o[4] = b.x; o[5] = b.y; o[6] = b.z; o[7] = b.w; }
__device__ __forceinline__ void st8(bf16_t* ptr, const float (&o)[8]) { *(uint4*)ptr = make_uint4(pk2(o[0], o[1]), pk2(o[2], o[3]), pk2(o[4], o[5]), pk2(o[6], o[7])); }
__device__ __forceinline__ void smix8(const bf16_t* bp, bool hp, bool hn, const float* m0, const float* m1, float (&o)[8]) {
    float x[8], pv[8], nv[8], a[8], b[8]; ld8(bp, x); ld8f(m0, a); ld8f(m1, b);
    if (hp) ld8(bp - 2048, pv); else {
#pragma unroll
        for (int e = 0; e < 8; ++e) pv[e] = 0.f; }
    if (hn) ld8(bp + 2048, nv); else {
#pragma unroll
        for (int e = 0; e < 8; ++e) nv[e] = 0.f; }
#pragma unroll
    for (int e = 0; e < 8; ++e) o[e] = x[e] + a[e] * (pv[e] - x[e]) + b[e] * (nv[e] - x[e]);
}
__device__ __forceinline__ void seq_of(int row, int& t, int& L) { if (row < ML) { t = row & 4095; L = 4096; } else { t = (row - ML) & 255; L = 256; } }
__device__ __forceinline__ void prep_phase(const Params& p, int l) {
    const float* mu0 = p.mu + (size_t)l * 2 * 1920; const float* mu1 = mu0 + 1920;
#pragma unroll 1
    for (int idx = blockIdx.x * 512 + otid(); idx < MT * 48; idx += gridDim.x * 512) {
        const int row = idx / 48, cc = (idx % 48) * 8; int t, L; seq_of(row, t, L);
        int rc, mc; if (cc < 128) { rc = 1664 + cc; mc = 1664 + cc; } else if (cc < 256) { rc = 1792 + (cc - 128); mc = 1792 + (cc - 128); } else { rc = 1536 + (cc - 256); mc = 512 + (cc - 256); }
        float sm[8]; smix8(p.rw + (size_t)row * 2048 + rc, t > 0, t < L - 1, mu0 + mc, mu1 + mc, sm);
#pragma unroll
        for (int e = 0; e < 8; ++e) sm[e] = cc < 128 ? tanhf(sm[e]) : (cc < 256 ? sm[e] : sigmoidf_(sm[e]));
        st8(p.a2b + (size_t)row * 384 + cc, sm);
    }
}

__device__ __forceinline__ int scan_row(int st, int dir, int b, int& t, int& L) {
    if (st < 256) { t = dir ? 255 - st : st; L = 256; return ML + b * 256 + t; }
    const int s2 = st - 256; t = dir ? 4095 - s2 : s2; L = 4096; return b * 4096 + t;
}
struct ScanRaw { uint4 r0, rp, rn, k0, kp, kn, v0, vp, vn, a, e; float mp, mn; };
__device__ __forceinline__ void up8(const uint4& w, float (&o)[8]) { o[0] = lo_bf(w.x); o[1] = hi_bf(w.x); o[2] = lo_bf(w.y); o[3] = hi_bf(w.y); o[4] = lo_bf(w.z); o[5] = hi_bf(w.z); o[6] = lo_bf(w.w); o[7] = hi_bf(w.w); }
__device__ __forceinline__ void scan_load(const Params& p, int chunk, int dir, int b, int h, int pw, int lane, ScanRaw& R) {
    const int sl = pw * 8 + (lane >> 3), col = h * 64 + (lane & 7) * 8;
    int t, L; const int row = scan_row(chunk * 32 + sl, dir, b, t, L);
    const bool hp = t > 0, hn = t < L - 1; const int op = hp ? -2048 : 0, on = hn ? 2048 : 0;
    const bf16_t* bp = p.rw + (size_t)row * 2048 + col;
    R.r0 = *(const uint4*)bp; R.rp = *(const uint4*)(bp + op); R.rn = *(const uint4*)(bp + on);
    R.k0 = *(const uint4*)(bp + 512); R.kp = *(const uint4*)(bp + 512 + op); R.kn = *(const uint4*)(bp + 512 + on);
    R.v0 = *(const uint4*)(bp + 1024); R.vp = *(const uint4*)(bp + 1024 + op); R.vn = *(const uint4*)(bp + 1024 + on);
    R.a = *(const uint4*)(p.aa + ((size_t)dir * MT + row) * 512 + col); R.e = *(const uint4*)(p.dec + ((size_t)dir * MT + row) * 512 + col);
    R.mp = hp ? 1.0f : 0.0f; R.mn = hn ? 1.0f : 0.0f;
}
__device__ __forceinline__ void scan_emit(const ScanRaw& R, const float* cb, float* buf, int pw, int lane) {
    const int sl = pw * 8 + (lane >> 3), cg = lane & 7;
    float x[8], pv[8], nv[8], r[8], k[8], v[8], a[8], e[8], kk[8], m0[8], m1[8];
    up8(R.r0, x); up8(R.rp, pv); up8(R.rn, nv); ld8f(cb + cg * 8, m0); ld8f(cb + 64 + cg * 8, m1);
#pragma unroll
    for (int i = 0; i < 8; ++i) r[i] = x[i] + m0[i] * (pv[i] * R.mp - x[i]) + m1[i] * (nv[i] * R.mn - x[i]);
    up8(R.k0, x); up8(R.kp, pv); up8(R.kn, nv); ld8f(cb + 128 + cg * 8, m0); ld8f(cb + 192 + cg * 8, m1);
#pragma unroll
    for (int i = 0; i < 8; ++i) k[i] = x[i] + m0[i] * (pv[i] * R.mp - x[i]) + m1[i] * (nv[i] * R.mn - x[i]);
    up8(R.v0, x); up8(R.vp, pv); up8(R.vn, nv); ld8f(cb + 256 + cg * 8, m0); ld8f(cb + 320 + cg * 8, m1);
#pragma unroll
    for (int i = 0; i < 8; ++i) v[i] = x[i] + m0[i] * (pv[i] * R.mp - x[i]) + m1[i] * (nv[i] * R.mn - x[i]);
    up8(R.a, a); up8(R.e, e); ld8f(cb + 384 + cg * 8, m0); ld8f(cb + 448 + cg * 8, m1);
    float n2 = 0.f;
#pragma unroll
    for (int i = 0; i < 8; ++i) { kk[i] = k[i] * m0[i]; n2 += kk[i] * kk[i]; }
    n2 += __shfl_xor(n2, 1); n2 += __shfl_xor(n2, 2); n2 += __shfl_xor(n2, 4);
    const float inv = 1.0f / fmaxf(sqrtf(n2), 1e-12f);
    float* o = buf + sl * 384 + cg * 8;
#pragma unroll
    for (int i = 0; i < 8; ++i) { kk[i] *= inv; e[i] = __expf(e[i]); k[i] = k[i] * (1.0f + (a[i] - 1.0f) * m1[i]); a[i] = kk[i] * a[i]; }
    *(float4*)(o) = make_float4(e[0], e[1], e[2], e[3]); *(float4*)(o + 4) = make_float4(e[4], e[5], e[6], e[7]);
    *(float4*)(o + 64) = make_float4(kk[0], kk[1], kk[2], kk[3]); *(float4*)(o + 68) = make_float4(kk[4], kk[5], kk[6], kk[7]);
    *(float4*)(o + 128) = make_float4(a[0], a[1], a[2], a[3]); *(float4*)(o + 132) = make_float4(a[4], a[5], a[6], a[7]);
    *(float4*)(o + 192) = make_float4(k[0], k[1], k[2], k[3]); *(float4*)(o + 196) = make_float4(k[4], k[5], k[6], k[7]);
    *(float4*)(o + 256) = make_float4(r[0], r[1], r[2], r[3]); *(float4*)(o + 260) = make_float4(r[4], r[5], r[6], r[7]);
    *(float4*)(o + 320) = make_float4(v[0], v[1], v[2], v[3]); *(float4*)(o + 324) = make_float4(v[4], v[5], v[6], v[7]);
}
__device__ __forceinline__ void scan_phase(const Params& p, int l, unsigned char* shm) {
    const int tid = otid(), wave = tid >> 6, lane = tid & 63;
    float* buf0 = (float*)shm; float* buf1 = buf0 + 32 * 384;
#pragma unroll 1
    for (int wi = blockIdx.x; wi < 256; wi += gridDim.x) {
        const int dir = wi >> 7, b = (wi >> 4) & 7, h = (wi >> 1) & 7, half = wi & 1;
        const int ri = lane >> 3, cj = lane & 7, irow = half * 32 + (wave & 3) * 8 + ri;
        pg8::f32x2 s0 = {0.f, 0.f}, s1 = {0.f, 0.f}, s2 = {0.f, 0.f}, s3 = {0.f, 0.f};
        ScanRaw R; float* cb = buf0 + 2 * 32 * 384;
        __syncthreads();
        if (wave == 4) { const float* mu0 = p.mu + (size_t)l * 2 * 1920; const float* mu1 = mu0 + 1920; const int col = h * 64 + lane;
            cb[lane] = mu0[col]; cb[64 + lane] = mu1[col]; cb[128 + lane] = mu0[640 + col]; cb[192 + lane] = mu1[640 + col]; cb[256 + lane] = mu0[1152 + col]; cb[320 + lane] = mu1[1152 + col];
            cb[384 + lane] = p.kk_scale[l * 512 + col]; cb[448 + lane] = p.ka[l * 512 + col]; }
        __syncthreads();
        if (wave >= 4) {
            scan_load(p, 0, dir, b, h, wave - 4, lane, R); scan_emit(R, cb, buf0, wave - 4, lane); scan_load(p, 1, dir, b, h, wave - 4, lane, R);
        }
        __syncthreads();
#pragma unroll 1
        for (int c = 0; c < 136; ++c) {
            float* cur = (c & 1) ? buf1 : buf0; float* nxt = (c & 1) ? buf0 : buf1;
            if (wave >= 4) { if (c + 1 < 136) { scan_emit(R, cb, nxt, wave - 4, lane); if (c + 2 < 136) scan_load(p, c + 2, dir, b, h, wave - 4, lane, R); } }
            else {
#define SC_LOAD(X, SL) { const float* o_ = cur + (SL) * 384 + cj * 8; X##w0 = *(const f32x4*)(o_); X##w1 = *(const f32x4*)(o_ + 4); X##k0 = *(const f32x4*)(o_ + 64); X##k1 = *(const f32x4*)(o_ + 68); \
                    X##b0 = *(const f32x4*)(o_ + 128); X##b1 = *(const f32x4*)(o_ + 132); X##d0 = *(const f32x4*)(o_ + 192); X##d1 = *(const f32x4*)(o_ + 196); X##r0 = *(const f32x4*)(o_ + 256); X##r1 = *(const f32x4*)(o_ + 260); \
                    X##vv = cur[(SL) * 384 + 320 + irow]; }
#define SC_STEP(X, SL) { pg8::f32x2 ac = s0 * X##k0.xy; ac += s1 * X##k0.zw; ac += s2 * X##k1.xy; ac += s3 * X##k1.zw; \
                    float sa = ac.x + ac.y; sa = sum8(sa); const pg8::f32x2 sa2 = {-sa, -sa}, vv2 = {X##vv, X##vv}; \
                    s0 = s0 * X##w0.xy + sa2 * X##b0.xy + vv2 * X##d0.xy; s1 = s1 * X##w0.zw + sa2 * X##b0.zw + vv2 * X##d0.zw; s2 = s2 * X##w1.xy + sa2 * X##b1.xy + vv2 * X##d1.xy; s3 = s3 * X##w1.zw + sa2 * X##b1.zw + vv2 * X##d1.zw; \
                    pg8::f32x2 yc = s0 * X##r0.xy; yc += s1 * X##r0.zw; yc += s2 * X##r1.xy; yc += s3 * X##r1.zw; \
                    float yv = yc.x + yc.y; yv = sum8(yv); \
                    yk = (cj == ((SL) & 7)) ? yv : yk; }
                const int st0 = c * 32, row0 = c < 8 ? ML + b * 256 + (dir ? 255 - st0 : st0) : b * 4096 + (dir ? 4095 - (st0 - 256) : st0 - 256);
                bf16_t* yp = p.y + ((size_t)dir * MT + row0) * 512 + h * 64 + irow; const int ystep = dir ? -512 : 512;
                f32x4 Aw0, Aw1, Ak0, Ak1, Ab0, Ab1, Ad0, Ad1, Ar0, Ar1, Bw0, Bw1, Bk0, Bk1, Bb0, Bb1, Bd0, Bd1, Br0, Br1; float Avv, Bvv;
                SC_LOAD(A, 0)
                bf16_t* ypl = yp + cj * ystep;
#pragma unroll 1
                for (int s8 = 0; s8 < 32; s8 += 8) {
                    float yk = 0.f;
#pragma unroll
                    for (int j = 0; j < 8; j += 2) {
                        SC_LOAD(B, s8 + j + 1)
                        SC_STEP(A, j)
                        SC_LOAD(A, s8 + j + 2)
                        SC_STEP(B, j + 1)
                    }
                    ypl[s8 * ystep] = f2bf(yk);
                }
#undef SC_LOAD
#undef SC_STEP
            }
            __syncthreads();
        }
    }
}

__device__ __forceinline__ void attn_phase(const Params& p, int l, unsigned char* shm) {
    const int tid = otid(), wave = tid >> 6, lane = tid & 63, fr = lane & 15, fq = lane >> 4;
    const int g = wave >> 1, qh = wave & 1;
    bf16_t* Ks = (bf16_t*)shm;
    bf16_t* Vs = (bf16_t*)(shm + 64 * 136 * 2);
    const float scale = 0.08838834764831845f;
#pragma unroll 1
    for (int un = blockIdx.x; un < (l == 3 ? 1024 : 1088); un += gridDim.x) {
        const bool lat = un < 1024; int b, qb, hk;
        if (lat) { b = un >> 7; qb = (un >> 1) & 63; hk = un & 1; } else { const int v = un - 1024; b = v >> 3; qb = (v >> 1) & 3; hk = v & 1; }
        const int q0 = qb * 64, rowbase = lat ? b * 4096 : ML + b * 256, hq = hk * 4 + g;
        bf16x8 Qf[2][4];
#pragma unroll
        for (int qt = 0; qt < 2; ++qt)
#pragma unroll
            for (int ks = 0; ks < 4; ++ks) Qf[qt][ks] = *(const bf16x8*)(p.q + (size_t)(rowbase + q0 + qh * 32 + qt * 16 + fr) * 1024 + hq * 128 + ks * 32 + fq * 8);
        const float sinkv = p.sink[l * 8 + hq];
        float mrun[2] = {sinkv, sinkv}, lsum[2]; lsum[0] = lsum[1] = (fq == 0) ? 1.0f : 0.0f;
        f32x4 O[8][2];
#pragma unroll
        for (int dt = 0; dt < 8; ++dt) { O[dt][0] = (f32x4){0.f, 0.f, 0.f, 0.f}; O[dt][1] = (f32x4){0.f, 0.f, 0.f, 0.f}; }
        const int jlo = lat ? (qb < 2 ? 2 - qb : 0) : 0, jhi = lat ? (65 - qb < 4 ? 65 - qb : 4) : -1;
        const int nloc = lat ? jhi - jlo + 1 : 0, nkb = nloc + 4;
        uint4 ra, rc, rv0, rv1;
#define AT_LOAD(I) { const int i_ = (I); const bool loc_ = i_ < nloc; const int kp_ = loc_ ? q0 - 128 + 64 * (jlo + i_) : 0, cb_ = i_ - nloc; \
            const int krow_ = loc_ ? b * 4096 + kp_ : ML + b * 256 + cb_ * 64; \
            const bf16_t* vsrc_ = loc_ ? p.vt + (size_t)(b * 256 + hk * 128) * 4096 + kp_ : p.vtc + (size_t)(b * 256 + hk * 128) * 256 + cb_ * 64; const int vstr_ = loc_ ? 4096 : 256; \
            const uint4* s1_ = (const uint4*)(p.ak + (size_t)(krow_ + (tid >> 3)) * 256 + hk * 128 + (tid & 7) * 16); ra = s1_[0]; rc = s1_[1]; \
            const uint4* s2_ = (const uint4*)(vsrc_ + (size_t)(tid >> 2) * vstr_ + (tid & 3) * 16); rv0 = s2_[0]; rv1 = s2_[1]; }
        AT_LOAD(0)
#pragma unroll 1
        for (int kb = 0; kb < nkb; ++kb) {
            const bool local = kb < nloc; const int kp0 = local ? q0 - 128 + 64 * (jlo + kb) : 0;
            __syncthreads();
            {
                const int key = tid >> 3, ch = tid & 7, dd = tid >> 2, c4 = tid & 3;
                uint4* d1 = (uint4*)(Ks + key * 136 + ch * 16); d1[0] = ra; d1[1] = rc;
                uint2* d2 = (uint2*)(Vs + dd * 68 + c4 * 16); d2[0] = make_uint2(rv0.x, rv0.y); d2[1] = make_uint2(rv0.z, rv0.w); d2[2] = make_uint2(rv1.x, rv1.y); d2[3] = make_uint2(rv1.z, rv1.w);
            }
            __syncthreads();
            if (kb + 1 < nkb) AT_LOAD(kb + 1)
            f32x4 S[4][2];
#pragma unroll
            for (int kt = 0; kt < 4; ++kt) { S[kt][0] = (f32x4){0.f, 0.f, 0.f, 0.f}; S[kt][1] = (f32x4){0.f, 0.f, 0.f, 0.f};
#pragma unroll
                for (int ks = 0; ks < 4; ++ks) { const bf16x8 Kf = *(const bf16x8*)(Ks + (kt * 16 + fr) * 136 + ks * 32 + fq * 8);
                    S[kt][0] = __builtin_amdgcn_mfma_f32_16x16x32_bf16(Kf, Qf[0][ks], S[kt][0], 0, 0, 0); S[kt][1] = __builtin_amdgcn_mfma_f32_16x16x32_bf16(Kf, Qf[1][ks], S[kt][1], 0, 0, 0); } }
#pragma unroll
            for (int qt = 0; qt < 2; ++qt) {
                const int qp = q0 + qh * 32 + qt * 16 + fr; float mx = -1e30f;
#pragma unroll
                for (int kt = 0; kt < 4; ++kt)
#pragma unroll
                    for (int e = 0; e < 4; ++e) { float sv = S[kt][qt][e] * scale; if (local) { const int dlt = kp0 + kt * 16 + 4 * fq + e - qp; if (dlt > 128 || dlt < -128) sv = -1e30f; } S[kt][qt][e] = sv; mx = fmaxf(mx, sv); }
                mx = fmaxf(mx, __shfl_xor(mx, 16)); mx = fmaxf(mx, __shfl_xor(mx, 32));
                const float mnew = fmaxf(mrun[qt], mx), alpha = __expf(mrun[qt] - mnew); mrun[qt] = mnew;
                float ps = 0.f;
#pragma unroll
                for (int kt = 0; kt < 4; ++kt)
#pragma unroll
                    for (int e = 0; e < 4; ++e) { const float pv = __expf(S[kt][qt][e] - mnew); S[kt][qt][e] = pv; ps += pv; }
                lsum[qt] = lsum[qt] * alpha + ps;
#pragma unroll
                for (int dt = 0; dt < 8; ++dt) O[dt][qt] *= alpha;
            }
#pragma unroll
            for (int kg = 0; kg < 2; ++kg) {
                bf16x8 Pf[2];
#pragma unroll
                for (int qt = 0; qt < 2; ++qt) { const uint4 w = make_uint4(pk2(S[2 * kg][qt][0], S[2 * kg][qt][1]), pk2(S[2 * kg][qt][2], S[2 * kg][qt][3]), pk2(S[2 * kg + 1][qt][0], S[2 * kg + 1][qt][1]), pk2(S[2 * kg + 1][qt][2], S[2 * kg + 1][qt][3])); Pf[qt] = *(const bf16x8*)&w; }
#pragma unroll
                for (int dt = 0; dt < 8; ++dt) {
                    const uint2 lo = *(const uint2*)(Vs + (dt * 16 + fr) * 68 + kg * 32 + 4 * fq), hi = *(const uint2*)(Vs + (dt * 16 + fr) * 68 + kg * 32 + 16 + 4 * fq);
                    const uint4 w = make_uint4(lo.x, lo.y, hi.x, hi.y); const bf16x8 Vf = *(const bf16x8*)&w;
                    O[dt][0] = __builtin_amdgcn_mfma_f32_16x16x32_bf16(Vf, Pf[0], O[dt][0], 0, 0, 0); O[dt][1] = __builtin_amdgcn_mfma_f32_16x16x32_bf16(Vf, Pf[1], O[dt][1], 0, 0, 0);
                }
            }
        }
#pragma unroll
        for (int qt = 0; qt < 2; ++qt) {
            float lt = lsum[qt]; lt += __shfl_xor(lt, 16); lt += __shfl_xor(lt, 32); const float inv = 1.0f / lt;
            bf16_t* d = p.at + (size_t)(rowbase + q0 + qh * 32 + qt * 16 + fr) * 1024 + hq * 128 + 4 * fq;
#pragma unroll
            for (int dt = 0; dt < 8; ++dt) { const f32x4 o = O[dt][qt] * inv; *(uint2*)(d + dt * 16) = make_uint2(pk2(o[0], o[1]), pk2(o[2], o[3])); }
        }
    }
#undef AT_LOAD
    __syncthreads();
}

__device__ __forceinline__ void fin_phase(const Params& p, int l, bf16_t* cat) {
    const int wave = otid() >> 6, lane = otid() & 63;
    const float* mu0 = p.mu + (size_t)l * 2 * 1920; const float* mu1 = mu0 + 1920;
#pragma unroll 1
    for (int row = blockIdx.x * 8 + wave; row < MT; row += gridDim.x * 8) {
        int t, L; seq_of(row, t, L); const bool hp = t > 0, hn = t < L - 1;
        bf16_t* co = cat + (size_t)row * 2048;
        {
            float v[8], g[8]; ld8(p.fo + (size_t)row * 512 + lane * 8, v); ld8f(p.f_g + l * 512 + lane * 8, g);
            float ss = 0.f;
#pragma unroll
            for (int e = 0; e < 8; ++e) ss += v[e] * v[e];
            ss = wave_sum(ss); const float rs = rsqrtf(ss * (1.0f / 512.0f) + 1e-6f);
#pragma unroll
            for (int e = 0; e < 8; ++e) v[e] = v[e] * rs * g[e];
            st8(co + lane * 8, v);
        }
        __builtin_amdgcn_sched_barrier(0);
        {
            float v0[8], v1[8], g0[8], g1[8]; ld8(p.at + (size_t)row * 1024 + lane * 16, v0); ld8(p.at + (size_t)row * 1024 + lane * 16 + 8, v1); ld8f(p.a_g + l * 1024 + lane * 16, g0); ld8f(p.a_g + l * 1024 + lane * 16 + 8, g1);
            float ss = 0.f;
#pragma unroll
            for (int e = 0; e < 8; ++e) ss += v0[e] * v0[e] + v1[e] * v1[e];
            ss = wave_sum(ss); const float rs = rsqrtf(ss * (1.0f / 1024.0f) + 1e-6f);
#pragma unroll
            for (int e = 0; e < 8; ++e) { v0[e] = v0[e] * rs * g0[e]; v1[e] = v1[e] * rs * g1[e]; }
            st8(co + 1024 + lane * 16, v0); st8(co + 1024 + lane * 16 + 8, v1);
        }
        __builtin_amdgcn_sched_barrier(0);
        {
            const int col = lane * 8;
            const bf16_t* bp = p.rw + (size_t)row * 2048 + col;
            float bs = 0.f;
            {   float r[8], k[8], a0[8], a1[8], kav[8], rkv[8];
                smix8(bp, hp, hn, mu0 + col, mu1 + col, r); smix8(bp + 512, hp, hn, mu0 + 640 + col, mu1 + 640 + col, k);
                ld8(p.aa + (size_t)row * 512 + col, a0); ld8(p.aa + ((size_t)MT + row) * 512 + col, a1); ld8f(p.ka + l * 512 + col, kav); ld8f(p.rk + l * 512 + col, rkv);
#pragma unroll
                for (int e = 0; e < 8; ++e) { const float kd = k[e] * (2.0f + (a0[e] + a1[e] - 2.0f) * kav[e]); bs += r[e] * kd * rkv[e]; }
                bs += __shfl_xor(bs, 1); bs += __shfl_xor(bs, 2); bs += __shfl_xor(bs, 4); }
            __builtin_amdgcn_sched_barrier(0);
            float y0[8];
            {   float y1[8]; ld8(p.y + (size_t)row * 512 + col, y0); ld8(p.y + ((size_t)MT + row) * 512 + col, y1);
                float sm = 0.f;
#pragma unroll
                for (int e = 0; e < 8; ++e) { y0[e] += y1[e]; sm += y0[e]; }
                sm += __shfl_xor(sm, 1); sm += __shfl_xor(sm, 2); sm += __shfl_xor(sm, 4);
                const float mean = sm * (1.0f / 64.0f); float vs = 0.f;
#pragma unroll
                for (int e = 0; e < 8; ++e) { y0[e] -= mean; vs += y0[e] * y0[e]; }
                vs += __shfl_xor(vs, 1); vs += __shfl_xor(vs, 2); vs += __shfl_xor(vs, 4);
                const float rs = rsqrtf(vs * (1.0f / 64.0f) + 64e-5f);
#pragma unroll
                for (int e = 0; e < 8; ++e) y0[e] *= rs; }
            __builtin_amdgcn_sched_barrier(0);
            {   float v[8], lw[8], lb[8], gv[8], o[8];
                smix8(bp + 1024, hp, hn, mu0 + 1152 + col, mu1 + 1152 + col, v);
                ld8f(p.lnx_w + l * 512 + col, lw); ld8f(p.lnx_b + l * 512 + col, lb); ld8(p.gg + (size_t)row * 512 + col, gv);
#pragma unroll
                for (int e = 0; e < 8; ++e) o[e] = (y0[e] * lw[e] + lb[e] + bs * v[e]) * gv[e];
                st8(co + 512 + col, o); }
        }
        __builtin_amdgcn_sched_barrier(0);
    }
}

__device__ __forceinline__ void conv_phase(const Params& p, int l, int r0, int Mp) {
    const float* cw = p.conv_w + (size_t)l * 3 * DFF; const float* cb = p.conv_b + (size_t)l * DFF;
#pragma unroll 1
    for (int idx = blockIdx.x * 512 + otid(); idx < Mp * 704; idx += gridDim.x * 512) {
        const int rl = idx / 704, ch = (idx % 704) * 8; int t, L; seq_of(r0 + rl, t, L);
        const bf16_t* hp_ = p.h + (size_t)rl * 11264 + ch;
        float x[8], pv[8], nv[8], up[8], w0[8], w1[8], w2[8], bb[8], o[8];
        ld8(hp_, x); ld8(hp_ + DFF, up); ld8f(cw + ch, w0); ld8f(cw + DFF + ch, w1); ld8f(cw + 2 * DFF + ch, w2); ld8f(cb + ch, bb);
        if (t > 0) ld8(hp_ - 11264, pv); else {
#pragma unroll
            for (int e = 0; e < 8; ++e) pv[e] = 0.f; }
        if (t < L - 1) ld8(hp_ + 11264, nv); else {
#pragma unroll
            for (int e = 0; e < 8; ++e) nv[e] = 0.f; }
#pragma unroll
        for (int e = 0; e < 8; e += 2) { pg8::f32x2 gt; gt.x = pv[e] * w0[e] + x[e] * w1[e] + nv[e] * w2[e] + bb[e]; gt.y = pv[e + 1] * w0[e + 1] + x[e + 1] * w1[e + 1] + nv[e + 1] * w2[e + 1] + bb[e + 1];
            const pg8::f32x2 ge = pg8::gelu_pk(gt); o[e] = ge.x * up[e]; o[e + 1] = ge.y * up[e + 1]; }
        st8(p.act + (size_t)rl * DFF + ch, o);
    }
}

__device__ __forceinline__ void final_norm(const Params& p) {
    const int wave = otid() >> 6, lane = otid() & 63;
#pragma unroll 1
    for (int row = blockIdx.x * 8 + wave; row < ML; row += gridDim.x * 8) {
        float4* src = (float4*)(p.out + (size_t)row * 2048);
        float4 v[8]; float ss = 0.f;
#pragma unroll
        for (int i = 0; i < 8; ++i) { v[i] = src[lane + 64 * i]; ss += v[i].x * v[i].x + v[i].y * v[i].y + v[i].z * v[i].z + v[i].w * v[i].w; }
        ss = wave_sum(ss); const float rs = rsqrtf(ss * (1.0f / 2048.0f) + 1e-6f);
        const float4* g4 = (const float4*)p.final_g;
#pragma unroll
        for (int i = 0; i < 8; ++i) { const float4 g = g4[lane + 64 * i]; src[lane + 64 * i] = make_float4(v[i].x * rs * g.x, v[i].y * rs * g.y, v[i].z * rs * g.z, v[i].w * rs * g.w); }
    }
}

#define LDS_BYTES (131072 + 256)
#define GBAR() xcd_barrier(bar)
__device__ __forceinline__ int opq(int v) { asm volatile("" : "+s"(v)); return v; }
__global__ void __launch_bounds__(512, 2) hymba_fwd(Params p) {
    extern __shared__ __attribute__((aligned(16))) unsigned char shm[];
    PG8_LAS unsigned char* lds = (PG8_LAS unsigned char*)shm;
    volatile LAS unsigned* st = (volatile LAS unsigned*)(lds + 131072);
    if (threadIdx.x == 0) { st[0] = 0u; st[1] = 0u; st[2] = 0u; st[3] = 0u; }
    __syncthreads();
    XcdBarrier bar = xcd_barrier_post(p.bar, st);
    const int G = gridDim.x, bid = blockIdx.x;
#ifndef SK_PRO
    prologue(p, shm);
#endif
    GBAR();
#pragma unroll 1
    for (int l = 0; l < 4; ++l) {
        const float* modl = p.mod + (size_t)l * MODL;
        const float* xl_in = l == 0 ? p.x : p.out; const float* xc_in = l == 0 ? p.ctx : p.xc;
#ifndef SK_NORM
        norm_mod(xl_in, xc_in, p.norm1_g + l * 2048, modl, 0, 2048, p.u);
#endif
        GBAR();
        { EpiIn E; E.q = p.q; E.ak = p.ak; E.vt = p.vt; E.vtc = p.vtc; E.rw = p.rw; E.ft = p.ft; E.ftc = p.ftc; E.rope = p.rope;
          StaticOrder S; S.init(opq(MT), opq(NIN), G, bid); Gemm g; g.A = p.u; g.Bt = p.wt_in + (size_t)l * NIN * 2048; g.M = opq(MT); g.N = opq(NIN); g.K = opq(2048);

#ifndef SK_GIN
          pg8::gemm_phase<EpiIn, StaticOrder, false>(lds, g, S, E, nullptr);
#endif
 }
        GBAR();
#ifndef SK_PREP
        prep_phase(p, l);
#endif
        GBAR();
        { EpiLR E; E.dec = p.dec; E.aa = p.aa; E.gg = p.gg; E.w0 = p.w0 + l * 1024; E.a0 = p.a0 + l * 1024;
          StaticOrder S; S.init(opq(MT), opq(2560), G, bid); Gemm g; g.A = p.a2b; g.Bt = p.wt_lr + (size_t)l * 2560 * 384; g.M = opq(MT); g.N = opq(2560); g.K = opq(384);

#ifndef SK_GLR
          pg8::gemm_phase<EpiLR, StaticOrder, false>(lds, g, S, E, nullptr);
#endif
 }
        __syncthreads();
        { EpiFO E; E.fo = p.fo; E.base = 0; E.seqlen = 4096;
          StaticOrder S; S.init(opq(4096), opq(4096), G, bid); Gemm g; g.A = p.wf; g.Bt = p.ft; g.M = opq(4096); g.N = opq(4096); g.K = opq(8192);

#ifndef SK_GFO
          pg8::gemm_phase<EpiFO, StaticOrder, false>(lds, g, S, E, nullptr);
#endif
 }
        __syncthreads();
        { EpiFO E; E.fo = p.fo; E.base = ML; E.seqlen = 256;
          StaticOrder S; S.init(opq(256), opq(4096), G, bid); Gemm g; g.A = p.wfc; g.Bt = p.ftc; g.M = opq(256); g.N = opq(4096); g.K = opq(512);

#ifndef SK_GFO
          pg8::gemm_phase<EpiFO, StaticOrder, false>(lds, g, S, E, nullptr);
#endif
 }
        __syncthreads();
#ifndef SK_ATT
        attn_phase(p, l, shm);
#endif
        GBAR();
#ifndef SK_SCAN
        scan_phase(p, l, shm);
#endif
        GBAR();
#ifndef SK_FIN
        fin_phase(p, l, p.u);
#endif
        GBAR();
        { EpiRes E; E.xl_in = xl_in; E.xc_in = xc_in; E.xl_out = p.out; E.xc_out = p.xc; E.ga = modl + 4096; E.row_off = 0;
          const int Mo = l == 3 ? ML : MT;
          StaticOrder S; S.init(opq(Mo), opq(2048), G, bid); Gemm g; g.A = p.u; g.Bt = p.wt_out + (size_t)l * 2048 * 2048; g.M = opq(Mo); g.N = opq(2048); g.K = opq(2048);

#ifndef SK_GRES
          pg8::gemm_phase<EpiRes, StaticOrder, false>(lds, g, S, E, nullptr);
#endif
 }
        GBAR();
        norm_mod(p.out, p.xc, p.norm2_g + l * 2048, modl, 6144, 8192, p.u);
        GBAR();
#pragma unroll 1
        for (int part = 0; part < 2; ++part) {
            const int r0 = part ? 0 : 16384, Mp = (!part && l != 3) ? 18432 : 16384;
            { EpiH E; E.o = p.h; E.ld = 11264;
              StaticOrder S; S.init(opq(Mp), opq(11264), G, bid); Gemm g; g.A = p.u + (size_t)r0 * 2048; g.Bt = p.wt_f1 + (size_t)l * 11264 * 2048; g.M = opq(Mp); g.N = opq(11264); g.K = opq(2048);

#ifndef SK_GH
              pg8::gemm_phase<EpiH, StaticOrder, false>(lds, g, S, E, nullptr);
#endif
 }
            GBAR();
#ifndef SK_CONV
            conv_phase(p, l, r0, Mp);
#endif
            GBAR();
            { EpiRes E; E.xl_in = p.out; E.xc_in = p.xc; E.xl_out = p.out; E.xc_out = p.xc; E.ga = modl + 10240; E.row_off = r0;
              StaticOrder S; S.init(opq(Mp), opq(2048), G, bid); Gemm g; g.A = p.act; g.Bt = p.wt_f2 + (size_t)l * 2048 * DFF; g.M = opq(Mp); g.N = opq(2048); g.K = opq(DFF);

#ifndef SK_GRES
          pg8::gemm_phase<EpiRes, StaticOrder, false>(lds, g, S, E, nullptr);
#endif
 }
            if (part) GBAR(); else __syncthreads();
        }
    }
    final_norm(p);
}

extern "C" void kernel_launch(void* const* d_in, const int* in_sizes, int n_in, void* d_out, int out_size, void* d_ws, size_t ws_size, hipStream_t stream) {
    (void)in_sizes; (void)n_in; (void)out_size; (void)ws_size;
    Params p{};
    const float** pf = (const float**)&p;
    for (int i = 0; i < 29; ++i) pf[i] = (const float*)d_in[i];
    p.out = (float*)d_out;
    char* w = (char*)d_ws; size_t off = 0;
    auto take = [&](size_t bytes) { char* r = w + off; off += (bytes + 255) & ~(size_t)255; return r; };
    p.bar = (unsigned*)take(XCD_BAR_WORDS * 4);
    p.mod = (float*)take((size_t)4 * MODL * 4);
    p.rope = (float*)take((size_t)4096 * 64 * 2 * 4);
    p.xc = (float*)take((size_t)2048 * 2048 * 4);
    p.wt_in = (bf16_t*)take((size_t)4 * NIN * 2048 * 2);
    p.wt_out = (bf16_t*)take((size_t)4 * 2048 * 2048 * 2);
    p.wt_f1 = (bf16_t*)take((size_t)4 * 11264 * 2048 * 2);
    p.wt_f2 = (bf16_t*)take((size_t)4 * 2048 * DFF * 2);
    p.wt_lr = (bf16_t*)take((size_t)4 * 2560 * 384 * 2);
    p.wf = (bf16_t*)take((size_t)4096 * 8192 * 2);
    p.wfc = (bf16_t*)take((size_t)256 * 512 * 2);
    p.u = (bf16_t*)take((size_t)MT * 2048 * 2);
    const size_t mix0 = off;
    p.q = (bf16_t*)take((size_t)MT * 1024 * 2);
    p.ak = (bf16_t*)take((size_t)MT * 256 * 2);
    p.vt = (bf16_t*)take((size_t)8 * 256 * 4096 * 2);
    p.vtc = (bf16_t*)take((size_t)8 * 256 * 256 * 2);
    p.rw = (bf16_t*)take((size_t)MT * 2048 * 2);
    p.ft = (bf16_t*)take((size_t)8 * 512 * 8192 * 2);
    p.ftc = (bf16_t*)take((size_t)8 * 512 * 512 * 2);
    p.dec = (bf16_t*)take((size_t)2 * MT * 512 * 2);
    p.aa = (bf16_t*)take((size_t)2 * MT * 512 * 2);
    p.gg = (bf16_t*)take((size_t)MT * 512 * 2);
    p.y = (bf16_t*)take((size_t)2 * MT * 512 * 2);
    p.a2b = p.y;
    p.fo = (bf16_t*)take((size_t)MT * 512 * 2);
    p.at = (bf16_t*)take((size_t)MT * 1024 * 2);
    p.h = (bf16_t*)(w + mix0);
    p.act = p.h + (size_t)18432 * 11264;
    static int grid = 0;
    if (!grid) {
        int dev = 0, cus = 0, per_cu = 0;
        hipGetDevice(&dev); hipDeviceGetAttribute(&cus, hipDeviceAttributeMultiprocessorCount, dev);
        if (hipFuncSetAttribute((const void*)hymba_fwd, hipFuncAttributeMaxDynamicSharedMemorySize, LDS_BYTES) != hipSuccess) fprintf(stderr, "hipFuncSetAttribute failed\n");
        if (hipOccupancyMaxActiveBlocksPerMultiprocessor(&per_cu, (const void*)hymba_fwd, 512, LDS_BYTES) != hipSuccess || per_cu < 1) { fprintf(stderr, "occupancy query failed\n"); per_cu = 1; }
        grid = cus > 0 ? cus : 256;
    }
    hipMemsetAsync(p.bar, 0, XCD_BAR_WORDS * 4, stream);
    hipLaunchKernelGGL(hymba_fwd, dim3(grid), dim3(512), LDS_BYTES, stream, p);
}
```

```cpp
#include <hip/hip_runtime.h>
#include <stdint.h>
#include <stdio.h>
#define XB_TMO      128
#define XB_XCNT(j)  (256  + 64 * (j))
#define XB_XSUB(j)  (1280 + 64 * (j))
#define XB_XGEN(j)  (2304 + 64 * (j))
#define XB_TOP      3328
#define XB_TOPGEN   3392
#define XCD_BAR_WORDS 3456
#define XB_SPIN_CAP (1u << 18)
#define LAS __attribute__((address_space(3)))

__device__ __forceinline__ unsigned xb_ld(unsigned* p)              { return __hip_atomic_load(p, __ATOMIC_RELAXED, __HIP_MEMORY_SCOPE_AGENT); }
__device__ __forceinline__ unsigned xb_add(unsigned* p, unsigned v) { return __hip_atomic_fetch_add(p, v, __ATOMIC_RELAXED, __HIP_MEMORY_SCOPE_AGENT); }
__device__ __forceinline__ unsigned xb_xcc_id() { return (unsigned)__builtin_amdgcn_s_getreg((3 << 11) | 20) & 0xFu; }
#define XB_SPIN(cond, bar) do { unsigned _sp = 0; while (cond) { __builtin_amdgcn_s_sleep(1); \
    if ((++_sp & 255u) == 0u) { if (xb_ld(&(bar)[XB_TMO])) break; if (_sp > XB_SPIN_CAP) { atomicAdd(&(bar)[XB_TMO], 1u); break; } } } } while (0)

struct XcdBarrier {
    unsigned* bar; unsigned x;
    volatile LAS unsigned* st;
};

__device__ __forceinline__ XcdBarrier xcd_barrier_post(unsigned* bar, volatile LAS unsigned* st) {
    XcdBarrier b; b.bar = bar; b.x = xb_xcc_id(); b.st = st;
    if (threadIdx.x == 0) (void)xb_add(&bar[XB_XCNT(b.x)], 1u);
    return b;
}
__device__ __forceinline__ void xcd_barrier_complete(unsigned* bar, unsigned x, unsigned& nloc, unsigned& nx) {
    const unsigned G = gridDim.x * gridDim.y * gridDim.z;
    unsigned sum, cnt, mine, sp = 0u;
    for (;;) {
        sum = 0u; cnt = 0u; mine = 0u;
#pragma unroll
        for (unsigned j = 0; j < 16; ++j) { const unsigned c = xb_ld(&bar[XB_XCNT(j)]); sum += c; cnt += (c > 0u) ? 1u : 0u; mine = (j == x) ? c : mine; }
        if (sum == G) break;
        __builtin_amdgcn_s_sleep(1);
        if ((++sp & 255u) == 0u) { if (xb_ld(&bar[XB_TMO])) break; if (sp > XB_SPIN_CAP) { atomicAdd(&bar[XB_TMO], 1u); break; } }
    }
    nloc = mine > 0u ? mine : 1u; nx = cnt > 0u ? cnt : 1u;
}

__device__ __forceinline__ void xcd_barrier(const XcdBarrier& b) {
    asm volatile("s_waitcnt vmcnt(0)" ::: "memory");
    __syncthreads();
    if (threadIdx.x == 0) {
        unsigned* bar = b.bar;
        __builtin_amdgcn_s_waitcnt(0);
        unsigned nloc = b.st[0], nx = b.st[1];
        if (nloc == 0u) { xcd_barrier_complete(bar, b.x, nloc, nx); b.st[0] = nloc; b.st[1] = nx; }
        const unsigned old = xb_add(&bar[XB_XSUB(b.x)], 1u);
        const unsigned gen = old / nloc;
        if (old + 1u == (gen + 1u) * nloc) {
            __builtin_amdgcn_fence(__ATOMIC_RELEASE, "agent");
            asm volatile("s_waitcnt vmcnt(0)" ::: "memory");
            const unsigned og = xb_add(&bar[XB_TOP], 1u);
            const unsigned tg = og / nx;
            if (og + 1u == (tg + 1u) * nx) xb_add(&bar[XB_TOPGEN], 1u);
            else XB_SPIN(xb_ld(&bar[XB_TOPGEN]) == tg, bar);
            __builtin_amdgcn_fence(__ATOMIC_ACQUIRE, "agent");
            xb_add(&bar[XB_XGEN(b.x)], 1u);
            asm volatile("s_waitcnt vmcnt(0)" ::: "memory");
        } else {
            XB_SPIN(xb_ld(&bar[XB_XGEN(b.x)]) == gen, bar);
            __builtin_amdgcn_fence(__ATOMIC_ACQUIRE, "agent");
            asm volatile("s_waitcnt vmcnt(0)" ::: "memory");
        }
    }
    __syncthreads();
}

namespace pg8 {
#define PG8_LAS __attribute__((address_space(3)))
typedef unsigned short bf16_t;
typedef short bf16x8 __attribute__((ext_vector_type(8)));
typedef float f32x4 __attribute__((ext_vector_type(4)));
typedef unsigned u32x4 __attribute__((ext_vector_type(4)));
constexpr int BM = 256, BK = 64, HALF = 128, HTB = HALF * BK * 2  , STAGE_BYTES = 8 * HTB, NXCD = 8, WGM = 8;

__host__ __device__ __forceinline__ int lds_byte(int r, int c) { const int st = (r >> 4) * 2 + (c >> 5), rr = r & 15, cc = c & 31, ob = rr * 64 + cc * 2; return st * 1024 + (ob ^ (((ob >> 9) & 1) << 5)); }
__host__ __device__ __forceinline__ void stage_rc(int b, int& R, int& C) { const int st = b / 1024, sb = b % 1024, swz = sb ^ (((sb >> 9) & 1) << 5); R = (st >> 1) * 16 + swz / 64; C = (st & 1) * 32 + (swz % 64) / 2; }
__host__ __device__ __forceinline__ int perm32(int rho) { const int n = rho >> 4, i = rho & 15; return 8 * (i >> 2) + 4 * n + (i & 3); }

struct Unit { int pm, pn; };
struct Gemm { const bf16_t* A; const bf16_t* Bt; int M, N, K; };

struct StaticOrder {
    int nM, nN, nwg, G, c;
    __host__ __device__ void init(int M, int N, int G_, int c_) { nM = M / BM; nN = N / BM; nwg = nM * nN; G = G_; c = c_; }
    __host__ __device__ bool next(int i, Unit& u) const {
        const long L = (long)i * G + c; if (L >= nwg) return false;
        int wgid = (int)L; { const int q = nwg / NXCD, r = nwg % NXCD, xcd = wgid % NXCD, off = wgid / NXCD; wgid = (xcd < r ? xcd * (q + 1) : r * (q + 1) + (xcd - r) * q) + off; }
        const int nig = WGM * nN, gid = wgid / nig, fm = gid * WGM, gsz = (nM - fm) < WGM ? (nM - fm) : WGM;
        u.pm = fm + ((wgid % nig) % gsz); u.pn = (wgid % nig) / gsz; return true;
    }
    __device__ __forceinline__ void a_ready(const Unit&) const {}
    __device__ __forceinline__ void done(const Unit&) const {}
};
__device__ __forceinline__ unsigned cvt_pk_bf16(float lo, float hi) { unsigned r; asm volatile("v_cvt_pk_bf16_f32 %0, %1, %2" : "=v"(r) : "v"(lo), "v"(hi)); return r; }
typedef float f32x2 __attribute__((ext_vector_type(2)));
__device__ __forceinline__ f32x2 gelu_pk(f32x2 v) {
    const f32x2 av = __builtin_elementwise_abs(v), d = av * 0.2316418882f + 1.0f;
    f32x2 t; t.x = __builtin_amdgcn_rcpf(d.x); t.y = __builtin_amdgcn_rcpf(d.y);
    f32x2 q = t * 0.5307027145f + (-0.7265760135f); q = q * t + 0.7107068705f; q = q * t + (-0.142248368f); q = q * t + 0.127414796f; q = q * t;
    const f32x2 s = (v * v) * (-0.72134752044f);
    f32x2 e; e.x = __builtin_amdgcn_exp2f(s.x); e.y = __builtin_amdgcn_exp2f(s.y);
    const f32x2 m = v * (q * e), r = v - m;
    f32x2 o; o.x = v.x < 0.f ? m.x : r.x; o.y = v.y < 0.f ? m.y : r.y; return o;
}

template <class Epi, class Sched, bool STAMP = false>
__device__ __forceinline__ void gemm_phase(PG8_LAS unsigned char* lds, const Gemm g, const Sched& S, const Epi& E, unsigned long long* stamps) {
    int tid_ = threadIdx.x; asm volatile("" : "+v"(tid_));
    const int tid = tid_, wid = __builtin_amdgcn_readfirstlane(tid >> 6), lane = tid & 63, wr = wid >> 2, wc = wid & 3, fr = lane & 15, fq = lane >> 4;
    const int K = g.K, nt = K / BK;
    int ts_lo = 0, ts_hi = 0, nts = 0; const unsigned long long rt_entry = STAMP ? (unsigned long long)wall_clock64() : 0ull;
#define PG8_STAMP() do { if (STAMP && wid == 0 && nts < 64) { const unsigned long long _c = (unsigned long long)clock64(); \
        ts_lo = (lane == nts) ? (int)(unsigned)_c : ts_lo; ts_hi = (lane == nts) ? (int)(unsigned)(_c >> 32) : ts_hi; ++nts; } } while (0)
    PG8_STAMP();
    unsigned voffA[2], voffB[2];
#pragma unroll
    for (int i = 0; i < 2; ++i) { int R, C; stage_rc(tid * 16 + i * 8192, R, C); const int Rb = Epi::PERM ? ((R & ~31) + perm32(R & 31)) : R;
        voffA[i] = (unsigned)(R * K + C) * 2u; voffB[i] = (unsigned)(Rb * K + C) * 2u; }
    const size_t kstep = (size_t)(BK * 2);
    const size_t hstep = (size_t)HALF * K * 2;
    const size_t tstep = 2 * hstep;
    const unsigned ldsw = (unsigned)wid * 1024u;
    const int aoff = lds_byte(wr * 64 + fr, fq * 8), boff = lds_byte(wc * 32 + fr, fq * 8);
#define PG8_SA(b, h) (((b) * 2 + (h)) * HTB)
#define PG8_SB(b, h) ((4 + (b) * 2 + (h)) * HTB)
#define PG8_STAGE(bufoff, gbase, voff) do { _Pragma("unroll") for (int _i = 0; _i < 2; ++_i) \
        __builtin_amdgcn_global_load_lds((const unsigned*)((const char*)(gbase) + (voff)[_i]), (PG8_LAS unsigned*)(lds + (bufoff) + ldsw + _i * 8192), 16, 0, 0); } while (0)
#define PG8_LDA(dst, b, h) do { _Pragma("unroll") for (int m = 0; m < 4; ++m) _Pragma("unroll") for (int k = 0; k < 2; ++k) dst[m][k] = *(const PG8_LAS bf16x8*)(lds + PG8_SA(b, h) + aoff + m * 2048 + k * 1024); } while (0)
#define PG8_LDB(dst, b, h) do { _Pragma("unroll") for (int n = 0; n < 2; ++n) _Pragma("unroll") for (int k = 0; k < 2; ++k) dst[n][k] = *(const PG8_LAS bf16x8*)(lds + PG8_SB(b, h) + boff + n * 2048 + k * 1024); } while (0)
#define PG8_MMA(ai, bj, At, Bt) do { __builtin_amdgcn_s_setprio(1); _Pragma("unroll") for (int m = 0; m < 4; ++m) _Pragma("unroll") for (int n = 0; n < 2; ++n) _Pragma("unroll") for (int k = 0; k < 2; ++k) \
        acc[ai][bj][m][n] = __builtin_amdgcn_mfma_f32_16x16x32_bf16(Bt[n][k], At[m][k], acc[ai][bj][m][n], 0, 0, 0); __builtin_amdgcn_s_setprio(0); } while (0)
#define PG8_WAIT_V(n) asm volatile("s_waitcnt vmcnt(" #n ")" ::: "memory")
#define PG8_WAIT_L(n) asm volatile("s_waitcnt lgkmcnt(" #n ")" ::: "memory")
#define PG8_BAR __builtin_amdgcn_s_barrier()
#define PG8_SCHED __builtin_amdgcn_sched_barrier(0)
    Unit cur, nxt; int ui = 0;
    if (!S.next(0, cur)) return;
    f32x4 acc[2][2][4][2];
#pragma unroll
    for (int a = 0; a < 2; ++a)
#pragma unroll
        for (int b = 0; b < 2; ++b)
#pragma unroll
            for (int m = 0; m < 4; ++m)
#pragma unroll
                for (int n = 0; n < 2; ++n) acc[a][b][m][n] = (f32x4){0.f, 0.f, 0.f, 0.f};
    bf16x8 At[4][2], B0[2][2], B1[2][2];
    const char* cA = (const char*)g.A + (size_t)cur.pm * tstep; const char* cB = (const char*)g.Bt + (size_t)cur.pn * tstep;
    S.a_ready(cur);
    PG8_STAGE(PG8_SB(0, 0), cB, voffB); PG8_STAGE(PG8_SA(0, 0), cA, voffA); PG8_STAGE(PG8_SB(0, 1), cB + hstep, voffB); PG8_STAGE(PG8_SA(0, 1), cA + hstep, voffA);
    if (wr == 1) PG8_BAR;
    PG8_WAIT_V(4); PG8_BAR;
    PG8_STAGE(PG8_SB(1, 0), cB + kstep, voffB); PG8_STAGE(PG8_SA(1, 0), cA + kstep, voffA); PG8_STAGE(PG8_SB(1, 1), cB + hstep + kstep, voffB);
    PG8_WAIT_V(6); PG8_BAR;
    PG8_STAMP();
    for (;;) {
        const bool has_next = S.next(ui + 1, nxt);
        const char* nA = has_next ? (const char*)g.A + (size_t)nxt.pm * tstep : cA; const char* nB = has_next ? (const char*)g.Bt + (size_t)nxt.pn * tstep : cB;
        for (int t = 0; t < nt; t += 2) {
            const bool last = (t == nt - 2);
            const char* a1 = cA + (size_t)(t + 1) * kstep;
            const char* a2 = last ? nA : cA + (size_t)(t + 2) * kstep; const char* b2 = last ? nB : cB + (size_t)(t + 2) * kstep;
            const char* a3 = a2 + kstep; const char* b3 = b2 + kstep;
            if (last && has_next) S.a_ready(nxt);
            PG8_LDB(B0, 0, 0); PG8_SCHED; PG8_LDA(At, 0, 0); PG8_STAGE(PG8_SA(1, 1), a1 + hstep, voffA);
            PG8_WAIT_L(8); PG8_BAR; PG8_WAIT_L(0); PG8_MMA(0, 0, At, B0); PG8_BAR; PG8_SCHED;
            PG8_LDB(B1, 0, 1); PG8_STAGE(PG8_SB(0, 0), b2, voffB);
            PG8_BAR; PG8_WAIT_L(0); PG8_MMA(0, 1, At, B1); PG8_BAR;
            PG8_LDA(At, 0, 1); PG8_STAGE(PG8_SA(0, 0), a2, voffA);
            PG8_BAR; PG8_WAIT_L(0); PG8_MMA(1, 0, At, B0); PG8_BAR; PG8_SCHED;
            PG8_STAGE(PG8_SB(0, 1), b2 + hstep, voffB);
            PG8_WAIT_V(6); PG8_BAR; PG8_MMA(1, 1, At, B1); PG8_BAR;
            PG8_LDB(B0, 1, 0); PG8_SCHED; PG8_LDA(At, 1, 0); PG8_STAGE(PG8_SA(0, 1), a2 + hstep, voffA);
            PG8_WAIT_L(8); PG8_BAR; PG8_WAIT_L(0); PG8_MMA(0, 0, At, B0); PG8_BAR; PG8_SCHED;
            PG8_LDB(B1, 1, 1); PG8_STAGE(PG8_SB(1, 0), b3, voffB);
            PG8_BAR; PG8_WAIT_L(0); PG8_MMA(0, 1, At, B1); PG8_BAR;
            PG8_LDA(At, 1, 1); PG8_STAGE(PG8_SA(1, 0), a3, voffA);
            PG8_BAR; PG8_WAIT_L(0); PG8_MMA(1, 0, At, B0); PG8_BAR; PG8_SCHED;
            PG8_STAGE(PG8_SB(1, 1), b3 + hstep, voffB);
            PG8_WAIT_V(6); PG8_BAR; PG8_MMA(1, 1, At, B1); PG8_BAR;
        }
        PG8_STAMP();
        if constexpr (!Epi::AFTER_DRAIN) { E(acc, cur, wr, wc, fr, fq); S.done(cur); }
        PG8_STAMP();
        if (!has_next) break;
#pragma unroll
        for (int a = 0; a < 2; ++a)
#pragma unroll
            for (int b = 0; b < 2; ++b)
#pragma unroll
                for (int m = 0; m < 4; ++m)
#pragma unroll
                    for (int n = 0; n < 2; ++n) acc[a][b][m][n] = (f32x4){0.f, 0.f, 0.f, 0.f};
        cur = nxt; cA = nA; cB = nB; ++ui;
    }
    PG8_WAIT_V(0);
    if (wr == 0) PG8_BAR;
    PG8_BAR;
    if constexpr (Epi::AFTER_DRAIN) { E.fused(acc, cur, wr, wc, fr, fq, lds, wid, lane); S.done(cur); }
    PG8_STAMP();
    if (STAMP && wid == 0) { stamps[lane] = lane < nts ? (((unsigned long long)(unsigned)ts_hi << 32) | (unsigned)ts_lo) : 0ull;
        if (lane == 62) stamps[62] = rt_entry; if (lane == 63) stamps[63] = (unsigned long long)wall_clock64(); }
#undef PG8_STAMP
#undef PG8_SA
#undef PG8_SB
#undef PG8_STAGE
#undef PG8_LDA
#undef PG8_LDB
#undef PG8_MMA
#undef PG8_WAIT_V
#undef PG8_WAIT_L
#undef PG8_BAR
#undef PG8_SCHED
}
}

using pg8::bf16_t; using pg8::f32x4; using pg8::bf16x8; using pg8::Unit; using pg8::Gemm; using pg8::StaticOrder;
#define MT 34816
#define ML 32768
#define NIN 4608
#define DFF 5632
#define MODL (9 * 12288)

struct Params {
    const float *x, *c, *ctx, *c_ctx, *norm1_g, *norm2_g, *w_ada, *b_ada, *w_in, *mu, *w0, *w2, *a0, *a2, *g2, *kk_scale, *ka, *rk, *lnx_w, *lnx_b, *sink, *f_g, *a_g, *w_out, *w_ffn_in, *conv_w, *conv_b, *w_ffn_out, *final_g;
    float* out; unsigned* bar; float* mod; float* rope; float* xc;
    bf16_t *wt_in, *wt_out, *wt_f1, *wt_f2, *wt_lr, *wf, *wfc, *u, *q, *ak, *vt, *vtc, *rw, *ft, *ftc, *dec, *aa, *gg, *y, *a2b, *fo, *at, *h, *act;
};

__device__ __forceinline__ int otid() { int t = threadIdx.x; asm volatile("" : "+v"(t)); return t; }
__device__ __forceinline__ bf16_t f2bf(float f) { unsigned u = __float_as_uint(f); u += 0x7FFFu + ((u >> 16) & 1u); return (bf16_t)(u >> 16); }
__device__ __forceinline__ float bf2f(bf16_t h) { return __uint_as_float(((unsigned)h) << 16); }
__device__ __forceinline__ unsigned pk2(float a, float b) { return (unsigned)f2bf(a) | ((unsigned)f2bf(b) << 16); }
__device__ __forceinline__ float lo_bf(unsigned w) { return __uint_as_float(w << 16); }
__device__ __forceinline__ float hi_bf(unsigned w) { return __uint_as_float(w & 0xffff0000u); }
__device__ __forceinline__ float wave_sum(float v) { v += __shfl_xor(v, 32); v += __shfl_xor(v, 16); v += __shfl_xor(v, 8); v += __shfl_xor(v, 4); v += __shfl_xor(v, 2); v += __shfl_xor(v, 1); return v; }
__device__ __forceinline__ float sigmoidf_(float x) { return 1.0f / (1.0f + __expf(-x)); }
template <int CTRL> __device__ __forceinline__ float dpp_add(float x) { return x + __int_as_float(__builtin_amdgcn_update_dpp(0, __float_as_int(x), CTRL, 0xf, 0xf, true)); }
__device__ __forceinline__ float sum8(float x) { x = dpp_add<0xB1>(x); x = dpp_add<0x4E>(x); x = dpp_add<0x141>(x); return x; }

__device__ __forceinline__ int srccol_in(int n) {
    if (n < 1024) return -1;
    if (n < 2304) { const int base = n < 2048 ? 512 : 3456; const int cq = n < 2048 ? n - 1024 : n - 2048; const int head = cq >> 7, pp = cq & 127, axis = pp >> 6, i = (pp & 63) >> 1, half = pp & 1; return base + head * 128 + axis * 64 + half * 32 + i; }
    if (n < 2560) return 3712 + (n - 2304);
    if (n < 3072) return 1536 + (n - 2560);
    if (n < 3584) return 2176 + (n - 3072);
    if (n < 4096) return 2688 + (n - 3584);
    if (n < 4224) return 2048 + (n - 4096);
    if (n < 4352) return 3200 + (n - 4224);
    if (n < 4480) return 3328 + (n - 4352);
    return -1;
}
__device__ __forceinline__ void xpose_tile(const float* src, int Nsrc, bf16_t* dst, int K, int n0, int k0, int mode, float* tile) {
    const int tid = otid(), nn = tid & 63, kk = tid >> 6;
    const int sc = mode ? srccol_in(n0 + nn) : (n0 + nn);
    float v[16];
#pragma unroll
    for (int pp = 0; pp < 16; ++pp) v[pp] = sc >= 0 ? src[(size_t)(k0 + kk + 8 * pp) * Nsrc + sc] : 0.f;
#pragma unroll
    for (int pp = 0; pp < 16; ++pp) tile[(kk + 8 * pp) * 65 + nn] = v[pp];
    __syncthreads();
    const int rn = tid >> 3, kc = tid & 7;
#pragma unroll
    for (int hh = 0; hh < 2; ++hh) { const int kb = hh * 64 + kc * 8; uint4 w;
        w.x = pk2(tile[(kb + 0) * 65 + rn], tile[(kb + 1) * 65 + rn]); w.y = pk2(tile[(kb + 2) * 65 + rn], tile[(kb + 3) * 65 + rn]);
        w.z = pk2(tile[(kb + 4) * 65 + rn], tile[(kb + 5) * 65 + rn]); w.w = pk2(tile[(kb + 6) * 65 + rn], tile[(kb + 7) * 65 + rn]);
        *(uint4*)(dst + (size_t)(n0 + rn) * K + k0 + kb) = w; }
    __syncthreads();
}

__device__ __forceinline__ void prologue(const Params& p, unsigned char* shm) {
    const int tid = otid(), G = gridDim.x, bid = blockIdx.x;
    float* fl = (float*)shm;
#pragma unroll 1
    for (int it = bid; it < 4 * 5632; it += G) {
        const int l = it / 5632; int r = it % 5632;
        if (r < 896) xpose_tile(p.w_in + (size_t)l * 2048 * 3968, 3968, p.wt_in + (size_t)l * NIN * 2048, 2048, 1024 + (r >> 4) * 64, (r & 15) * 128, 1, fl);
        else if (r < 1408) { r -= 896; xpose_tile(p.w_out + (size_t)l * 2048 * 2048, 2048, p.wt_out + (size_t)l * 2048 * 2048, 2048, (r >> 4) * 64, (r & 15) * 128, 0, fl); }
        else if (r < 4224) { r -= 1408; xpose_tile(p.w_ffn_in + (size_t)l * 2048 * 11264, 11264, p.wt_f1 + (size_t)l * 11264 * 2048, 2048, (r >> 4) * 64, (r & 15) * 128, 0, fl); }
        else { r -= 4224; xpose_tile(p.w_ffn_out + (size_t)l * DFF * 2048, 2048, p.wt_f2 + (size_t)l * 2048 * DFF, DFF, (r / 44) * 64, (r % 44) * 128, 0, fl); }
    }
    {
        float* wt = fl; float* ctab = fl + 64 * 129;
        if (tid < 128) ctab[tid] = cospif((float)tid / 64.0f) * 0.08838834764831845f;
        __syncthreads();
#pragma unroll 1
        for (int it = bid; it < 512; it += G) {
            const int l = it >> 7, g = (it >> 5) & 3, k0 = (it & 31) * 64;
            const float* src = p.w_in + (size_t)l * 2048 * 3968;
#pragma unroll
            for (int pp = 0; pp < 16; ++pp) { const int idx = tid + 512 * pp, kk = idx >> 7, c = idx & 127; wt[kk * 129 + c] = src[(size_t)(k0 + kk) * 3968 + g * 128 + c]; }
            __syncthreads();
            const int cp = tid & 127, kq = tid >> 7;
            unsigned oc[8], os[8];
#pragma unroll 1
            for (int k2 = 0; k2 < 8; ++k2) {
                float c0 = 0.f, s0 = 0.f, c1 = 0.f, s1 = 0.f;
                const float* r0 = wt + (kq * 16 + 2 * k2) * 129; const float* r1 = r0 + 129;
                for (int c = 0; c < 128; ++c) { const int j = (c * cp) & 127; const float cv = ctab[j], sv = ctab[(j - 32) & 127]; c0 += r0[c] * cv; s0 += r0[c] * sv; c1 += r1[c] * cv; s1 += r1[c] * sv; }
                oc[k2] = pk2(c0, c1); os[k2] = pk2(s0, s1);
            }
            bf16_t* dc = p.wt_in + (size_t)l * NIN * 2048 + (size_t)(g * 128 + cp) * 2048 + k0 + kq * 16;
            bf16_t* ds = dc + (size_t)512 * 2048;
            *(uint4*)dc = make_uint4(oc[0], oc[1], oc[2], oc[3]); *(uint4*)(dc + 8) = make_uint4(oc[4], oc[5], oc[6], oc[7]);
            *(uint4*)ds = make_uint4(os[0], os[1], os[2], os[3]); *(uint4*)(ds + 8) = make_uint4(os[4], os[5], os[6], os[7]);
            __syncthreads();
        }
    }
    {
        float* ct = fl;
        __syncthreads();
        for (int i = tid; i < 4096; i += 512) ct[i] = cospif((float)i / 2048.0f) * (1.0f / 64.0f);
        __syncthreads();
#pragma unroll 1
        for (int idx = bid * 512 + tid; idx < 4096 * 1024; idx += G * 512) {
            const int kf = idx >> 10, gi = idx & 1023, half = gi >> 9, t0 = (gi & 511) * 8;
            float v[8];
#pragma unroll
            for (int e = 0; e < 8; ++e) { const int j = (kf * (t0 + e)) & 4095; v[e] = half ? -ct[(j - 1024) & 4095] : ct[j]; }
            *(uint4*)(p.wf + (size_t)kf * 8192 + half * 4096 + t0) = make_uint4(pk2(v[0], v[1]), pk2(v[2], v[3]), pk2(v[4], v[5]), pk2(v[6], v[7]));
        }
#pragma unroll 1
        for (int idx = bid * 512 + tid; idx < 256 * 64; idx += G * 512) {
            const int kf = idx >> 6, gi = idx & 63, half = gi >> 5, t0 = (gi & 31) * 8;
            float v[8];
#pragma unroll
            for (int e = 0; e < 8; ++e) { const int j = ((kf * (t0 + e)) & 255) * 16; v[e] = 4.0f * (half ? -ct[(j - 1024) & 4095] : ct[j]); }
            *(uint4*)(p.wfc + (size_t)kf * 512 + half * 256 + t0) = make_uint4(pk2(v[0], v[1]), pk2(v[2], v[3]), pk2(v[4], v[5]), pk2(v[6], v[7]));
        }
#pragma unroll 1
        for (int idx = bid * 512 + tid; idx < 4096 * 64; idx += G * 512) {
            const int t = idx >> 6, axis = (idx >> 5) & 1, i = idx & 31;
            const float inv = powf(10000.0f, -(float)i / 32.0f); const float pos = (float)(axis ? (t & 63) : (t >> 6)); const float ang = pos * inv;
            p.rope[(size_t)idx * 2] = cosf(ang); p.rope[(size_t)idx * 2 + 1] = sinf(ang);
        }
#pragma unroll 1
        for (int idx = bid * 512 + tid; idx < 4 * 2560 * 384; idx += G * 512) {
            const int l = idx / (2560 * 384), rem = idx % (2560 * 384), n = rem / 384, k = rem % 384;
            float v = 0.f;
            if (n < 1024) { const int dir = n >> 9, ch = n & 511; if (k < 128 && (k >> 6) == dir) v = p.w2[(((size_t)l * 2 + dir) * 64 + (k & 63)) * 512 + ch]; }
            else if (n < 2048) { const int nn = n - 1024, dir = nn >> 9, ch = nn & 511; if (k >= 128 && k < 256 && ((k - 128) >> 6) == dir) v = p.a2[(((size_t)l * 2 + dir) * 64 + ((k - 128) & 63)) * 512 + ch]; }
            else { const int ch = n - 2048; if (k >= 256) v = p.g2[((size_t)l * 128 + (k - 256)) * 512 + ch]; }
            p.wt_lr[idx] = f2bf(v);
        }
        __syncthreads();
    }
    {
        float* sv = fl; float* red = fl + 9 * 2048;
        for (int i = tid; i < 9 * 2048; i += 512) { const int s = i >> 11, k = i & 2047; const float xv = s < 8 ? p.c[s * 2048 + k] : p.c_ctx[k]; sv[i] = xv / (1.0f + expf(-xv)); }
        __syncthreads();
#pragma unroll 1
        for (int it = bid; it < 768; it += G) {
            const int l = it / 192, col0 = (it % 192) * 64, cx = tid & 63, ks = tid >> 6;
            float acc[9];
#pragma unroll
            for (int s = 0; s < 9; ++s) acc[s] = 0.f;
            const float* wp = p.w_ada + (size_t)l * 2048 * 12288 + col0 + cx;
#pragma unroll 16
            for (int k = ks * 256; k < ks * 256 + 256; ++k) { const float w = wp[(size_t)k * 12288];
#pragma unroll
                for (int s = 0; s < 9; ++s) acc[s] += sv[s * 2048 + k] * w; }
#pragma unroll
            for (int s = 0; s < 9; ++s) red[(ks * 9 + s) * 64 + cx] = acc[s];
            __syncthreads();
            for (int o = tid; o < 576; o += 512) { const int s = o >> 6, cc = o & 63; float t = 0.f;
#pragma unroll
                for (int k8 = 0; k8 < 8; ++k8) t += red[(k8 * 9 + s) * 64 + cc];
                p.mod[((size_t)l * 9 + s) * 12288 + col0 + cc] = t + p.b_ada[(size_t)l * 12288 + col0 + cc]; }
            __syncthreads();
        }
    }
}

__device__ __forceinline__ void norm_mod(const float* xl, const float* xc, const float* gain, const float* modl, int shOff, int scOff, bf16_t* U) {
    const int wave = otid() >> 6, lane = otid() & 63;
#pragma unroll 1
    for (int row = blockIdx.x * 8 + wave; row < MT; row += gridDim.x * 8) {
        const float4* src = (const float4*)(row < ML ? xl + (size_t)row * 2048 : xc + (size_t)(row - ML) * 2048);
        const int s = row < ML ? (row >> 12) : 8;
        float4 v[8]; float ss = 0.f;
#pragma unroll
        for (int i = 0; i < 8; ++i) { v[i] = src[lane + 64 * i]; ss += v[i].x * v[i].x + v[i].y * v[i].y + v[i].z * v[i].z + v[i].w * v[i].w; }
        ss = wave_sum(ss);
        const float rs = rsqrtf(ss * (1.0f / 2048.0f) + 1e-6f);
        const float4* g4 = (const float4*)gain; const float4* sh4 = (const float4*)(modl + s * 12288 + shOff); const float4* sc4 = (const float4*)(modl + s * 12288 + scOff);
#pragma unroll
        for (int i = 0; i < 8; ++i) { const int ci = lane + 64 * i; const float4 g = g4[ci], sh = sh4[ci], sc = sc4[ci];
            const float o0 = v[i].x * rs * g.x * (1.0f + sc.x) + sh.x, o1 = v[i].y * rs * g.y * (1.0f + sc.y) + sh.y, o2 = v[i].z * rs * g.z * (1.0f + sc.z) + sh.z, o3 = v[i].w * rs * g.w * (1.0f + sc.w) + sh.w;
            *(uint2*)(U + (size_t)row * 2048 + ci * 4) = make_uint2(pk2(o0, o1), pk2(o2, o3)); }
    }
}

struct EpiIn {
    static constexpr bool PERM = false, AFTER_DRAIN = false;
    bf16_t *q, *ak, *vt, *vtc, *rw, *ft, *ftc; const float* rope;
    __device__ __forceinline__ void operator()(const f32x4 (&acc)[2][2][4][2], const Unit& u, int wr, int wc, int fr, int fq) const {
        asm volatile("" : "+v"(fr), "+v"(fq));
        const int pn = u.pn; const int cb = wc * 32 + 4 * fq;
#pragma unroll
        for (int ai = 0; ai < 2; ++ai)
#pragma unroll
            for (int m = 0; m < 4; ++m) {
                const int r = u.pm * 256 + ai * 128 + wr * 64 + m * 16 + fr;
                const bool lat = r < ML; const int b = lat ? (r >> 12) : ((r - ML) >> 8); const int t = lat ? (r & 4095) : ((r - ML) & 255);
                if (pn < 4) {
                    const int half = pn >> 1; const int ch0 = (pn & 1) * 256 + cb;
                    bf16_t* d = lat ? ft + ((unsigned)(b * 512 + ch0) * 8192u + half * 4096 + t) : ftc + ((unsigned)(b * 512 + ch0) * 512u + half * 256 + t);
                    const unsigned sd = lat ? 8192u : 512u;
#pragma unroll
                    for (int bj = 0; bj < 2; ++bj)
#pragma unroll
                        for (int n = 0; n < 2; ++n) { const f32x4 v = acc[ai][bj][m][n]; bf16_t* dd = d + (unsigned)(bj * 128 + n * 16) * sd;
                            dd[0] = f2bf(v[0]); dd[sd] = f2bf(v[1]); dd[2 * sd] = f2bf(v[2]); dd[3 * sd] = f2bf(v[3]); }
                } else if (pn < 9) {
                    bf16_t* d = pn < 8 ? q + ((unsigned)r * 1024u + (pn - 4) * 256 + cb) : ak + ((unsigned)r * 256u + cb);
                    const float* rp = rope + (unsigned)t * 128u;
#pragma unroll
                    for (int bj = 0; bj < 2; ++bj)
#pragma unroll
                        for (int n = 0; n < 2; ++n) { f32x4 v = acc[ai][bj][m][n];
                            if (lat) { const int pp = (cb + n * 16) & 127, axis = pp >> 6, i = (pp & 63) >> 1;
                                const float4 cs = *(const float4*)(rp + (axis * 32 + i) * 2);
                                const float a0 = v[0], b0 = v[1], a1 = v[2], b1 = v[3];
                                v[0] = a0 * cs.x - b0 * cs.y; v[1] = a0 * cs.y + b0 * cs.x; v[2] = a1 * cs.z - b1 * cs.w; v[3] = a1 * cs.w + b1 * cs.z; }
                            *(uint2*)(d + bj * 128 + n * 16) = make_uint2(pk2(v[0], v[1]), pk2(v[2], v[3])); }
                } else if (pn == 9) {
                    bf16_t* d = lat ? vt + ((unsigned)(b * 256 + cb) * 4096u + t) : vtc + ((unsigned)(b * 256 + cb) * 256u + t);
                    const unsigned sd = lat ? 4096u : 256u;
#pragma unroll
                    for (int bj = 0; bj < 2; ++bj)
#pragma unroll
                        for (int n = 0; n < 2; ++n) { const f32x4 v = acc[ai][bj][m][n]; bf16_t* dd = d + (unsigned)(bj * 128 + n * 16) * sd;
                            dd[0] = f2bf(v[0]); dd[sd] = f2bf(v[1]); dd[2 * sd] = f2bf(v[2]); dd[3 * sd] = f2bf(v[3]); }
                } else {
                    bf16_t* d = rw + ((unsigned)r * 2048u + (pn - 10) * 256 + cb);
#pragma unroll
                    for (int bj = 0; bj < 2; ++bj)
#pragma unroll
                        for (int n = 0; n < 2; ++n) { const f32x4 v = acc[ai][bj][m][n]; *(uint2*)(d + bj * 128 + n * 16) = make_uint2(pk2(v[0], v[1]), pk2(v[2], v[3])); }
                }
                __builtin_amdgcn_sched_barrier(0);
            }
    }
};
struct EpiLR {
    static constexpr bool PERM = false, AFTER_DRAIN = false;
    bf16_t *dec, *aa, *gg; const float *w0, *a0;
    __device__ __forceinline__ void operator()(const f32x4 (&acc)[2][2][4][2], const Unit& u, int wr, int wc, int fr, int fq) const {
        asm volatile("" : "+v"(fr), "+v"(fq));
        const int pn = u.pn; const int cb = wc * 32 + 4 * fq;
#pragma unroll
        for (int ai = 0; ai < 2; ++ai)
#pragma unroll
            for (int m = 0; m < 4; ++m) {
                const int r = u.pm * 256 + ai * 128 + wr * 64 + m * 16 + fr;
                if (pn < 8) {
                    const int c0 = (pn & 3) * 256 + cb;
                    const float* bias = (pn < 4 ? w0 : a0) + c0;
                    bf16_t* d = (pn < 4 ? dec : aa) + ((unsigned)((c0 >> 9) * MT + r) * 512u + (c0 & 511));
#pragma unroll
                    for (int bj = 0; bj < 2; ++bj)
#pragma unroll
                        for (int n = 0; n < 2; ++n) { f32x4 v = acc[ai][bj][m][n]; const float4 wb = *(const float4*)(bias + bj * 128 + n * 16);
                            v[0] += wb.x; v[1] += wb.y; v[2] += wb.z; v[3] += wb.w;
#pragma unroll
                            for (int e = 0; e < 4; ++e) { const float ex = __expf(-v[e]);
                                v[e] = pn < 4 ? -__expf(-(v[e] < -20.f ? -v[e] : __logf(1.0f + ex)) - 0.5f) : 1.0f / (1.0f + ex); }
                            *(uint2*)(d + bj * 128 + n * 16) = make_uint2(pk2(v[0], v[1]), pk2(v[2], v[3])); }
                } else {
                    bf16_t* d = gg + ((unsigned)r * 512u + (pn - 8) * 256 + cb);
#pragma unroll
                    for (int bj = 0; bj < 2; ++bj)
#pragma unroll
                        for (int n = 0; n < 2; ++n) { const f32x4 v = acc[ai][bj][m][n]; *(uint2*)(d + bj * 128 + n * 16) = make_uint2(pk2(v[0], v[1]), pk2(v[2], v[3])); }
                }
                __builtin_amdgcn_sched_barrier(0);
            }
    }
};
struct EpiFO {
    static constexpr bool PERM = false, AFTER_DRAIN = false;
    bf16_t* fo; int base, seqlen;
    __device__ __forceinline__ void operator()(const f32x4 (&acc)[2][2][4][2], const Unit& u, int wr, int wc, int fr, int fq) const {
        asm volatile("" : "+v"(fr), "+v"(fq));
#pragma unroll
        for (int ai = 0; ai < 2; ++ai)
#pragma unroll
            for (int m = 0; m < 4; ++m) {
                const int r = u.pm * 256 + ai * 128 + wr * 64 + m * 16 + fr;
#pragma unroll
                for (int bj = 0; bj < 2; ++bj)
#pragma unroll
                    for (int n = 0; n < 2; ++n) {
                        const int c = u.pn * 256 + bj * 128 + wc * 32 + n * 16 + 4 * fq; const f32x4 v = acc[ai][bj][m][n];
                        *(uint2*)(fo + (unsigned)(base + (c >> 9) * seqlen + r) * 512u + (c & 511)) = make_uint2(pk2(v[0], v[1]), pk2(v[2], v[3]));
                    }
                __builtin_amdgcn_sched_barrier(0);
            }
    }
};
struct EpiRes {
    static constexpr bool PERM = false, AFTER_DRAIN = false;
    const float *xl_in, *xc_in; float *xl_out, *xc_out; const float* ga; int row_off;
    __device__ __forceinline__ void operator()(const f32x4 (&acc)[2][2][4][2], const Unit& u, int wr, int wc, int fr, int fq) const {
        asm volatile("" : "+v"(fr), "+v"(fq));
#pragma unroll
        for (int ai = 0; ai < 2; ++ai)
#pragma unroll
            for (int m = 0; m < 4; ++m) {
                const int r = row_off + u.pm * 256 + ai * 128 + wr * 64 + m * 16 + fr;
                const bool lat = r < ML; const int s = lat ? (r >> 12) : 8;
                const float* xi = lat ? xl_in + (size_t)r * 2048 : xc_in + (size_t)(r - ML) * 2048;
                float* xo = lat ? xl_out + (size_t)r * 2048 : xc_out + (size_t)(r - ML) * 2048;
#pragma unroll
                for (int bj = 0; bj < 2; ++bj)
#pragma unroll
                    for (int n = 0; n < 2; ++n) {
                        const int c = u.pn * 256 + bj * 128 + wc * 32 + n * 16 + 4 * fq; const f32x4 v = acc[ai][bj][m][n];
                        const float4 xv = *(const float4*)(xi + c); const float4 g = *(const float4*)(ga + s * 12288 + c);
                        *(float4*)(xo + c) = make_float4(xv.x + g.x * v[0], xv.y + g.y * v[1], xv.z + g.z * v[2], xv.w + g.w * v[3]);
                    }
                __builtin_amdgcn_sched_barrier(0);
            }
    }
};
struct EpiH {
    static constexpr bool PERM = false, AFTER_DRAIN = false;
    bf16_t* o; int ld;
    __device__ __forceinline__ void operator()(const f32x4 (&acc)[2][2][4][2], const Unit& u, int wr, int wc, int fr, int fq) const {
        asm volatile("" : "+v"(fr), "+v"(fq));
#pragma unroll
        for (int ai = 0; ai < 2; ++ai)
#pragma unroll
            for (int m = 0; m < 4; ++m) {
                const int r = u.pm * 256 + ai * 128 + wr * 64 + m * 16 + fr;
#pragma unroll
                for (int bj = 0; bj < 2; ++bj)
#pragma unroll
                    for (int n = 0; n < 2; ++n) {
                        const int c = u.pn * 256 + bj * 128 + wc * 32 + n * 16 + 4 * fq; const f32x4 v = acc[ai][bj][m][n];
                        *(uint2*)(o + (size_t)r * ld + c) = make_uint2(pk2(v[0], v[1]), pk2(v[2], v[3]));
                    }
                __builtin_amdgcn_sched_barrier(0);
            }
    }
};

__device__ __forceinline__ void ld8(const bf16_t* ptr, float (&o)[8]) { const uint4 w = *(const uint4*)ptr; o[0] = lo_bf(w.x); o[1] = hi_bf(w.x); o[2] = lo_bf(w.y); o[3] = hi_bf(w.y); o[4] = lo_bf(w.z); o[5] = hi_bf(w.z); o[6] = lo_bf(w.w); o[7] = hi_bf(w.w); }
__device__ __forceinline__ void ld8f(const float* ptr, float (&o)[8]) { const float4 a = *(const float4*)ptr, b = *(const float4*)(ptr + 4); o[0] = a.x; o[1] = a.y; o[2] = a.z; o[3] = a.w; o[4] = b.x; o[5] = b.y; o[6] = b.z; o[7] = b.w; }
__device__ __forceinline__ void st8(bf16_t* ptr, const float (&o)[8]) { *(uint4*)ptr = make_uint4(pk2(o[0], o[1]), pk2(o[2], o[3]), pk2(o[4], o[5]), pk2(o[6], o[7])); }
__device__ __forceinline__ void smix8(const bf16_t* bp, bool hp, bool hn, const float* m0, const float* m1, float (&o)[8]) {
    float x[8], pv[8], nv[8], a[8], b[8]; ld8(bp, x); ld8f(m0, a); ld8f(m1, b);
    if (hp) ld8(bp - 2048, pv); else {
#pragma unroll
        for (int e = 0; e < 8; ++e) pv[e] = 0.f; }
    if (hn) ld8(bp + 2048, nv); else {
#pragma unroll
        for (int e = 0; e < 8; ++e) nv[e] = 0.f; }
#pragma unroll
    for (int e = 0; e < 8; ++e) o[e] = x[e] + a[e] * (pv[e] - x[e]) + b[e] * (nv[e] - x[e]);
}
__device__ __forceinline__ void seq_of(int row, int& t, int& L) { if (row < ML) { t = row & 4095; L = 4096; } else { t = (row - ML) & 255; L = 256; } }
__device__ __forceinline__ void prep_phase(const Params& p, int l) {
    const float* mu0 = p.mu + (size_t)l * 2 * 1920; const float* mu1 = mu0 + 1920;
#pragma unroll 1
    for (int idx = blockIdx.x * 512 + otid(); idx < MT * 48; idx += gridDim.x * 512) {
        const int row = idx / 48, cc = (idx % 48) * 8; int t, L; seq_of(row, t, L);
        int rc, mc; if (cc < 128) { rc = 1664 + cc; mc = 1664 + cc; } else if (cc < 256) { rc = 1792 + (cc - 128); mc = 1792 + (cc - 128); } else { rc = 1536 + (cc - 256); mc = 512 + (cc - 256); }
        float sm[8]; smix8(p.rw + (size_t)row * 2048 + rc, t > 0, t < L - 1, mu0 + mc, mu1 + mc, sm);
#pragma unroll
        for (int e = 0; e < 8; ++e) sm[e] = cc < 128 ? tanhf(sm[e]) : (cc < 256 ? sm[e] : sigmoidf_(sm[e]));
        st8(p.a2b + (size_t)row * 384 + cc, sm);
    }
}

__device__ __forceinline__ int scan_row(int st, int dir, int b, int& t, int& L) {
    if (st < 256) { t = dir ? 255 - st : st; L = 256; return ML + b * 256 + t; }
    const int s2 = st - 256; t = dir ? 4095 - s2 : s2; L = 4096; return b * 4096 + t;
}
struct ScanRaw { uint4 r0, rp, rn, k0, kp, kn, v0, vp, vn, a, e; float mp, mn; };
__device__ __forceinline__ void up8(const uint4& w, float (&o)[8]) { o[0] = lo_bf(w.x); o[1] = hi_bf(w.x); o[2] = lo_bf(w.y); o[3] = hi_bf(w.y); o[4] = lo_bf(w.z); o[5] = hi_bf(w.z); o[6] = lo_bf(w.w); o[7] = hi_bf(w.w); }
__device__ __forceinline__ void scan_load(const Params& p, int chunk, int dir, int b, int h, int pw, int lane, ScanRaw& R) {
    const int sl = pw * 8 + (lane >> 3), col = h * 64 + (lane & 7) * 8;
    int t, L; const int row = scan_row(chunk * 32 + sl, dir, b, t, L);
    const bool hp = t > 0, hn = t < L - 1; const int op = hp ? -2048 : 0, on = hn ? 2048 : 0;
    const bf16_t* bp = p.rw + (size_t)row * 2048 + col;
    R.r0 = *(const uint4*)bp; R.rp = *(const uint4*)(bp + op); R.rn = *(const uint4*)(bp + on);
    R.k0 = *(const uint4*)(bp + 512); R.kp = *(const uint4*)(bp + 512 + op); R.kn = *(const uint4*)(bp + 512 + on);
    R.v0 = *(const uint4*)(bp + 1024); R.vp = *(const uint4*)(bp + 1024 + op); R.vn = *(const uint4*)(bp + 1024 + on);
    R.a = *(const uint4*)(p.aa + ((size_t)dir * MT + row) * 512 + col); R.e = *(const uint4*)(p.dec + ((size_t)dir * MT + row) * 512 + col);
    R.mp = hp ? 1.0f : 0.0f; R.mn = hn ? 1.0f : 0.0f;
}
__device__ __forceinline__ void scan_emit(const ScanRaw& R, const float* cb, float* buf, int pw, int lane) {
    const int sl = pw * 8 + (lane >> 3), cg = lane & 7;
    float x[8], pv[8], nv[8], r[8], k[8], v[8], a[8], e[8], kk[8], m0[8], m1[8];
    up8(R.r0, x); up8(R.rp, pv); up8(R.rn, nv); ld8f(cb + cg * 8, m0); ld8f(cb + 64 + cg * 8, m1);
#pragma unroll
    for (int i = 0; i < 8; ++i) r[i] = x[i] + m0[i] * (pv[i] * R.mp - x[i]) + m1[i] * (nv[i] * R.mn - x[i]);
    up8(R.k0, x); up8(R.kp, pv); up8(R.kn, nv); ld8f(cb + 128 + cg * 8, m0); ld8f(cb + 192 + cg * 8, m1);
#pragma unroll
    for (int i = 0; i < 8; ++i) k[i] = x[i] + m0[i] * (pv[i] * R.mp - x[i]) + m1[i] * (nv[i] * R.mn - x[i]);
    up8(R.v0, x); up8(R.vp, pv); up8(R.vn, nv); ld8f(cb + 256 + cg * 8, m0); ld8f(cb + 320 + cg * 8, m1);
#pragma unroll
    for (int i = 0; i < 8; ++i) v[i] = x[i] + m0[i] * (pv[i] * R.mp - x[i]) + m1[i] * (nv[i] * R.mn - x[i]);
    up8(R.a, a); up8(R.e, e); ld8f(cb + 384 + cg * 8, m0); ld8f(cb + 448 + cg * 8, m1);
    float n2 = 0.f;
#pragma unroll
    for (int i = 0; i < 8; ++i) { kk[i] = k[i] * m0[i]; n2 += kk[i] * kk[i]; }
    n2 += __shfl_xor(n2, 1); n2 += __shfl_xor(n2, 2); n2 += __shfl_xor(n2, 4);
    const float inv = 1.0f / fmaxf(sqrtf(n2), 1e-12f);
    float* o = buf + sl * 384 + cg * 8;
#pragma unroll
    for (int i = 0; i < 8; ++i) { kk[i] *= inv; e[i] = __expf(e[i]); k[i] = k[i] * (1.0f + (a[i] - 1.0f) * m1[i]); a[i] = kk[i] * a[i]; }
    *(float4*)(o) = make_float4(e[0], e[1], e[2], e[3]); *(float4*)(o + 4) = make_float4(e[4], e[5], e[6], e[7]);
    *(float4*)(o + 64) = make_float4(kk[0], kk[1], kk[2], kk[3]); *(float4*)(o + 68) = make_float4(kk[4], kk[5], kk[6], kk[7]);
    *(float4*)(o + 128) = make_float4(a[0], a[1], a[2], a[3]); *(float4*)(o + 132) = make_float4(a[4], a[5], a[6], a[7]);
    *(float4*)(o + 192) = make_float4(k[0], k[1], k[2], k[3]); *(float4*)(o + 196) = make_float4(k[4], k[5], k[6], k[7]);
    *(float4*)(o + 256) = make_float4(r[0], r[1], r[2], r[3]); *(float4*)(o + 260) = make_float4(r[4], r[5], r[6], r[7]);
    *(float4*)(o + 320) = make_float4(v[0], v[1], v[2], v[3]); *(float4*)(o + 324) = make_float4(v[4], v[5], v[6], v[7]);
}
__device__ __forceinline__ void scan_phase(const Params& p, int l, unsigned char* shm) {
    const int tid = otid(), wave = tid >> 6, lane = tid & 63;
    float* buf0 = (float*)shm; float* buf1 = buf0 + 32 * 384;
#pragma unroll 1
    for (int wi = blockIdx.x; wi < 256; wi += gridDim.x) {
        const int dir = wi >> 7, b = (wi >> 4) & 7, h = (wi >> 1) & 7, half = wi & 1;
        const int ri = lane >> 3, cj = lane & 7, irow = half * 32 + (wave & 3) * 8 + ri;
        pg8::f32x2 s0 = {0.f, 0.f}, s1 = {0.f, 0.f}, s2 = {0.f, 0.f}, s3 = {0.f, 0.f};
        ScanRaw R; float* cb = buf0 + 2 * 32 * 384;
        __syncthreads();
        if (wave == 4) { const float* mu0 = p.mu + (size_t)l * 2 * 1920; const float* mu1 = mu0 + 1920; const int col = h * 64 + lane;
            cb[lane] = mu0[col]; cb[64 + lane] = mu1[col]; cb[128 + lane] = mu0[640 + col]; cb[192 + lane] = mu1[640 + col]; cb[256 + lane] = mu0[1152 + col]; cb[320 + lane] = mu1[1152 + col];
            cb[384 + lane] = p.kk_scale[l * 512 + col]; cb[448 + lane] = p.ka[l * 512 + col]; }
        __syncthreads();
        if (wave >= 4) {
            scan_load(p, 0, dir, b, h, wave - 4, lane, R); scan_emit(R, cb, buf0, wave - 4, lane); scan_load(p, 1, dir, b, h, wave - 4, lane, R);
        }
        __syncthreads();
#pragma unroll 1
        for (int c = 0; c < 136; ++c) {
            float* cur = (c & 1) ? buf1 : buf0; float* nxt = (c & 1) ? buf0 : buf1;
            if (wave >= 4) { if (c + 1 < 136) { scan_emit(R, cb, nxt, wave - 4, lane); if (c + 2 < 136) scan_load(p, c + 2, dir, b, h, wave - 4, lane, R); } }
            else {
#define SC_LOAD(X, SL) { const float* o_ = cur + (SL) * 384 + cj * 8; X##w0 = *(const f32x4*)(o_); X##w1 = *(const f32x4*)(o_ + 4); X##k0 = *(const f32x4*)(o_ + 64); X##k1 = *(const f32x4*)(o_ + 68); \
                    X##b0 = *(const f32x4*)(o_ + 128); X##b1 = *(const f32x4*)(o_ + 132); X##d0 = *(const f32x4*)(o_ + 192); X##d1 = *(const f32x4*)(o_ + 196); X##r0 = *(const f32x4*)(o_ + 256); X##r1 = *(const f32x4*)(o_ + 260); \
                    X##vv = cur[(SL) * 384 + 320 + irow]; }
#define SC_STEP(X, SL) { pg8::f32x2 ac = s0 * X##k0.xy; ac += s1 * X##k0.zw; ac += s2 * X##k1.xy; ac += s3 * X##k1.zw; \
                    float sa = ac.x + ac.y; sa = sum8(sa); const pg8::f32x2 sa2 = {-sa, -sa}, vv2 = {X##vv, X##vv}; \
                    s0 = s0 * X##w0.xy + sa2 * X##b0.xy + vv2 * X##d0.xy; s1 = s1 * X##w0.zw + sa2 * X##b0.zw + vv2 * X##d0.zw; s2 = s2 * X##w1.xy + sa2 * X##b1.xy + vv2 * X##d1.xy; s3 = s3 * X##w1.zw + sa2 * X##b1.zw + vv2 * X##d1.zw; \
                    pg8::f32x2 yc = s0 * X##r0.xy; yc += s1 * X##r0.zw; yc += s2 * X##r1.xy; yc += s3 * X##r1.zw; \
                    float yv = yc.x + yc.y; yv = sum8(yv); \
                    yk = (cj == ((SL) & 7)) ? yv : yk; }
                const int st0 = c * 32, row0 = c < 8 ? ML + b * 256 + (dir ? 255 - st0 : st0) : b * 4096 + (dir ? 4095 - (st0 - 256) : st0 - 256);
                bf16_t* yp = p.y + ((size_t)dir * MT + row0) * 512 + h * 64 + irow; const int ystep = dir ? -512 : 512;
                f32x4 Aw0, Aw1, Ak0, Ak1, Ab0, Ab1, Ad0, Ad1, Ar0, Ar1, Bw0, Bw1, Bk0, Bk1, Bb0, Bb1, Bd0, Bd1, Br0, Br1; float Avv, Bvv;
                SC_LOAD(A, 0)
                bf16_t* ypl = yp + cj * ystep;
#pragma unroll 1
                for (int s8 = 0; s8 < 32; s8 += 8) {
                    float yk = 0.f;
#pragma unroll
                    for (int j = 0; j < 8; j += 2) {
                        SC_LOAD(B, s8 + j + 1)
                        SC_STEP(A, j)
                        SC_LOAD(A, s8 + j + 2)
                        SC_STEP(B, j + 1)
                    }
                    ypl[s8 * ystep] = f2bf(yk);
                }
#undef SC_LOAD
#undef SC_STEP
            }
            __syncthreads();
        }
    }
}

__device__ __forceinline__ void attn_phase(const Params& p, int l, unsigned char* shm) {
    const int tid = otid(), wave = tid >> 6, lane = tid & 63, fr = lane & 15, fq = lane >> 4;
    const int g = wave >> 1, qh = wave & 1;
    bf16_t* Ks = (bf16_t*)shm;
    bf16_t* Vs = (bf16_t*)(shm + 64 * 136 * 2);
    const float scale = 0.08838834764831845f;
#pragma unroll 1
    for (int un = (int)((blockIdx.x + gridDim.x - (80u % gridDim.x)) % gridDim.x); un < (l == 3 ? 1024 : 1088); un += gridDim.x) {
        const bool lat = un < 1024; int b, qb, hk;
        if (lat) { b = un >> 7; qb = (un >> 1) & 63; hk = un & 1; } else { const int v = un - 1024; b = v >> 3; qb = (v >> 1) & 3; hk = v & 1; }
        const int q0 = qb * 64, rowbase = lat ? b * 4096 : ML + b * 256, hq = hk * 4 + g;
        bf16x8 Qf[2][4];
#pragma unroll
        for (int qt = 0; qt < 2; ++qt)
#pragma unroll
            for (int ks = 0; ks < 4; ++ks) Qf[qt][ks] = *(const bf16x8*)(p.q + (size_t)(rowbase + q0 + qh * 32 + qt * 16 + fr) * 1024 + hq * 128 + ks * 32 + fq * 8);
        const float sinkv = p.sink[l * 8 + hq];
        float mrun[2] = {sinkv, sinkv}, lsum[2]; lsum[0] = lsum[1] = (fq == 0) ? 1.0f : 0.0f;
        f32x4 O[8][2];
#pragma unroll
        for (int dt = 0; dt < 8; ++dt) { O[dt][0] = (f32x4){0.f, 0.f, 0.f, 0.f}; O[dt][1] = (f32x4){0.f, 0.f, 0.f, 0.f}; }
        const int jlo = lat ? (qb < 2 ? 2 - qb : 0) : 0, jhi = lat ? (65 - qb < 4 ? 65 - qb : 4) : -1;
        const int nloc = lat ? jhi - jlo + 1 : 0, nkb = nloc + 4;
        uint4 ra, rc, rv0, rv1;
#define AT_LOAD(I) { const int i_ = (I); const bool loc_ = i_ < nloc; const int kp_ = loc_ ? q0 - 128 + 64 * (jlo + i_) : 0, cb_ = i_ - nloc; \
            const int krow_ = loc_ ? b * 4096 + kp_ : ML + b * 256 + cb_ * 64; \
            const bf16_t* vsrc_ = loc_ ? p.vt + (size_t)(b * 256 + hk * 128) * 4096 + kp_ : p.vtc + (size_t)(b * 256 + hk * 128) * 256 + cb_ * 64; const int vstr_ = loc_ ? 4096 : 256; \
            const uint4* s1_ = (const uint4*)(p.ak + (size_t)(krow_ + (tid >> 3)) * 256 + hk * 128 + (tid & 7) * 16); ra = s1_[0]; rc = s1_[1]; \
            const uint4* s2_ = (const uint4*)(vsrc_ + (size_t)(tid >> 2) * vstr_ + (tid & 3) * 16); rv0 = s2_[0]; rv1 = s2_[1]; }
        AT_LOAD(0)
#pragma unroll 1
        for (int kb = 0; kb < nkb; ++kb) {
            const bool local = kb < nloc; const int kp0 = local ? q0 - 128 + 64 * (jlo + kb) : 0;
            __syncthreads();
            {
                const int key = tid >> 3, ch = tid & 7, dd = tid >> 2, c4 = tid & 3;
                uint4* d1 = (uint4*)(Ks + key * 136 + ch * 16); d1[0] = ra; d1[1] = rc;
                uint2* d2 = (uint2*)(Vs + dd * 68 + c4 * 16); d2[0] = make_uint2(rv0.x, rv0.y); d2[1] = make_uint2(rv0.z, rv0.w); d2[2] = make_uint2(rv1.x, rv1.y); d2[3] = make_uint2(rv1.z, rv1.w);
            }
            __syncthreads();
            if (kb + 1 < nkb) AT_LOAD(kb + 1)
            f32x4 S[4][2];
#pragma unroll
            for (int kt = 0; kt < 4; ++kt) { S[kt][0] = (f32x4){0.f, 0.f, 0.f, 0.f}; S[kt][1] = (f32x4){0.f, 0.f, 0.f, 0.f};
#pragma unroll
                for (int ks = 0; ks < 4; ++ks) { const bf16x8 Kf = *(const bf16x8*)(Ks + (kt * 16 + fr) * 136 + ks * 32 + fq * 8);
                    S[kt][0] = __builtin_amdgcn_mfma_f32_16x16x32_bf16(Kf, Qf[0][ks], S[kt][0], 0, 0, 0); S[kt][1] = __builtin_amdgcn_mfma_f32_16x16x32_bf16(Kf, Qf[1][ks], S[kt][1], 0, 0, 0); } }
#pragma unroll
            for (int qt = 0; qt < 2; ++qt) {
                const int qp = q0 + qh * 32 + qt * 16 + fr; float mx = -1e30f;
#pragma unroll
                for (int kt = 0; kt < 4; ++kt)
#pragma unroll
                    for (int e = 0; e < 4; ++e) { float sv = S[kt][qt][e] * scale; if (local) { const int dlt = kp0 + kt * 16 + 4 * fq + e - qp; if (dlt > 128 || dlt < -128) sv = -1e30f; } S[kt][qt][e] = sv; mx = fmaxf(mx, sv); }
                mx = fmaxf(mx, __shfl_xor(mx, 16)); mx = fmaxf(mx, __shfl_xor(mx, 32));
                const float mnew = fmaxf(mrun[qt], mx), alpha = __expf(mrun[qt] - mnew); mrun[qt] = mnew;
                float ps = 0.f;
#pragma unroll
                for (int kt = 0; kt < 4; ++kt)
#pragma unroll
                    for (int e = 0; e < 4; ++e) { const float pv = __expf(S[kt][qt][e] - mnew); S[kt][qt][e] = pv; ps += pv; }
                lsum[qt] = lsum[qt] * alpha + ps;
#pragma unroll
                for (int dt = 0; dt < 8; ++dt) O[dt][qt] *= alpha;
            }
#pragma unroll
            for (int kg = 0; kg < 2; ++kg) {
                bf16x8 Pf[2];
#pragma unroll
                for (int qt = 0; qt < 2; ++qt) { const uint4 w = make_uint4(pk2(S[2 * kg][qt][0], S[2 * kg][qt][1]), pk2(S[2 * kg][qt][2], S[2 * kg][qt][3]), pk2(S[2 * kg + 1][qt][0], S[2 * kg + 1][qt][1]), pk2(S[2 * kg + 1][qt][2], S[2 * kg + 1][qt][3])); Pf[qt] = *(const bf16x8*)&w; }
#pragma unroll
                for (int dt = 0; dt < 8; ++dt) {
                    const uint2 lo = *(const uint2*)(Vs + (dt * 16 + fr) * 68 + kg * 32 + 4 * fq), hi = *(const uint2*)(Vs + (dt * 16 + fr) * 68 + kg * 32 + 16 + 4 * fq);
                    const uint4 w = make_uint4(lo.x, lo.y, hi.x, hi.y); const bf16x8 Vf = *(const bf16x8*)&w;
                    O[dt][0] = __builtin_amdgcn_mfma_f32_16x16x32_bf16(Vf, Pf[0], O[dt][0], 0, 0, 0); O[dt][1] = __builtin_amdgcn_mfma_f32_16x16x32_bf16(Vf, Pf[1], O[dt][1], 0, 0, 0);
                }
            }
        }
#pragma unroll
        for (int qt = 0; qt < 2; ++qt) {
            float lt = lsum[qt]; lt += __shfl_xor(lt, 16); lt += __shfl_xor(lt, 32); const float inv = 1.0f / lt;
            bf16_t* d = p.at + (size_t)(rowbase + q0 + qh * 32 + qt * 16 + fr) * 1024 + hq * 128 + 4 * fq;
#pragma unroll
            for (int dt = 0; dt < 8; ++dt) { const f32x4 o = O[dt][qt] * inv; *(uint2*)(d + dt * 16) = make_uint2(pk2(o[0], o[1]), pk2(o[2], o[3])); }
        }
    }
#undef AT_LOAD
    __syncthreads();
}

__device__ __forceinline__ void fin_phase(const Params& p, int l, bf16_t* cat) {
    const int wave = otid() >> 6, lane = otid() & 63;
    const float* mu0 = p.mu + (size_t)l * 2 * 1920; const float* mu1 = mu0 + 1920;
#pragma unroll 1
    for (int row = blockIdx.x * 8 + wave; row < MT; row += gridDim.x * 8) {
        int t, L; seq_of(row, t, L); const bool hp = t > 0, hn = t < L - 1;
        bf16_t* co = cat + (size_t)row * 2048;
        {
            float v[8], g[8]; ld8(p.fo + (size_t)row * 512 + lane * 8, v); ld8f(p.f_g + l * 512 + lane * 8, g);
            float ss = 0.f;
#pragma unroll
            for (int e = 0; e < 8; ++e) ss += v[e] * v[e];
            ss = wave_sum(ss); const float rs = rsqrtf(ss * (1.0f / 512.0f) + 1e-6f);
#pragma unroll
            for (int e = 0; e < 8; ++e) v[e] = v[e] * rs * g[e];
            st8(co + lane * 8, v);
        }
        __builtin_amdgcn_sched_barrier(0);
        {
            float v0[8], v1[8], g0[8], g1[8]; ld8(p.at + (size_t)row * 1024 + lane * 16, v0); ld8(p.at + (size_t)row * 1024 + lane * 16 + 8, v1); ld8f(p.a_g + l * 1024 + lane * 16, g0); ld8f(p.a_g + l * 1024 + lane * 16 + 8, g1);
            float ss = 0.f;
#pragma unroll
            for (int e = 0; e < 8; ++e) ss += v0[e] * v0[e] + v1[e] * v1[e];
            ss = wave_sum(ss); const float rs = rsqrtf(ss * (1.0f / 1024.0f) + 1e-6f);
#pragma unroll
            for (int e = 0; e < 8; ++e) { v0[e] = v0[e] * rs * g0[e]; v1[e] = v1[e] * rs * g1[e]; }
            st8(co + 1024 + lane * 16, v0); st8(co + 1024 + lane * 16 + 8, v1);
        }
        __builtin_amdgcn_sched_barrier(0);
        {
            const int col = lane * 8;
            const bf16_t* bp = p.rw + (size_t)row * 2048 + col;
            float bs = 0.f;
            {   float r[8], k[8], a0[8], a1[8], kav[8], rkv[8];
                smix8(bp, hp, hn, mu0 + col, mu1 + col, r); smix8(bp + 512, hp, hn, mu0 + 640 + col, mu1 + 640 + col, k);
                ld8(p.aa + (size_t)row * 512 + col, a0); ld8(p.aa + ((size_t)MT + row) * 512 + col, a1); ld8f(p.ka + l * 512 + col, kav); ld8f(p.rk + l * 512 + col, rkv);
#pragma unroll
                for (int e = 0; e < 8; ++e) { const float kd = k[e] * (2.0f + (a0[e] + a1[e] - 2.0f) * kav[e]); bs += r[e] * kd * rkv[e]; }
                bs += __shfl_xor(bs, 1); bs += __shfl_xor(bs, 2); bs += __shfl_xor(bs, 4); }
            __builtin_amdgcn_sched_barrier(0);
            float y0[8];
            {   float y1[8]; ld8(p.y + (size_t)row * 512 + col, y0); ld8(p.y + ((size_t)MT + row) * 512 + col, y1);
                float sm = 0.f;
#pragma unroll
                for (int e = 0; e < 8; ++e) { y0[e] += y1[e]; sm += y0[e]; }
                sm += __shfl_xor(sm, 1); sm += __shfl_xor(sm, 2); sm += __shfl_xor(sm, 4);
                const float mean = sm * (1.0f / 64.0f); float vs = 0.f;
#pragma unroll
                for (int e = 0; e < 8; ++e) { y0[e] -= mean; vs += y0[e] * y0[e]; }
                vs += __shfl_xor(vs, 1); vs += __shfl_xor(vs, 2); vs += __shfl_xor(vs, 4);
                const float rs = rsqrtf(vs * (1.0f / 64.0f) + 64e-5f);
#pragma unroll
                for (int e = 0; e < 8; ++e) y0[e] *= rs; }
            __builtin_amdgcn_sched_barrier(0);
            {   float v[8], lw[8], lb[8], gv[8], o[8];
                smix8(bp + 1024, hp, hn, mu0 + 1152 + col, mu1 + 1152 + col, v);
                ld8f(p.lnx_w + l * 512 + col, lw); ld8f(p.lnx_b + l * 512 + col, lb); ld8(p.gg + (size_t)row * 512 + col, gv);
#pragma unroll
                for (int e = 0; e < 8; ++e) o[e] = (y0[e] * lw[e] + lb[e] + bs * v[e]) * gv[e];
                st8(co + 512 + col, o); }
        }
        __builtin_amdgcn_sched_barrier(0);
    }
}

__device__ __forceinline__ void conv_phase(const Params& p, int l, int r0, int Mp) {
    const float* cw = p.conv_w + (size_t)l * 3 * DFF; const float* cb = p.conv_b + (size_t)l * DFF;
#pragma unroll 1
    for (int idx = blockIdx.x * 512 + otid(); idx < Mp * 704; idx += gridDim.x * 512) {
        const int rl = idx / 704, ch = (idx % 704) * 8; int t, L; seq_of(r0 + rl, t, L);
        const bf16_t* hp_ = p.h + (size_t)rl * 11264 + ch;
        float x[8], pv[8], nv[8], up[8], w0[8], w1[8], w2[8], bb[8], o[8];
        ld8(hp_, x); ld8(hp_ + DFF, up); ld8f(cw + ch, w0); ld8f(cw + DFF + ch, w1); ld8f(cw + 2 * DFF + ch, w2); ld8f(cb + ch, bb);
        if (t > 0) ld8(hp_ - 11264, pv); else {
#pragma unroll
            for (int e = 0; e < 8; ++e) pv[e] = 0.f; }
        if (t < L - 1) ld8(hp_ + 11264, nv); else {
#pragma unroll
            for (int e = 0; e < 8; ++e) nv[e] = 0.f; }
#pragma unroll
        for (int e = 0; e < 8; e += 2) { pg8::f32x2 gt; gt.x = pv[e] * w0[e] + x[e] * w1[e] + nv[e] * w2[e] + bb[e]; gt.y = pv[e + 1] * w0[e + 1] + x[e + 1] * w1[e + 1] + nv[e + 1] * w2[e + 1] + bb[e + 1];
            const pg8::f32x2 ge = pg8::gelu_pk(gt); o[e] = ge.x * up[e]; o[e + 1] = ge.y * up[e + 1]; }
        st8(p.act + (size_t)rl * DFF + ch, o);
    }
}

__device__ __forceinline__ void final_norm(const Params& p) {
    const int wave = otid() >> 6, lane = otid() & 63;
#pragma unroll 1
    for (int row = blockIdx.x * 8 + wave; row < ML; row += gridDim.x * 8) {
        float4* src = (float4*)(p.out + (size_t)row * 2048);
        float4 v[8]; float ss = 0.f;
#pragma unroll
        for (int i = 0; i < 8; ++i) { v[i] = src[lane + 64 * i]; ss += v[i].x * v[i].x + v[i].y * v[i].y + v[i].z * v[i].z + v[i].w * v[i].w; }
        ss = wave_sum(ss); const float rs = rsqrtf(ss * (1.0f / 2048.0f) + 1e-6f);
        const float4* g4 = (const float4*)p.final_g;
#pragma unroll
        for (int i = 0; i < 8; ++i) { const float4 g = g4[lane + 64 * i]; src[lane + 64 * i] = make_float4(v[i].x * rs * g.x, v[i].y * rs * g.y, v[i].z * rs * g.z, v[i].w * rs * g.w); }
    }
}

#define LDS_BYTES (131072 + 256)
#define GBAR() xcd_barrier(bar)
__device__ __forceinline__ int opq(int v) { asm volatile("" : "+s"(v)); return v; }
__global__ void __launch_bounds__(512, 2) hymba_fwd(Params p) {
    extern __shared__ __attribute__((aligned(16))) unsigned char shm[];
    PG8_LAS unsigned char* lds = (PG8_LAS unsigned char*)shm;
    volatile LAS unsigned* st = (volatile LAS unsigned*)(lds + 131072);
    if (threadIdx.x == 0) { st[0] = 0u; st[1] = 0u; st[2] = 0u; st[3] = 0u; }
    __syncthreads();
    XcdBarrier bar = xcd_barrier_post(p.bar, st);
    const int G = gridDim.x, bid = blockIdx.x;
#ifndef SK_PRO
    prologue(p, shm);
#endif
    GBAR();
#pragma unroll 1
    for (int l = 0; l < 4; ++l) {
        const float* modl = p.mod + (size_t)l * MODL;
        const float* xl_in = l == 0 ? p.x : p.out; const float* xc_in = l == 0 ? p.ctx : p.xc;
#ifndef SK_NORM
        norm_mod(xl_in, xc_in, p.norm1_g + l * 2048, modl, 0, 2048, p.u);
#endif
        GBAR();
        { EpiIn E; E.q = p.q; E.ak = p.ak; E.vt = p.vt; E.vtc = p.vtc; E.rw = p.rw; E.ft = p.ft; E.ftc = p.ftc; E.rope = p.rope;
          StaticOrder S; S.init(opq(MT), opq(NIN), G, bid); Gemm g; g.A = p.u; g.Bt = p.wt_in + (size_t)l * NIN * 2048; g.M = opq(MT); g.N = opq(NIN); g.K = opq(2048);

#ifndef SK_GIN
          pg8::gemm_phase<EpiIn, StaticOrder, false>(lds, g, S, E, nullptr);
#endif
 }
        GBAR();
#ifndef SK_PREP
        prep_phase(p, l);
#endif
        GBAR();
        { EpiLR E; E.dec = p.dec; E.aa = p.aa; E.gg = p.gg; E.w0 = p.w0 + l * 1024; E.a0 = p.a0 + l * 1024;
          StaticOrder S; S.init(opq(MT), opq(2560), G, bid); Gemm g; g.A = p.a2b; g.Bt = p.wt_lr + (size_t)l * 2560 * 384; g.M = opq(MT); g.N = opq(2560); g.K = opq(384);

#ifndef SK_GLR
          pg8::gemm_phase<EpiLR, StaticOrder, false>(lds, g, S, E, nullptr);
#endif
 }
        __syncthreads();
        { EpiFO E; E.fo = p.fo; E.base = 0; E.seqlen = 4096;
          StaticOrder S; S.init(opq(4096), opq(4096), G, bid); Gemm g; g.A = p.wf; g.Bt = p.ft; g.M = opq(4096); g.N = opq(4096); g.K = opq(8192);

#ifndef SK_GFO
          pg8::gemm_phase<EpiFO, StaticOrder, false>(lds, g, S, E, nullptr);
#endif
 }
        __syncthreads();
        { EpiFO E; E.fo = p.fo; E.base = ML; E.seqlen = 256;
          StaticOrder S; S.init(opq(256), opq(4096), G, (bid + G - (160 % G)) % G); Gemm g; g.A = p.wfc; g.Bt = p.ftc; g.M = opq(256); g.N = opq(4096); g.K = opq(512);

#ifndef SK_GFO
          pg8::gemm_phase<EpiFO, StaticOrder, false>(lds, g, S, E, nullptr);
#endif
 }
        __syncthreads();
#ifndef SK_ATT
        attn_phase(p, l, shm);
#endif
        GBAR();
#ifndef SK_SCAN
        scan_phase(p, l, shm);
#endif
        GBAR();
#ifndef SK_FIN
        fin_phase(p, l, p.u);
#endif
        GBAR();
        { EpiRes E; E.xl_in = xl_in; E.xc_in = xc_in; E.xl_out = p.out; E.xc_out = p.xc; E.ga = modl + 4096; E.row_off = 0;
          const int Mo = l == 3 ? ML : MT;
          StaticOrder S; S.init(opq(Mo), opq(2048), G, bid); Gemm g; g.A = p.u; g.Bt = p.wt_out + (size_t)l * 2048 * 2048; g.M = opq(Mo); g.N = opq(2048); g.K = opq(2048);

#ifndef SK_GRES
          pg8::gemm_phase<EpiRes, StaticOrder, false>(lds, g, S, E, nullptr);
#endif
 }
        GBAR();
        norm_mod(p.out, p.xc, p.norm2_g + l * 2048, modl, 6144, 8192, p.u);
        GBAR();
#pragma unroll 1
        for (int part = 0; part < 2; ++part) {
            const int r0 = part ? 0 : 16384, Mp = (!part && l != 3) ? 18432 : 16384;
            { EpiH E; E.o = p.h; E.ld = 11264;
              StaticOrder S; S.init(opq(Mp), opq(11264), G, bid); Gemm g; g.A = p.u + (size_t)r0 * 2048; g.Bt = p.wt_f1 + (size_t)l * 11264 * 2048; g.M = opq(Mp); g.N = opq(11264); g.K = opq(2048);

#ifndef SK_GH
              pg8::gemm_phase<EpiH, StaticOrder, false>(lds, g, S, E, nullptr);
#endif
 }
            GBAR();
#ifndef SK_CONV
            conv_phase(p, l, r0, Mp);
#endif
            GBAR();
            { EpiRes E; E.xl_in = p.out; E.xc_in = p.xc; E.xl_out = p.out; E.xc_out = p.xc; E.ga = modl + 10240; E.row_off = r0;
              StaticOrder S; S.init(opq(Mp), opq(2048), G, bid); Gemm g; g.A = p.act; g.Bt = p.wt_f2 + (size_t)l * 2048 * DFF; g.M = opq(Mp); g.N = opq(2048); g.K = opq(DFF);

#ifndef SK_GRES
          pg8::gemm_phase<EpiRes, StaticOrder, false>(lds, g, S, E, nullptr);
#endif
 }
            if (part) GBAR(); else __syncthreads();
        }
    }
    final_norm(p);
}

extern "C" void kernel_launch(void* const* d_in, const int* in_sizes, int n_in, void* d_out, int out_size, void* d_ws, size_t ws_size, hipStream_t stream) {
    (void)in_sizes; (void)n_in; (void)out_size; (void)ws_size;
    Params p{};
    const float** pf = (const float**)&p;
    for (int i = 0; i < 29; ++i) pf[i] = (const float*)d_in[i];
    p.out = (float*)d_out;
    char* w = (char*)d_ws; size_t off = 0;
    auto take = [&](size_t bytes) { char* r = w + off; off += (bytes + 255) & ~(size_t)255; return r; };
    p.bar = (unsigned*)take(XCD_BAR_WORDS * 4);
    p.mod = (float*)take((size_t)4 * MODL * 4);
    p.rope = (float*)take((size_t)4096 * 64 * 2 * 4);
    p.xc = (float*)take((size_t)2048 * 2048 * 4);
    p.wt_in = (bf16_t*)take((size_t)4 * NIN * 2048 * 2);
    p.wt_out = (bf16_t*)take((size_t)4 * 2048 * 2048 * 2);
    p.wt_f1 = (bf16_t*)take((size_t)4 * 11264 * 2048 * 2);
    p.wt_f2 = (bf16_t*)take((size_t)4 * 2048 * DFF * 2);
    p.wt_lr = (bf16_t*)take((size_t)4 * 2560 * 384 * 2);
    p.wf = (bf16_t*)take((size_t)4096 * 8192 * 2);
    p.wfc = (bf16_t*)take((size_t)256 * 512 * 2);
    p.u = (bf16_t*)take((size_t)MT * 2048 * 2);
    const size_t mix0 = off;
    p.q = (bf16_t*)take((size_t)MT * 1024 * 2);
    p.ak = (bf16_t*)take((size_t)MT * 256 * 2);
    p.vt = (bf16_t*)take((size_t)8 * 256 * 4096 * 2);
    p.vtc = (bf16_t*)take((size_t)8 * 256 * 256 * 2);
    p.rw = (bf16_t*)take((size_t)MT * 2048 * 2);
    p.ft = (bf16_t*)take((size_t)8 * 512 * 8192 * 2);
    p.ftc = (bf16_t*)take((size_t)8 * 512 * 512 * 2);
    p.dec = (bf16_t*)take((size_t)2 * MT * 512 * 2);
    p.aa = (bf16_t*)take((size_t)2 * MT * 512 * 2);
    p.gg = (bf16_t*)take((size_t)MT * 512 * 2);
    p.y = (bf16_t*)take((size_t)2 * MT * 512 * 2);
    p.a2b = p.y;
    p.fo = (bf16_t*)take((size_t)MT * 512 * 2);
    p.at = (bf16_t*)take((size_t)MT * 1024 * 2);
    p.h = (bf16_t*)(w + mix0);
    p.act = p.h + (size_t)18432 * 11264;
    static int grid = 0;
    if (!grid) {
        int dev = 0, cus = 0, per_cu = 0;
        hipGetDevice(&dev); hipDeviceGetAttribute(&cus, hipDeviceAttributeMultiprocessorCount, dev);
        if (hipFuncSetAttribute((const void*)hymba_fwd, hipFuncAttributeMaxDynamicSharedMemorySize, LDS_BYTES) != hipSuccess) fprintf(stderr, "hipFuncSetAttribute failed\n");
        if (hipOccupancyMaxActiveBlocksPerMultiprocessor(&per_cu, (const void*)hymba_fwd, 512, LDS_BYTES) != hipSuccess || per_cu < 1) { fprintf(stderr, "occupancy query failed\n"); per_cu = 1; }
        grid = cus > 0 ? cus : 256;
    }
    hipMemsetAsync(p.bar, 0, XCD_BAR_WORDS * 4, stream);
    hipLaunchKernelGGL(hymba_fwd, dim3(grid), dim3(512), LDS_BYTES, stream, p);
}
```

```cpp
#include <hip/hip_runtime.h>
#include <stdint.h>
#include <stdio.h>
#define XB_TMO      128
#define XB_XCNT(j)  (256  + 64 * (j))
#define XB_XSUB(j)  (1280 + 64 * (j))
#define XB_XGEN(j)  (2304 + 64 * (j))
#define XB_TOP      3328
#define XB_TOPGEN   3392
#define XCD_BAR_WORDS 3456
#define XB_SPIN_CAP (1u << 18)
#define LAS __attribute__((address_space(3)))

__device__ __forceinline__ unsigned xb_ld(unsigned* p)              { return __hip_atomic_load(p, __ATOMIC_RELAXED, __HIP_MEMORY_SCOPE_AGENT); }
__device__ __forceinline__ unsigned xb_add(unsigned* p, unsigned v) { return __hip_atomic_fetch_add(p, v, __ATOMIC_RELAXED, __HIP_MEMORY_SCOPE_AGENT); }
__device__ __forceinline__ unsigned xb_xcc_id() { return (unsigned)__builtin_amdgcn_s_getreg((3 << 11) | 20) & 0xFu; }
#define XB_SPIN(cond, bar) do { unsigned _sp = 0; while (cond) { __builtin_amdgcn_s_sleep(1); \
    if ((++_sp & 255u) == 0u) { if (xb_ld(&(bar)[XB_TMO])) break; if (_sp > XB_SPIN_CAP) { atomicAdd(&(bar)[XB_TMO], 1u); break; } } } } while (0)

struct XcdBarrier {
    unsigned* bar; unsigned x;
    volatile LAS unsigned* st;
};

__device__ __forceinline__ XcdBarrier xcd_barrier_post(unsigned* bar, volatile LAS unsigned* st) {
    XcdBarrier b; b.bar = bar; b.x = xb_xcc_id(); b.st = st;
    if (threadIdx.x == 0) (void)xb_add(&bar[XB_XCNT(b.x)], 1u);
    return b;
}
__device__ __forceinline__ void xcd_barrier_complete(unsigned* bar, unsigned x, unsigned& nloc, unsigned& nx) {
    const unsigned G = gridDim.x * gridDim.y * gridDim.z;
    unsigned sum, cnt, mine, sp = 0u;
    for (;;) {
        sum = 0u; cnt = 0u; mine = 0u;
#pragma unroll
        for (unsigned j = 0; j < 16; ++j) { const unsigned c = xb_ld(&bar[XB_XCNT(j)]); sum += c; cnt += (c > 0u) ? 1u : 0u; mine = (j == x) ? c : mine; }
        if (sum == G) break;
        __builtin_amdgcn_s_sleep(1);
        if ((++sp & 255u) == 0u) { if (xb_ld(&bar[XB_TMO])) break; if (sp > XB_SPIN_CAP) { atomicAdd(&bar[XB_TMO], 1u); break; } }
    }
    nloc = mine > 0u ? mine : 1u; nx = cnt > 0u ? cnt : 1u;
}

__device__ __forceinline__ void xcd_barrier(const XcdBarrier& b) {
    asm volatile("s_waitcnt vmcnt(0)" ::: "memory");
    __syncthreads();
    if (threadIdx.x == 0) {
        unsigned* bar = b.bar;
        __builtin_amdgcn_s_waitcnt(0);
        unsigned nloc = b.st[0], nx = b.st[1];
        if (nloc == 0u) { xcd_barrier_complete(bar, b.x, nloc, nx); b.st[0] = nloc; b.st[1] = nx; }
        const unsigned old = xb_add(&bar[XB_XSUB(b.x)], 1u);
        const unsigned gen = old / nloc;
        if (old + 1u == (gen + 1u) * nloc) {
            __builtin_amdgcn_fence(__ATOMIC_RELEASE, "agent");
            asm volatile("s_waitcnt vmcnt(0)" ::: "memory");
            const unsigned og = xb_add(&bar[XB_TOP], 1u);
            const unsigned tg = og / nx;
            if (og + 1u == (tg + 1u) * nx) xb_add(&bar[XB_TOPGEN], 1u);
            else XB_SPIN(xb_ld(&bar[XB_TOPGEN]) == tg, bar);
            __builtin_amdgcn_fence(__ATOMIC_ACQUIRE, "agent");
            xb_add(&bar[XB_XGEN(b.x)], 1u);
            asm volatile("s_waitcnt vmcnt(0)" ::: "memory");
        } else {
            XB_SPIN(xb_ld(&bar[XB_XGEN(b.x)]) == gen, bar);
            __builtin_amdgcn_fence(__ATOMIC_ACQUIRE, "agent");
            asm volatile("s_waitcnt vmcnt(0)" ::: "memory");
        }
    }
    __syncthreads();
}

namespace pg8 {
#define PG8_LAS __attribute__((address_space(3)))
typedef unsigned short bf16_t;
typedef short bf16x8 __attribute__((ext_vector_type(8)));
typedef float f32x4 __attribute__((ext_vector_type(4)));
typedef unsigned u32x4 __attribute__((ext_vector_type(4)));
constexpr int BM = 256, BK = 64, HALF = 128, HTB = HALF * BK * 2  , STAGE_BYTES = 8 * HTB, NXCD = 8, WGM = 8;

__host__ __device__ __forceinline__ int lds_byte(int r, int c) { const int st = (r >> 4) * 2 + (c >> 5), rr = r & 15, cc = c & 31, ob = rr * 64 + cc * 2; return st * 1024 + (ob ^ (((ob >> 9) & 1) << 5)); }
__host__ __device__ __forceinline__ void stage_rc(int b, int& R, int& C) { const int st = b / 1024, sb = b % 1024, swz = sb ^ (((sb >> 9) & 1) << 5); R = (st >> 1) * 16 + swz / 64; C = (st & 1) * 32 + (swz % 64) / 2; }
__host__ __device__ __forceinline__ int perm32(int rho) { const int n = rho >> 4, i = rho & 15; return 8 * (i >> 2) + 4 * n + (i & 3); }

struct Unit { int pm, pn; };
struct Gemm { const bf16_t* A; const bf16_t* Bt; int M, N, K; };

struct StaticOrder {
    int nM, nN, nwg, G, c;
    __host__ __device__ void init(int M, int N, int G_, int c_) { nM = M / BM; nN = N / BM; nwg = nM * nN; G = G_; c = c_; }
    __host__ __device__ bool next(int i, Unit& u) const {
        const long L = (long)i * G + c; if (L >= nwg) return false;
        int wgid = (int)L; { const int q = nwg / NXCD, r = nwg % NXCD, xcd = wgid % NXCD, off = wgid / NXCD; wgid = (xcd < r ? xcd * (q + 1) : r * (q + 1) + (xcd - r) * q) + off; }
        const int nig = WGM * nN, gid = wgid / nig, fm = gid * WGM, gsz = (nM - fm) < WGM ? (nM - fm) : WGM;
        u.pm = fm + ((wgid % nig) % gsz); u.pn = (wgid % nig) / gsz; return true;
    }
    __device__ __forceinline__ void a_ready(const Unit&) const {}
    __device__ __forceinline__ void done(const Unit&) const {}
};
__device__ __forceinline__ unsigned cvt_pk_bf16(float lo, float hi) { unsigned r; asm volatile("v_cvt_pk_bf16_f32 %0, %1, %2" : "=v"(r) : "v"(lo), "v"(hi)); return r; }
typedef float f32x2 __attribute__((ext_vector_type(2)));
__device__ __forceinline__ f32x2 gelu_pk(f32x2 v) {
    const f32x2 av = __builtin_elementwise_abs(v), d = av * 0.2316418882f + 1.0f;
    f32x2 t; t.x = __builtin_amdgcn_rcpf(d.x); t.y = __builtin_amdgcn_rcpf(d.y);
    f32x2 q = t * 0.5307027145f + (-0.7265760135f); q = q * t + 0.7107068705f; q = q * t + (-0.142248368f); q = q * t + 0.127414796f; q = q * t;
    const f32x2 s = (v * v) * (-0.72134752044f);
    f32x2 e; e.x = __builtin_amdgcn_exp2f(s.x); e.y = __builtin_amdgcn_exp2f(s.y);
    const f32x2 m = v * (q * e), r = v - m;
    f32x2 o; o.x = v.x < 0.f ? m.x : r.x; o.y = v.y < 0.f ? m.y : r.y; return o;
}

template <class Epi, class Sched, bool STAMP = false>
__device__ __forceinline__ void gemm_phase(PG8_LAS unsigned char* lds, const Gemm g, const Sched& S, const Epi& E, unsigned long long* stamps) {
    int tid_ = threadIdx.x; asm volatile("" : "+v"(tid_));
    const int tid = tid_, wid = __builtin_amdgcn_readfirstlane(tid >> 6), lane = tid & 63, wr = wid >> 2, wc = wid & 3, fr = lane & 15, fq = lane >> 4;
    const int K = g.K, nt = K / BK;
    int ts_lo = 0, ts_hi = 0, nts = 0; const unsigned long long rt_entry = STAMP ? (unsigned long long)wall_clock64() : 0ull;
#define PG8_STAMP() do { if (STAMP && wid == 0 && nts < 64) { const unsigned long long _c = (unsigned long long)clock64(); \
        ts_lo = (lane == nts) ? (int)(unsigned)_c : ts_lo; ts_hi = (lane == nts) ? (int)(unsigned)(_c >> 32) : ts_hi; ++nts; } } while (0)
    PG8_STAMP();
    unsigned voffA[2], voffB[2];
#pragma unroll
    for (int i = 0; i < 2; ++i) { int R, C; stage_rc(tid * 16 + i * 8192, R, C); const int Rb = Epi::PERM ? ((R & ~31) + perm32(R & 31)) : R;
        voffA[i] = (unsigned)(R * K + C) * 2u; voffB[i] = (unsigned)(Rb * K + C) * 2u; }
    const size_t kstep = (size_t)(BK * 2);
    const size_t hstep = (size_t)HALF * K * 2;
    const size_t tstep = 2 * hstep;
    const unsigned ldsw = (unsigned)wid * 1024u;
    const int aoff = lds_byte(wr * 64 + fr, fq * 8), boff = lds_byte(wc * 32 + fr, fq * 8);
#define PG8_SA(b, h) (((b) * 2 + (h)) * HTB)
#define PG8_SB(b, h) ((4 + (b) * 2 + (h)) * HTB)
#define PG8_STAGE(bufoff, gbase, voff) do { _Pragma("unroll") for (int _i = 0; _i < 2; ++_i) \
        __builtin_amdgcn_global_load_lds((const unsigned*)((const char*)(gbase) + (voff)[_i]), (PG8_LAS unsigned*)(lds + (bufoff) + ldsw + _i * 8192), 16, 0, 0); } while (0)
#define PG8_LDA(dst, b, h) do { _Pragma("unroll") for (int m = 0; m < 4; ++m) _Pragma("unroll") for (int k = 0; k < 2; ++k) dst[m][k] = *(const PG8_LAS bf16x8*)(lds + PG8_SA(b, h) + aoff + m * 2048 + k * 1024); } while (0)
#define PG8_LDB(dst, b, h) do { _Pragma("unroll") for (int n = 0; n < 2; ++n) _Pragma("unroll") for (int k = 0; k < 2; ++k) dst[n][k] = *(const PG8_LAS bf16x8*)(lds + PG8_SB(b, h) + boff + n * 2048 + k * 1024); } while (0)
#define PG8_MMA(ai, bj, At, Bt) do { __builtin_amdgcn_s_setprio(1); _Pragma("unroll") for (int m = 0; m < 4; ++m) _Pragma("unroll") for (int n = 0; n < 2; ++n) _Pragma("unroll") for (int k = 0; k < 2; ++k) \
        acc[ai][bj][m][n] = __builtin_amdgcn_mfma_f32_16x16x32_bf16(Bt[n][k], At[m][k], acc[ai][bj][m][n], 0, 0, 0); __builtin_amdgcn_s_setprio(0); } while (0)
#define PG8_WAIT_V(n) asm volatile("s_waitcnt vmcnt(" #n ")" ::: "memory")
#define PG8_WAIT_L(n) asm volatile("s_waitcnt lgkmcnt(" #n ")" ::: "memory")
#define PG8_BAR __builtin_amdgcn_s_barrier()
#define PG8_SCHED __builtin_amdgcn_sched_barrier(0)
    Unit cur, nxt; int ui = 0;
    if (!S.next(0, cur)) return;
    f32x4 acc[2][2][4][2];
#pragma unroll
    for (int a = 0; a < 2; ++a)
#pragma unroll
        for (int b = 0; b < 2; ++b)
#pragma unroll
            for (int m = 0; m < 4; ++m)
#pragma unroll
                for (int n = 0; n < 2; ++n) acc[a][b][m][n] = (f32x4){0.f, 0.f, 0.f, 0.f};
    bf16x8 At[4][2], B0[2][2], B1[2][2];
    const char* cA = (const char*)g.A + (size_t)cur.pm * tstep; const char* cB = (const char*)g.Bt + (size_t)cur.pn * tstep;
    S.a_ready(cur);
    PG8_STAGE(PG8_SB(0, 0), cB, voffB); PG8_STAGE(PG8_SA(0, 0), cA, voffA); PG8_STAGE(PG8_SB(0, 1), cB + hstep, voffB); PG8_STAGE(PG8_SA(0, 1), cA + hstep, voffA);
    if (wr == 1) PG8_BAR;
    PG8_WAIT_V(4); PG8_BAR;
    PG8_STAGE(PG8_SB(1, 0), cB + kstep, voffB); PG8_STAGE(PG8_SA(1, 0), cA + kstep, voffA); PG8_STAGE(PG8_SB(1, 1), cB + hstep + kstep, voffB);
    PG8_WAIT_V(6); PG8_BAR;
    PG8_STAMP();
    for (;;) {
        const bool has_next = S.next(ui + 1, nxt);
        const char* nA = has_next ? (const char*)g.A + (size_t)nxt.pm * tstep : cA; const char* nB = has_next ? (const char*)g.Bt + (size_t)nxt.pn * tstep : cB;
        for (int t = 0; t < nt; t += 2) {
            const bool last = (t == nt - 2);
            const char* a1 = cA + (size_t)(t + 1) * kstep;
            const char* a2 = last ? nA : cA + (size_t)(t + 2) * kstep; const char* b2 = last ? nB : cB + (size_t)(t + 2) * kstep;
            const char* a3 = a2 + kstep; const char* b3 = b2 + kstep;
            if (last && has_next) S.a_ready(nxt);
            PG8_LDB(B0, 0, 0); PG8_SCHED; PG8_LDA(At, 0, 0); PG8_STAGE(PG8_SA(1, 1), a1 + hstep, voffA);
            PG8_WAIT_L(8); PG8_BAR; PG8_WAIT_L(0); PG8_MMA(0, 0, At, B0); PG8_BAR; PG8_SCHED;
            PG8_LDB(B1, 0, 1); PG8_STAGE(PG8_SB(0, 0), b2, voffB);
            PG8_BAR; PG8_WAIT_L(0); PG8_MMA(0, 1, At, B1); PG8_BAR;
            PG8_LDA(At, 0, 1); PG8_STAGE(PG8_SA(0, 0), a2, voffA);
            PG8_BAR; PG8_WAIT_L(0); PG8_MMA(1, 0, At, B0); PG8_BAR; PG8_SCHED;
            PG8_STAGE(PG8_SB(0, 1), b2 + hstep, voffB);
            PG8_WAIT_V(6); PG8_BAR; PG8_MMA(1, 1, At, B1); PG8_BAR;
            PG8_LDB(B0, 1, 0); PG8_SCHED; PG8_LDA(At, 1, 0); PG8_STAGE(PG8_SA(0, 1), a2 + hstep, voffA);
            PG8_WAIT_L(8); PG8_BAR; PG8_WAIT_L(0); PG8_MMA(0, 0, At, B0); PG8_BAR; PG8_SCHED;
            PG8_LDB(B1, 1, 1); PG8_STAGE(PG8_SB(1, 0), b3, voffB);
            PG8_BAR; PG8_WAIT_L(0); PG8_MMA(0, 1, At, B1); PG8_BAR;
            PG8_LDA(At, 1, 1); PG8_STAGE(PG8_SA(1, 0), a3, voffA);
            PG8_BAR; PG8_WAIT_L(0); PG8_MMA(1, 0, At, B0); PG8_BAR; PG8_SCHED;
            PG8_STAGE(PG8_SB(1, 1), b3 + hstep, voffB);
            PG8_WAIT_V(6); PG8_BAR; PG8_MMA(1, 1, At, B1); PG8_BAR;
        }
        PG8_STAMP();
        if constexpr (!Epi::AFTER_DRAIN) { E(acc, cur, wr, wc, fr, fq); S.done(cur); }
        PG8_STAMP();
        if (!has_next) break;
#pragma unroll
        for (int a = 0; a < 2; ++a)
#pragma unroll
            for (int b = 0; b < 2; ++b)
#pragma unroll
                for (int m = 0; m < 4; ++m)
#pragma unroll
                    for (int n = 0; n < 2; ++n) acc[a][b][m][n] = (f32x4){0.f, 0.f, 0.f, 0.f};
        cur = nxt; cA = nA; cB = nB; ++ui;
    }
    PG8_WAIT_V(0);
    if (wr == 0) PG8_BAR;
    PG8_BAR;
    if constexpr (Epi::AFTER_DRAIN) { E.fused(acc, cur, wr, wc, fr, fq, lds, wid, lane); S.done(cur); }
    PG8_STAMP();
    if (STAMP && wid == 0) { stamps[lane] = lane < nts ? (((unsigned long long)(unsigned)ts_hi << 32) | (unsigned)ts_lo) : 0ull;
        if (lane == 62) stamps[62] = rt_entry; if (lane == 63) stamps[63] = (unsigned long long)wall_clock64(); }
#undef PG8_STAMP
#undef PG8_SA
#undef PG8_SB
#undef PG8_STAGE
#undef PG8_LDA
#undef PG8_LDB
#undef PG8_MMA
#undef PG8_WAIT_V
#undef PG8_WAIT_L
#undef PG8_BAR
#undef PG8_SCHED
}
}

using pg8::bf16_t; using pg8::f32x4; using pg8::bf16x8; using pg8::Unit; using pg8::Gemm; using pg8::StaticOrder;
#define MT 34816
#define ML 32768
#define NIN 4608
#define DFF 5632
#define MODL (9 * 12288)

struct Params {
    const float *x, *c, *ctx, *c_ctx, *norm1_g, *norm2_g, *w_ada, *b_ada, *w_in, *mu, *w0, *w2, *a0, *a2, *g2, *kk_scale, *ka, *rk, *lnx_w, *lnx_b, *sink, *f_g, *a_g, *w_out, *w_ffn_in, *conv_w, *conv_b, *w_ffn_out, *final_g;
    float* out; unsigned* bar; float* mod; float* rope; float* xc;
    bf16_t *wt_in, *wt_out, *wt_f1, *wt_f2, *wt_lr, *wf, *wfc, *u, *q, *ak, *vt, *vtc, *rw, *ft, *ftc, *dec, *aa, *gg, *y, *a2b, *fo, *at, *h, *act;
};

__device__ __forceinline__ int otid() { int t = threadIdx.x; asm volatile("" : "+v"(t)); return t; }
__device__ __forceinline__ bf16_t f2bf(float f) { unsigned u = __float_as_uint(f); u += 0x7FFFu + ((u >> 16) & 1u); return (bf16_t)(u >> 16); }
__device__ __forceinline__ float bf2f(bf16_t h) { return __uint_as_float(((unsigned)h) << 16); }
__device__ __forceinline__ unsigned pk2(float a, float b) { return (unsigned)f2bf(a) | ((unsigned)f2bf(b) << 16); }
__device__ __forceinline__ float lo_bf(unsigned w) { return __uint_as_float(w << 16); }
__device__ __forceinline__ float hi_bf(unsigned w) { return __uint_as_float(w & 0xffff0000u); }
__device__ __forceinline__ float wave_sum(float v) { v += __shfl_xor(v, 32); v += __shfl_xor(v, 16); v += __shfl_xor(v, 8); v += __shfl_xor(v, 4); v += __shfl_xor(v, 2); v += __shfl_xor(v, 1); return v; }
__device__ __forceinline__ float sigmoidf_(float x) { return 1.0f / (1.0f + __expf(-x)); }
template <int CTRL> __device__ __forceinline__ float dpp_add(float x) { return x + __int_as_float(__builtin_amdgcn_update_dpp(0, __float_as_int(x), CTRL, 0xf, 0xf, true)); }
__device__ __forceinline__ float sum8(float x) { x = dpp_add<0xB1>(x); x = dpp_add<0x4E>(x); x = dpp_add<0x141>(x); return x; }

__device__ __forceinline__ int srccol_in(int n) {
    if (n < 1024) return -1;
    if (n < 2304) { const int base = n < 2048 ? 512 : 3456; const int cq = n < 2048 ? n - 1024 : n - 2048; const int head = cq >> 7, pp = cq & 127, axis = pp >> 6, i = (pp & 63) >> 1, half = pp & 1; return base + head * 128 + axis * 64 + half * 32 + i; }
    if (n < 2560) return 3712 + (n - 2304);
    if (n < 3072) return 1536 + (n - 2560);
    if (n < 3584) return 2176 + (n - 3072);
    if (n < 4096) return 2688 + (n - 3584);
    if (n < 4224) return 2048 + (n - 4096);
    if (n < 4352) return 3200 + (n - 4224);
    if (n < 4480) return 3328 + (n - 4352);
    return -1;
}
__device__ __forceinline__ void xpose_tile(const float* src, int Nsrc, bf16_t* dst, int K, int n0, int k0, int mode, float* tile) {
    const int tid = otid(), nn = tid & 63, kk = tid >> 6;
    const int sc = mode ? srccol_in(n0 + nn) : (n0 + nn);
    float v[16];
#pragma unroll
    for (int pp = 0; pp < 16; ++pp) v[pp] = sc >= 0 ? src[(size_t)(k0 + kk + 8 * pp) * Nsrc + sc] : 0.f;
#pragma unroll
    for (int pp = 0; pp < 16; ++pp) tile[(kk + 8 * pp) * 65 + nn] = v[pp];
    __syncthreads();
    const int rn = tid >> 3, kc = tid & 7;
#pragma unroll
    for (int hh = 0; hh < 2; ++hh) { const int kb = hh * 64 + kc * 8; uint4 w;
        w.x = pk2(tile[(kb + 0) * 65 + rn], tile[(kb + 1) * 65 + rn]); w.y = pk2(tile[(kb + 2) * 65 + rn], tile[(kb + 3) * 65 + rn]);
        w.z = pk2(tile[(kb + 4) * 65 + rn], tile[(kb + 5) * 65 + rn]); w.w = pk2(tile[(kb + 6) * 65 + rn], tile[(kb + 7) * 65 + rn]);
        *(uint4*)(dst + (size_t)(n0 + rn) * K + k0 + kb) = w; }
    __syncthreads();
}

__device__ __forceinline__ void prologue(const Params& p, unsigned char* shm) {
    const int tid = otid(), G = gridDim.x, bid = blockIdx.x;
    float* fl = (float*)shm;
#pragma unroll 1
    for (int it = bid; it < 4 * 5632; it += G) {
        const int l = it / 5632; int r = it % 5632;
        if (r < 896) xpose_tile(p.w_in + (size_t)l * 2048 * 3968, 3968, p.wt_in + (size_t)l * NIN * 2048, 2048, 1024 + (r >> 4) * 64, (r & 15) * 128, 1, fl);
        else if (r < 1408) { r -= 896; xpose_tile(p.w_out + (size_t)l * 2048 * 2048, 2048, p.wt_out + (size_t)l * 2048 * 2048, 2048, (r >> 4) * 64, (r & 15) * 128, 0, fl); }
        else if (r < 4224) { r -= 1408; xpose_tile(p.w_ffn_in + (size_t)l * 2048 * 11264, 11264, p.wt_f1 + (size_t)l * 11264 * 2048, 2048, (r >> 4) * 64, (r & 15) * 128, 0, fl); }
        else { r -= 4224; xpose_tile(p.w_ffn_out + (size_t)l * DFF * 2048, 2048, p.wt_f2 + (size_t)l * 2048 * DFF, DFF, (r / 44) * 64, (r % 44) * 128, 0, fl); }
    }
    {
        float* wt = fl; float* ctab = fl + 64 * 129;
        if (tid < 128) ctab[tid] = cospif((float)tid / 64.0f) * 0.08838834764831845f;
        __syncthreads();
#pragma unroll 1
        for (int it = bid; it < 512; it += G) {
            const int l = it >> 7, g = (it >> 5) & 3, k0 = (it & 31) * 64;
            const float* src = p.w_in + (size_t)l * 2048 * 3968;
#pragma unroll
            for (int pp = 0; pp < 16; ++pp) { const int idx = tid + 512 * pp, kk = idx >> 7, c = idx & 127; wt[kk * 129 + c] = src[(size_t)(k0 + kk) * 3968 + g * 128 + c]; }
            __syncthreads();
            const int cp = tid & 127, kq = tid >> 7;
            unsigned oc[8], os[8];
#pragma unroll 1
            for (int k2 = 0; k2 < 8; ++k2) {
                float c0 = 0.f, s0 = 0.f, c1 = 0.f, s1 = 0.f;
                const float* r0 = wt + (kq * 16 + 2 * k2) * 129; const float* r1 = r0 + 129;
                for (int c = 0; c < 128; ++c) { const int j = (c * cp) & 127; const float cv = ctab[j], sv = ctab[(j - 32) & 127]; c0 += r0[c] * cv; s0 += r0[c] * sv; c1 += r1[c] * cv; s1 += r1[c] * sv; }
                oc[k2] = pk2(c0, c1); os[k2] = pk2(s0, s1);
            }
            bf16_t* dc = p.wt_in + (size_t)l * NIN * 2048 + (size_t)(g * 128 + cp) * 2048 + k0 + kq * 16;
            bf16_t* ds = dc + (size_t)512 * 2048;
            *(uint4*)dc = make_uint4(oc[0], oc[1], oc[2], oc[3]); *(uint4*)(dc + 8) = make_uint4(oc[4], oc[5], oc[6], oc[7]);
            *(uint4*)ds = make_uint4(os[0], os[1], os[2], os[3]); *(uint4*)(ds + 8) = make_uint4(os[4], os[5], os[6], os[7]);
            __syncthreads();
        }
    }
    {
        float* ct = fl;
        __syncthreads();
        for (int i = tid; i < 4096; i += 512) ct[i] = cospif((float)i / 2048.0f) * (1.0f / 64.0f);
        __syncthreads();
#pragma unroll 1
        for (int idx = bid * 512 + tid; idx < 4096 * 1024; idx += G * 512) {
            const int kf = idx >> 10, gi = idx & 1023, half = gi >> 9, t0 = (gi & 511) * 8;
            float v[8];
#pragma unroll
            for (int e = 0; e < 8; ++e) { const int j = (kf * (t0 + e)) & 4095; v[e] = half ? -ct[(j - 1024) & 4095] : ct[j]; }
            *(uint4*)(p.wf + (size_t)kf * 8192 + half * 4096 + t0) = make_uint4(pk2(v[0], v[1]), pk2(v[2], v[3]), pk2(v[4], v[5]), pk2(v[6], v[7]));
        }
#pragma unroll 1
        for (int idx = bid * 512 + tid; idx < 256 * 64; idx += G * 512) {
            const int kf = idx >> 6, gi = idx & 63, half = gi >> 5, t0 = (gi & 31) * 8;
            float v[8];
#pragma unroll
            for (int e = 0; e < 8; ++e) { const int j = ((kf * (t0 + e)) & 255) * 16; v[e] = 4.0f * (half ? -ct[(j - 1024) & 4095] : ct[j]); }
            *(uint4*)(p.wfc + (size_t)kf * 512 + half * 256 + t0) = make_uint4(pk2(v[0], v[1]), pk2(v[2], v[3]), pk2(v[4], v[5]), pk2(v[6], v[7]));
        }
#pragma unroll 1
        for (int idx = bid * 512 + tid; idx < 4096 * 64; idx += G * 512) {
            const int t = idx >> 6, axis = (idx >> 5) & 1, i = idx & 31;
            const float inv = powf(10000.0f, -(float)i / 32.0f); const float pos = (float)(axis ? (t & 63) : (t >> 6)); const float ang = pos * inv;
            p.rope[(size_t)idx * 2] = cosf(ang); p.rope[(size_t)idx * 2 + 1] = sinf(ang);
        }
#pragma unroll 1
        for (int idx = bid * 512 + tid; idx < 4 * 2560 * 384; idx += G * 512) {
            const int l = idx / (2560 * 384), rem = idx % (2560 * 384), n = rem / 384, k = rem % 384;
            float v = 0.f;
            if (n < 1024) { const int dir = n >> 9, ch = n & 511; if (k < 128 && (k >> 6) == dir) v = p.w2[(((size_t)l * 2 + dir) * 64 + (k & 63)) * 512 + ch]; }
            else if (n < 2048) { const int nn = n - 1024, dir = nn >> 9, ch = nn & 511; if (k >= 128 && k < 256 && ((k - 128) >> 6) == dir) v = p.a2[(((size_t)l * 2 + dir) * 64 + ((k - 128) & 63)) * 512 + ch]; }
            else { const int ch = n - 2048; if (k >= 256) v = p.g2[((size_t)l * 128 + (k - 256)) * 512 + ch]; }
            p.wt_lr[idx] = f2bf(v);
        }
        __syncthreads();
    }
    {
        float* sv = fl; float* red = fl + 9 * 2048;
        for (int i = tid; i < 9 * 2048; i += 512) { const int s = i >> 11, k = i & 2047; const float xv = s < 8 ? p.c[s * 2048 + k] : p.c_ctx[k]; sv[i] = xv / (1.0f + expf(-xv)); }
        __syncthreads();
#pragma unroll 1
        for (int it = bid; it < 768; it += G) {
            const int l = it / 192, col0 = (it % 192) * 64, cx = tid & 63, ks = tid >> 6;
            float acc[9];
#pragma unroll
            for (int s = 0; s < 9; ++s) acc[s] = 0.f;
            const float* wp = p.w_ada + (size_t)l * 2048 * 12288 + col0 + cx;
#pragma unroll 16
            for (int k = ks * 256; k < ks * 256 + 256; ++k) { const float w = wp[(size_t)k * 12288];
#pragma unroll
                for (int s = 0; s < 9; ++s) acc[s] += sv[s * 2048 + k] * w; }
#pragma unroll
            for (int s = 0; s < 9; ++s) red[(ks * 9 + s) * 64 + cx] = acc[s];
            __syncthreads();
            for (int o = tid; o < 576; o += 512) { const int s = o >> 6, cc = o & 63; float t = 0.f;
#pragma unroll
                for (int k8 = 0; k8 < 8; ++k8) t += red[(k8 * 9 + s) * 64 + cc];
                p.mod[((size_t)l * 9 + s) * 12288 + col0 + cc] = t + p.b_ada[(size_t)l * 12288 + col0 + cc]; }
            __syncthreads();
        }
    }
}

__device__ __forceinline__ void norm_mod(const float* xl, const float* xc, const float* gain, const float* modl, int shOff, int scOff, bf16_t* U) {
    const int wave = otid() >> 6, lane = otid() & 63;
#pragma unroll 1
    for (int row = blockIdx.x * 8 + wave; row < MT; row += gridDim.x * 8) {
        const float4* src = (const float4*)(row < ML ? xl + (size_t)row * 2048 : xc + (size_t)(row - ML) * 2048);
        const int s = row < ML ? (row >> 12) : 8;
        float4 v[8]; float ss = 0.f;
#pragma unroll
        for (int i = 0; i < 8; ++i) { v[i] = src[lane + 64 * i]; ss += v[i].x * v[i].x + v[i].y * v[i].y + v[i].z * v[i].z + v[i].w * v[i].w; }
        ss = wave_sum(ss);
        const float rs = rsqrtf(ss * (1.0f / 2048.0f) + 1e-6f);
        const float4* g4 = (const float4*)gain; const float4* sh4 = (const float4*)(modl + s * 12288 + shOff); const float4* sc4 = (const float4*)(modl + s * 12288 + scOff);
#pragma unroll
        for (int i = 0; i < 8; ++i) { const int ci = lane + 64 * i; const float4 g = g4[ci], sh = sh4[ci], sc = sc4[ci];
            const float o0 = v[i].x * rs * g.x * (1.0f + sc.x) + sh.x, o1 = v[i].y * rs * g.y * (1.0f + sc.y) + sh.y, o2 = v[i].z * rs * g.z * (1.0f + sc.z) + sh.z, o3 = v[i].w * rs * g.w * (1.0f + sc.w) + sh.w;
            *(uint2*)(U + (size_t)row * 2048 + ci * 4) = make_uint2(pk2(o0, o1), pk2(o2, o3)); }
    }
}

struct EpiIn {
    static constexpr bool PERM = false, AFTER_DRAIN = false;
    bf16_t *q, *ak, *vt, *vtc, *rw, *ft, *ftc; const float* rope;
    __device__ __forceinline__ void operator()(const f32x4 (&acc)[2][2][4][2], const Unit& u, int wr, int wc, int fr, int fq) const {
        asm volatile("" : "+v"(fr), "+v"(fq));
        const int pn = u.pn; const int cb = wc * 32 + 4 * fq;
#pragma unroll
        for (int ai = 0; ai < 2; ++ai)
#pragma unroll
            for (int m = 0; m < 4; ++m) {
                const int r = u.pm * 256 + ai * 128 + wr * 64 + m * 16 + fr;
                const bool lat = r < ML; const int b = lat ? (r >> 12) : ((r - ML) >> 8); const int t = lat ? (r & 4095) : ((r - ML) & 255);
                if (pn < 4) {
                    const int half = pn >> 1; const int ch0 = (pn & 1) * 256 + cb;
                    bf16_t* d = lat ? ft + ((unsigned)(b * 512 + ch0) * 8192u + half * 4096 + t) : ftc + ((unsigned)(b * 512 + ch0) * 512u + half * 256 + t);
                    const unsigned sd = lat ? 8192u : 512u;
#pragma unroll
                    for (int bj = 0; bj < 2; ++bj)
#pragma unroll
                        for (int n = 0; n < 2; ++n) { const f32x4 v = acc[ai][bj][m][n]; bf16_t* dd = d + (unsigned)(bj * 128 + n * 16) * sd;
                            dd[0] = f2bf(v[0]); dd[sd] = f2bf(v[1]); dd[2 * sd] = f2bf(v[2]); dd[3 * sd] = f2bf(v[3]); }
                } else if (pn < 9) {
                    bf16_t* d = pn < 8 ? q + ((unsigned)r * 1024u + (pn - 4) * 256 + cb) : ak + ((unsigned)r * 256u + cb);
                    const float* rp = rope + (unsigned)t * 128u;
#pragma unroll
                    for (int bj = 0; bj < 2; ++bj)
#pragma unroll
                        for (int n = 0; n < 2; ++n) { f32x4 v = acc[ai][bj][m][n];
                            if (lat) { const int pp = (cb + n * 16) & 127, axis = pp >> 6, i = (pp & 63) >> 1;
                                const float4 cs = *(const float4*)(rp + (axis * 32 + i) * 2);
                                const float a0 = v[0], b0 = v[1], a1 = v[2], b1 = v[3];
                                v[0] = a0 * cs.x - b0 * cs.y; v[1] = a0 * cs.y + b0 * cs.x; v[2] = a1 * cs.z - b1 * cs.w; v[3] = a1 * cs.w + b1 * cs.z; }
                            *(uint2*)(d + bj * 128 + n * 16) = make_uint2(pk2(v[0], v[1]), pk2(v[2], v[3])); }
                } else if (pn == 9) {
                    bf16_t* d = lat ? vt + ((unsigned)(b * 256 + cb) * 4096u + t) : vtc + ((unsigned)(b * 256 + cb) * 256u + t);
                    const unsigned sd = lat ? 4096u : 256u;
#pragma unroll
                    for (int bj = 0; bj < 2; ++bj)
#pragma unroll
                        for (int n = 0; n < 2; ++n) { const f32x4 v = acc[ai][bj][m][n]; bf16_t* dd = d + (unsigned)(bj * 128 + n * 16) * sd;
                            dd[0] = f2bf(v[0]); dd[sd] = f2bf(v[1]); dd[2 * sd] = f2bf(v[2]); dd[3 * sd] = f2bf(v[3]); }
                } else {
                    bf16_t* d = rw + ((unsigned)r * 2048u + (pn - 10) * 256 + cb);
#pragma unroll
                    for (int bj = 0; bj < 2; ++bj)
#pragma unroll
                        for (int n = 0; n < 2; ++n) { const f32x4 v = acc[ai][bj][m][n]; *(uint2*)(d + bj * 128 + n * 16) = make_uint2(pk2(v[0], v[1]), pk2(v[2], v[3])); }
                }
                __builtin_amdgcn_sched_barrier(0);
            }
    }
};
struct EpiLR {
    static constexpr bool PERM = false, AFTER_DRAIN = false;
    bf16_t *dec, *aa, *gg; const float *w0, *a0;
    __device__ __forceinline__ void operator()(const f32x4 (&acc)[2][2][4][2], const Unit& u, int wr, int wc, int fr, int fq) const {
        asm volatile("" : "+v"(fr), "+v"(fq));
        const int pn = u.pn; const int cb = wc * 32 + 4 * fq;
#pragma unroll
        for (int ai = 0; ai < 2; ++ai)
#pragma unroll
            for (int m = 0; m < 4; ++m) {
                const int r = u.pm * 256 + ai * 128 + wr * 64 + m * 16 + fr;
                if (pn < 8) {
                    const int c0 = (pn & 3) * 256 + cb;
                    const float* bias = (pn < 4 ? w0 : a0) + c0;
                    bf16_t* d = (pn < 4 ? dec : aa) + ((unsigned)((c0 >> 9) * MT + r) * 512u + (c0 & 511));
#pragma unroll
                    for (int bj = 0; bj < 2; ++bj)
#pragma unroll
                        for (int n = 0; n < 2; ++n) { f32x4 v = acc[ai][bj][m][n]; const float4 wb = *(const float4*)(bias + bj * 128 + n * 16);
                            v[0] += wb.x; v[1] += wb.y; v[2] += wb.z; v[3] += wb.w;
#pragma unroll
                            for (int e = 0; e < 4; ++e) { const float ex = __expf(-v[e]);
                                v[e] = pn < 4 ? -__expf(-(v[e] < -20.f ? -v[e] : __logf(1.0f + ex)) - 0.5f) : 1.0f / (1.0f + ex); }
                            *(uint2*)(d + bj * 128 + n * 16) = make_uint2(pk2(v[0], v[1]), pk2(v[2], v[3])); }
                } else {
                    bf16_t* d = gg + ((unsigned)r * 512u + (pn - 8) * 256 + cb);
#pragma unroll
                    for (int bj = 0; bj < 2; ++bj)
#pragma unroll
                        for (int n = 0; n < 2; ++n) { const f32x4 v = acc[ai][bj][m][n]; *(uint2*)(d + bj * 128 + n * 16) = make_uint2(pk2(v[0], v[1]), pk2(v[2], v[3])); }
                }
                __builtin_amdgcn_sched_barrier(0);
            }
    }
};
struct EpiFO {
    static constexpr bool PERM = false, AFTER_DRAIN = false;
    bf16_t* fo; int base, seqlen;
    __device__ __forceinline__ void operator()(const f32x4 (&acc)[2][2][4][2], const Unit& u, int wr, int wc, int fr, int fq) const {
        asm volatile("" : "+v"(fr), "+v"(fq));
#pragma unroll
        for (int ai = 0; ai < 2; ++ai)
#pragma unroll
            for (int m = 0; m < 4; ++m) {
                const int r = u.pm * 256 + ai * 128 + wr * 64 + m * 16 + fr;
#pragma unroll
                for (int bj = 0; bj < 2; ++bj)
#pragma unroll
                    for (int n = 0; n < 2; ++n) {
                        const int c = u.pn * 256 + bj * 128 + wc * 32 + n * 16 + 4 * fq; const f32x4 v = acc[ai][bj][m][n];
                        *(uint2*)(fo + (unsigned)(base + (c >> 9) * seqlen + r) * 512u + (c & 511)) = make_uint2(pk2(v[0], v[1]), pk2(v[2], v[3]));
                    }
                __builtin_amdgcn_sched_barrier(0);
            }
    }
};
struct EpiRes {
    static constexpr bool PERM = false, AFTER_DRAIN = false;
    const float *xl_in, *xc_in; float *xl_out, *xc_out; const float* ga; int row_off;
    __device__ __forceinline__ void operator()(const f32x4 (&acc)[2][2][4][2], const Unit& u, int wr, int wc, int fr, int fq) const {
        asm volatile("" : "+v"(fr), "+v"(fq));
#pragma unroll
        for (int ai = 0; ai < 2; ++ai)
#pragma unroll
            for (int m = 0; m < 4; ++m) {
                const int r = row_off + u.pm * 256 + ai * 128 + wr * 64 + m * 16 + fr;
                const bool lat = r < ML; const int s = lat ? (r >> 12) : 8;
                const float* xi = lat ? xl_in + (size_t)r * 2048 : xc_in + (size_t)(r - ML) * 2048;
                float* xo = lat ? xl_out + (size_t)r * 2048 : xc_out + (size_t)(r - ML) * 2048;
#pragma unroll
                for (int bj = 0; bj < 2; ++bj)
#pragma unroll
                    for (int n = 0; n < 2; ++n) {
                        const int c = u.pn * 256 + bj * 128 + wc * 32 + n * 16 + 4 * fq; const f32x4 v = acc[ai][bj][m][n];
                        const float4 xv = *(const float4*)(xi + c); const float4 g = *(const float4*)(ga + s * 12288 + c);
                        *(float4*)(xo + c) = make_float4(xv.x + g.x * v[0], xv.y + g.y * v[1], xv.z + g.z * v[2], xv.w + g.w * v[3]);
                    }
                __builtin_amdgcn_sched_barrier(0);
            }
    }
};
struct EpiH {
    static constexpr bool PERM = false, AFTER_DRAIN = false;
    bf16_t* o; int ld;
    __device__ __forceinline__ void operator()(const f32x4 (&acc)[2][2][4][2], const Unit& u, int wr, int wc, int fr, int fq) const {
        asm volatile("" : "+v"(fr), "+v"(fq));
#pragma unroll
        for (int ai = 0; ai < 2; ++ai)
#pragma unroll
            for (int m = 0; m < 4; ++m) {
                const int r = u.pm * 256 + ai * 128 + wr * 64 + m * 16 + fr;
#pragma unroll
                for (int bj = 0; bj < 2; ++bj)
#pragma unroll
                    for (int n = 0; n < 2; ++n) {
                        const int c = u.pn * 256 + bj * 128 + wc * 32 + n * 16 + 4 * fq; const f32x4 v = acc[ai][bj][m][n];
                        *(uint2*)(o + (size_t)r * ld + c) = make_uint2(pk2(v[0], v[1]), pk2(v[2], v[3]));
                    }
                __builtin_amdgcn_sched_barrier(0);
            }
    }
};

__device__ __forceinline__ void ld8(const bf16_t* ptr, float (&o)[8]) { const uint4 w = *(const uint4*)ptr; o[0] = lo_bf(w.x); o[1] = hi_bf(w.x); o[2] = lo_bf(w.y); o[3] = hi_bf(w.y); o[4] = lo_bf(w.z); o[5] = hi_bf(w.z); o[6] = lo_bf(w.w); o[7] = hi_bf(w.w); }
__device__ __forceinline__ void ld8f(const float* ptr, float (&o)[8]) { const float4 a = *(const float4*)ptr, b = *(const float4*)(ptr + 4); o[0] = a.x; o[1] = a.y; o[2] = a.z; o[3] = a.w; o[4] = b.x; o[5] = b.y; o[6] = b.z; o[7] = b.w; }
__device__ __forceinline__ void st8(bf16_t* ptr, const float (&o)[8]) { *(uint4*)ptr = make_uint4(pk2(o[0], o[1]), pk2(o[2], o[3]), pk2(o[4], o[5]), pk2(o[6], o[7])); }
__device__ __forceinline__ void smix8(const bf16_t* bp, bool hp, bool hn, const float* m0, const float* m1, float (&o)[8]) {
    float x[8], pv[8], nv[8], a[8], b[8]; ld8(bp, x); ld8f(m0, a); ld8f(m1, b);
    if (hp) ld8(bp - 2048, pv); else {
#pragma unroll
        for (int e = 0; e < 8; ++e) pv[e] = 0.f; }
    if (hn) ld8(bp + 2048, nv); else {
#pragma unroll
        for (int e = 0; e < 8; ++e) nv[e] = 0.f; }
#pragma unroll
    for (int e = 0; e < 8; ++e) o[e] = x[e] + a[e] * (pv[e] - x[e]) + b[e] * (nv[e] - x[e]);
}
__device__ __forceinline__ void seq_of(int row, int& t, int& L) { if (row < ML) { t = row & 4095; L = 4096; } else { t = (row - ML) & 255; L = 256; } }
__device__ __forceinline__ void prep_phase(const Params& p, int l) {
    const float* mu0 = p.mu + (size_t)l * 2 * 1920; const float* mu1 = mu0 + 1920;
#pragma unroll 1
    for (int idx = blockIdx.x * 512 + otid(); idx < MT * 48; idx += gridDim.x * 512) {
        const int row = idx / 48, cc = (idx % 48) * 8; int t, L; seq_of(row, t, L);
        int rc, mc; if (cc < 128) { rc = 1664 + cc; mc = 1664 + cc; } else if (cc < 256) { rc = 1792 + (cc - 128); mc = 1792 + (cc - 128); } else { rc = 1536 + (cc - 256); mc = 512 + (cc - 256); }
        float sm[8]; smix8(p.rw + (size_t)row * 2048 + rc, t > 0, t < L - 1, mu0 + mc, mu1 + mc, sm);
#pragma unroll
        for (int e = 0; e < 8; ++e) sm[e] = cc < 128 ? tanhf(sm[e]) : (cc < 256 ? sm[e] : sigmoidf_(sm[e]));
        st8(p.a2b + (size_t)row * 384 + cc, sm);
    }
}

__device__ __forceinline__ int scan_row(int st, int dir, int b, int& t, int& L) {
    if (st < 256) { t = dir ? 255 - st : st; L = 256; return ML + b * 256 + t; }
    const int s2 = st - 256; t = dir ? 4095 - s2 : s2; L = 4096; return b * 4096 + t;
}
struct ScanRaw { uint4 r0, rp, rn, k0, kp, kn, v0, vp, vn, a, e; float mp, mn; };
__device__ __forceinline__ void up8(const uint4& w, float (&o)[8]) { o[0] = lo_bf(w.x); o[1] = hi_bf(w.x); o[2] = lo_bf(w.y); o[3] = hi_bf(w.y); o[4] = lo_bf(w.z); o[5] = hi_bf(w.z); o[6] = lo_bf(w.w); o[7] = hi_bf(w.w); }
__device__ __forceinline__ void scan_load(const Params& p, int chunk, int dir, int b, int h, int pw, int lane, ScanRaw& R) {
    const int sl = pw * 8 + (lane >> 3), col = h * 64 + (lane & 7) * 8;
    int t, L; const int row = scan_row(chunk * 32 + sl, dir, b, t, L);
    const bool hp = t > 0, hn = t < L - 1; const int op = hp ? -2048 : 0, on = hn ? 2048 : 0;
    const bf16_t* bp = p.rw + (size_t)row * 2048 + col;
    R.r0 = *(const uint4*)bp; R.rp = *(const uint4*)(bp + op); R.rn = *(const uint4*)(bp + on);
    R.k0 = *(const uint4*)(bp + 512); R.kp = *(const uint4*)(bp + 512 + op); R.kn = *(const uint4*)(bp + 512 + on);
    R.v0 = *(const uint4*)(bp + 1024); R.vp = *(const uint4*)(bp + 1024 + op); R.vn = *(const uint4*)(bp + 1024 + on);
    R.a = *(const uint4*)(p.aa + ((size_t)dir * MT + row) * 512 + col); R.e = *(const uint4*)(p.dec + ((size_t)dir * MT + row) * 512 + col);
    R.mp = hp ? 1.0f : 0.0f; R.mn = hn ? 1.0f : 0.0f;
}
__device__ __forceinline__ void scan_emit(const ScanRaw& R, const float* cb, float* buf, int pw, int lane) {
    const int sl = pw * 8 + (lane >> 3), cg = lane & 7;
    float x[8], pv[8], nv[8], r[8], k[8], v[8], a[8], e[8], kk[8], m0[8], m1[8];
    up8(R.r0, x); up8(R.rp, pv); up8(R.rn, nv); ld8f(cb + cg * 8, m0); ld8f(cb + 64 + cg * 8, m1);
#pragma unroll
    for (int i = 0; i < 8; ++i) r[i] = x[i] + m0[i] * (pv[i] * R.mp - x[i]) + m1[i] * (nv[i] * R.mn - x[i]);
    up8(R.k0, x); up8(R.kp, pv); up8(R.kn, nv); ld8f(cb + 128 + cg * 8, m0); ld8f(cb + 192 + cg * 8, m1);
#pragma unroll
    for (int i = 0; i < 8; ++i) k[i] = x[i] + m0[i] * (pv[i] * R.mp - x[i]) + m1[i] * (nv[i] * R.mn - x[i]);
    up8(R.v0, x); up8(R.vp, pv); up8(R.vn, nv); ld8f(cb + 256 + cg * 8, m0); ld8f(cb + 320 + cg * 8, m1);
#pragma unroll
    for (int i = 0; i < 8; ++i) v[i] = x[i] + m0[i] * (pv[i] * R.mp - x[i]) + m1[i] * (nv[i] * R.mn - x[i]);
    up8(R.a, a); up8(R.e, e); ld8f(cb + 384 + cg * 8, m0); ld8f(cb + 448 + cg * 8, m1);
    float n2 = 0.f;
#pragma unroll
    for (int i = 0; i < 8; ++i) { kk[i] = k[i] * m0[i]; n2 += kk[i] * kk[i]; }
    n2 += __shfl_xor(n2, 1); n2 += __shfl_xor(n2, 2); n2 += __shfl_xor(n2, 4);
    const float inv = 1.0f / fmaxf(sqrtf(n2), 1e-12f);
    float* o = buf + sl * 384 + cg * 8;
#pragma unroll
    for (int i = 0; i < 8; ++i) { kk[i] *= inv; e[i] = __expf(e[i]); k[i] = k[i] * (1.0f + (a[i] - 1.0f) * m1[i]); a[i] = kk[i] * a[i]; }
    *(float4*)(o) = make_float4(e[0], e[1], e[2], e[3]); *(float4*)(o + 4) = make_float4(e[4], e[5], e[6], e[7]);
    *(float4*)(o + 64) = make_float4(kk[0], kk[1], kk[2], kk[3]); *(float4*)(o + 68) = make_float4(kk[4], kk[5], kk[6], kk[7]);
    *(float4*)(o + 128) = make_float4(a[0], a[1], a[2], a[3]); *(float4*)(o + 132) = make_float4(a[4], a[5], a[6], a[7]);
    *(float4*)(o + 192) = make_float4(k[0], k[1], k[2], k[3]); *(float4*)(o + 196) = make_float4(k[4], k[5], k[6], k[7]);
    *(float4*)(o + 256) = make_float4(r[0], r[1], r[2], r[3]); *(float4*)(o + 260) = make_float4(r[4], r[5], r[6], r[7]);
    *(float4*)(o + 320) = make_float4(v[0], v[1], v[2], v[3]); *(float4*)(o + 324) = make_float4(v[4], v[5], v[6], v[7]);
}
__device__ __forceinline__ void scan_phase(const Params& p, int l, unsigned char* shm) {
    const int tid = otid(), wave = tid >> 6, lane = tid & 63;
    float* buf0 = (float*)shm; float* buf1 = buf0 + 32 * 384;
#pragma unroll 1
    for (int wi = blockIdx.x; wi < 256; wi += gridDim.x) {
        const int dir = wi >> 7, b = (wi >> 4) & 7, h = (wi >> 1) & 7, half = wi & 1;
        const int ri = lane >> 3, cj = lane & 7, irow = half * 32 + (wave & 3) * 8 + ri;
        pg8::f32x2 s0 = {0.f, 0.f}, s1 = {0.f, 0.f}, s2 = {0.f, 0.f}, s3 = {0.f, 0.f};
        ScanRaw R; float* cb = buf0 + 2 * 32 * 384;
        __syncthreads();
        if (wave == 4) { const float* mu0 = p.mu + (size_t)l * 2 * 1920; const float* mu1 = mu0 + 1920; const int col = h * 64 + lane;
            cb[lane] = mu0[col]; cb[64 + lane] = mu1[col]; cb[128 + lane] = mu0[640 + col]; cb[192 + lane] = mu1[640 + col]; cb[256 + lane] = mu0[1152 + col]; cb[320 + lane] = mu1[1152 + col];
            cb[384 + lane] = p.kk_scale[l * 512 + col]; cb[448 + lane] = p.ka[l * 512 + col]; }
        __syncthreads();
        if (wave >= 4) {
            scan_load(p, 0, dir, b, h, wave - 4, lane, R); scan_emit(R, cb, buf0, wave - 4, lane); scan_load(p, 1, dir, b, h, wave - 4, lane, R);
        }
        __syncthreads();
#pragma unroll 1
        for (int c = 0; c < 136; ++c) {
            float* cur = (c & 1) ? buf1 : buf0; float* nxt = (c & 1) ? buf0 : buf1;
            if (wave >= 4) { if (c + 1 < 136) { scan_emit(R, cb, nxt, wave - 4, lane); if (c + 2 < 136) scan_load(p, c + 2, dir, b, h, wave - 4, lane, R); } }
            else {
#define SC_LOAD(X, SL) { const float* o_ = cur + (SL) * 384 + cj * 8; X##w0 = *(const f32x4*)(o_); X##w1 = *(const f32x4*)(o_ + 4); X##k0 = *(const f32x4*)(o_ + 64); X##k1 = *(const f32x4*)(o_ + 68); \
                    X##b0 = *(const f32x4*)(o_ + 128); X##b1 = *(const f32x4*)(o_ + 132); X##d0 = *(const f32x4*)(o_ + 192); X##d1 = *(const f32x4*)(o_ + 196); X##r0 = *(const f32x4*)(o_ + 256); X##r1 = *(const f32x4*)(o_ + 260); \
                    X##vv = cur[(SL) * 384 + 320 + irow]; }
#define SC_STEP(X, SL) { pg8::f32x2 ac = s0 * X##k0.xy; ac += s1 * X##k0.zw; ac += s2 * X##k1.xy; ac += s3 * X##k1.zw; \
                    float sa = ac.x + ac.y; sa = sum8(sa); const pg8::f32x2 sa2 = {-sa, -sa}, vv2 = {X##vv, X##vv}; \
                    s0 = s0 * X##w0.xy + sa2 * X##b0.xy + vv2 * X##d0.xy; s1 = s1 * X##w0.zw + sa2 * X##b0.zw + vv2 * X##d0.zw; s2 = s2 * X##w1.xy + sa2 * X##b1.xy + vv2 * X##d1.xy; s3 = s3 * X##w1.zw + sa2 * X##b1.zw + vv2 * X##d1.zw; \
                    pg8::f32x2 yc = s0 * X##r0.xy; yc += s1 * X##r0.zw; yc += s2 * X##r1.xy; yc += s3 * X##r1.zw; \
                    float yv = yc.x + yc.y; yv = sum8(yv); \
                    yk = (cj == ((SL) & 7)) ? yv : yk; }
                const int st0 = c * 32, row0 = c < 8 ? ML + b * 256 + (dir ? 255 - st0 : st0) : b * 4096 + (dir ? 4095 - (st0 - 256) : st0 - 256);
                bf16_t* yp = p.y + ((size_t)dir * MT + row0) * 512 + h * 64 + irow; const int ystep = dir ? -512 : 512;
                f32x4 Aw0, Aw1, Ak0, Ak1, Ab0, Ab1, Ad0, Ad1, Ar0, Ar1, Bw0, Bw1, Bk0, Bk1, Bb0, Bb1, Bd0, Bd1, Br0, Br1; float Avv, Bvv;
                SC_LOAD(A, 0)
                bf16_t* ypl = yp + cj * ystep;
#pragma unroll 1
                for (int s8 = 0; s8 < 32; s8 += 8) {
                    float yk = 0.f;
#pragma unroll
                    for (int j = 0; j < 8; j += 2) {
                        SC_LOAD(B, s8 + j + 1)
                        SC_STEP(A, j)
                        SC_LOAD(A, s8 + j + 2)
                        SC_STEP(B, j + 1)
                    }
                    ypl[s8 * ystep] = f2bf(yk);
                }
#undef SC_LOAD
#undef SC_STEP
            }
            __syncthreads();
        }
    }
}

__device__ __forceinline__ void attn_phase(const Params& p, int l, unsigned char* shm) {
    const int tid = otid(), wave = tid >> 6, lane = tid & 63, fr = lane & 15, fq = lane >> 4;
    const int g = wave >> 1, qh = wave & 1;
    bf16_t* Ks = (bf16_t*)shm;
    bf16_t* Vs = (bf16_t*)(shm + 64 * 136 * 2);
    const float scale = 0.08838834764831845f;
#pragma unroll 1
    for (int un = (int)((blockIdx.x + gridDim.x - (80u % gridDim.x)) % gridDim.x); un < (l == 3 ? 1024 : 1088); un += gridDim.x) {
        const bool lat = un < 1024; int b, qb, hk;
        if (lat) { b = un >> 7; qb = (un >> 1) & 63; hk = un & 1; } else { const int v = un - 1024; b = v >> 3; qb = (v >> 1) & 3; hk = v & 1; }
        const int q0 = qb * 64, rowbase = lat ? b * 4096 : ML + b * 256, hq = hk * 4 + g;
        bf16x8 Qf[2][4];
#pragma unroll
        for (int qt = 0; qt < 2; ++qt)
#pragma unroll
            for (int ks = 0; ks < 4; ++ks) Qf[qt][ks] = *(const bf16x8*)(p.q + (size_t)(rowbase + q0 + qh * 32 + qt * 16 + fr) * 1024 + hq * 128 + ks * 32 + fq * 8);
        const float sinkv = p.sink[l * 8 + hq];
        float mrun[2] = {sinkv, sinkv}, lsum[2]; lsum[0] = lsum[1] = (fq == 0) ? 1.0f : 0.0f;
        f32x4 O[8][2];
#pragma unroll
        for (int dt = 0; dt < 8; ++dt) { O[dt][0] = (f32x4){0.f, 0.f, 0.f, 0.f}; O[dt][1] = (f32x4){0.f, 0.f, 0.f, 0.f}; }
        const int jlo = lat ? (qb < 2 ? 2 - qb : 0) : 0, jhi = lat ? (65 - qb < 4 ? 65 - qb : 4) : -1;
        const int nloc = lat ? jhi - jlo + 1 : 0, nkb = nloc + 4;
        uint4 ra, rc, rv0, rv1;
#define AT_LOAD(I) { const int i_ = (I); const bool loc_ = i_ < nloc; const int kp_ = loc_ ? q0 - 128 + 64 * (jlo + i_) : 0, cb_ = i_ - nloc; \
            const int krow_ = loc_ ? b * 4096 + kp_ : ML + b * 256 + cb_ * 64; \
            const bf16_t* vsrc_ = loc_ ? p.vt + (size_t)(b * 256 + hk * 128) * 4096 + kp_ : p.vtc + (size_t)(b * 256 + hk * 128) * 256 + cb_ * 64; const int vstr_ = loc_ ? 4096 : 256; \
            const uint4* s1_ = (const uint4*)(p.ak + (size_t)(krow_ + (tid >> 3)) * 256 + hk * 128 + (tid & 7) * 16); ra = s1_[0]; rc = s1_[1]; \
            const uint4* s2_ = (const uint4*)(vsrc_ + (size_t)(tid >> 2) * vstr_ + (tid & 3) * 16); rv0 = s2_[0]; rv1 = s2_[1]; }
        AT_LOAD(0)
#pragma unroll 1
        for (int kb = 0; kb < nkb; ++kb) {
            const bool local = kb < nloc; const int kp0 = local ? q0 - 128 + 64 * (jlo + kb) : 0;
            __syncthreads();
            {
                const int key = tid >> 3, ch = tid & 7, dd = tid >> 2, c4 = tid & 3;
                uint4* d1 = (uint4*)(Ks + key * 136 + ch * 16); d1[0] = ra; d1[1] = rc;
                uint2* d2 = (uint2*)(Vs + dd * 68 + c4 * 16); d2[0] = make_uint2(rv0.x, rv0.y); d2[1] = make_uint2(rv0.z, rv0.w); d2[2] = make_uint2(rv1.x, rv1.y); d2[3] = make_uint2(rv1.z, rv1.w);
            }
            __syncthreads();
            if (kb + 1 < nkb) AT_LOAD(kb + 1)
            f32x4 S[4][2];
#pragma unroll
            for (int kt = 0; kt < 4; ++kt) { S[kt][0] = (f32x4){0.f, 0.f, 0.f, 0.f}; S[kt][1] = (f32x4){0.f, 0.f, 0.f, 0.f};
#pragma unroll
                for (int ks = 0; ks < 4; ++ks) { const bf16x8 Kf = *(const bf16x8*)(Ks + (kt * 16 + fr) * 136 + ks * 32 + fq * 8);
                    S[kt][0] = __builtin_amdgcn_mfma_f32_16x16x32_bf16(Kf, Qf[0][ks], S[kt][0], 0, 0, 0); S[kt][1] = __builtin_amdgcn_mfma_f32_16x16x32_bf16(Kf, Qf[1][ks], S[kt][1], 0, 0, 0); } }
#pragma unroll
            for (int qt = 0; qt < 2; ++qt) {
                const int qp = q0 + qh * 32 + qt * 16 + fr; float mx = -1e30f;
#pragma unroll
                for (int kt = 0; kt < 4; ++kt)
#pragma unroll
                    for (int e = 0; e < 4; ++e) { float sv = S[kt][qt][e] * scale; if (local) { const int dlt = kp0 + kt * 16 + 4 * fq + e - qp; if (dlt > 128 || dlt < -128) sv = -1e30f; } S[kt][qt][e] = sv; mx = fmaxf(mx, sv); }
                mx = fmaxf(mx, __shfl_xor(mx, 16)); mx = fmaxf(mx, __shfl_xor(mx, 32));
                const float mnew = fmaxf(mrun[qt], mx), alpha = __expf(mrun[qt] - mnew); mrun[qt] = mnew;
                float ps = 0.f;
#pragma unroll
                for (int kt = 0; kt < 4; ++kt)
#pragma unroll
                    for (int e = 0; e < 4; ++e) { const float pv = __expf(S[kt][qt][e] - mnew); S[kt][qt][e] = pv; ps += pv; }
                lsum[qt] = lsum[qt] * alpha + ps;
#pragma unroll
                for (int dt = 0; dt < 8; ++dt) O[dt][qt] *= alpha;
            }
#pragma unroll
            for (int kg = 0; kg < 2; ++kg) {
                bf16x8 Pf[2];
#pragma unroll
                for (int qt = 0; qt < 2; ++qt) { const uint4 w = make_uint4(pk2(S[2 * kg][qt][0], S[2 * kg][qt][1]), pk2(S[2 * kg][qt][2], S[2 * kg][qt][3]), pk2(S[2 * kg + 1][qt][0], S[2 * kg + 1][qt][1]), pk2(S[2 * kg + 1][qt][2], S[2 * kg + 1][qt][3])); Pf[qt] = *(const bf16x8*)&w; }
#pragma unroll
                for (int dt = 0; dt < 8; ++dt) {
                    const uint2 lo = *(const uint2*)(Vs + (dt * 16 + fr) * 68 + kg * 32 + 4 * fq), hi = *(const uint2*)(Vs + (dt * 16 + fr) * 68 + kg * 32 + 16 + 4 * fq);
                    const uint4 w = make_uint4(lo.x, lo.y, hi.x, hi.y); const bf16x8 Vf = *(const bf16x8*)&w;
                    O[dt][0] = __builtin_amdgcn_mfma_f32_16x16x32_bf16(Vf, Pf[0], O[dt][0], 0, 0, 0); O[dt][1] = __builtin_amdgcn_mfma_f32_16x16x32_bf16(Vf, Pf[1], O[dt][1], 0, 0, 0);
                }
            }
        }
#pragma unroll
        for (int qt = 0; qt < 2; ++qt) {
            float lt = lsum[qt]; lt += __shfl_xor(lt, 16); lt += __shfl_xor(lt, 32); const float inv = 1.0f / lt;
            bf16_t* d = p.at + (size_t)(rowbase + q0 + qh * 32 + qt * 16 + fr) * 1024 + hq * 128 + 4 * fq;
#pragma unroll
            for (int dt = 0; dt < 8; ++dt) { const f32x4 o = O[dt][qt] * inv; *(uint2*)(d + dt * 16) = make_uint2(pk2(o[0], o[1]), pk2(o[2], o[3])); }
        }
    }
#undef AT_LOAD
    __syncthreads();
}

__device__ __forceinline__ void fin_phase(const Params& p, int l, bf16_t* cat) {
    const int wave = otid() >> 6, lane = otid() & 63;
    const float* mu0 = p.mu + (size_t)l * 2 * 1920; const float* mu1 = mu0 + 1920;
#pragma unroll 1
    for (int row = blockIdx.x * 8 + wave; row < MT; row += gridDim.x * 8) {
        int t, L; seq_of(row, t, L); const bool hp = t > 0, hn = t < L - 1;
        bf16_t* co = cat + (size_t)row * 2048;
        {
            float v[8], g[8]; ld8(p.fo + (size_t)row * 512 + lane * 8, v); ld8f(p.f_g + l * 512 + lane * 8, g);
            float ss = 0.f;
#pragma unroll
            for (int e = 0; e < 8; ++e) ss += v[e] * v[e];
            ss = wave_sum(ss); const float rs = rsqrtf(ss * (1.0f / 512.0f) + 1e-6f);
#pragma unroll
            for (int e = 0; e < 8; ++e) v[e] = v[e] * rs * g[e];
            st8(co + lane * 8, v);
        }
        __builtin_amdgcn_sched_barrier(0);
        {
            float v0[8], v1[8], g0[8], g1[8]; ld8(p.at + (size_t)row * 1024 + lane * 16, v0); ld8(p.at + (size_t)row * 1024 + lane * 16 + 8, v1); ld8f(p.a_g + l * 1024 + lane * 16, g0); ld8f(p.a_g + l * 1024 + lane * 16 + 8, g1);
            float ss = 0.f;
#pragma unroll
            for (int e = 0; e < 8; ++e) ss += v0[e] * v0[e] + v1[e] * v1[e];
            ss = wave_sum(ss); const float rs = rsqrtf(ss * (1.0f / 1024.0f) + 1e-6f);
#pragma unroll
            for (int e = 0; e < 8; ++e) { v0[e] = v0[e] * rs * g0[e]; v1[e] = v1[e] * rs * g1[e]; }
            st8(co + 1024 + lane * 16, v0); st8(co + 1024 + lane * 16 + 8, v1);
        }
        __builtin_amdgcn_sched_barrier(0);
        {
            const int col = lane * 8;
            const bf16_t* bp = p.rw + (size_t)row * 2048 + col;
            float bs = 0.f;
            {   float r[8], k[8], a0[8], a1[8], kav[8], rkv[8];
                smix8(bp, hp, hn, mu0 + col, mu1 + col, r); smix8(bp + 512, hp, hn, mu0 + 640 + col, mu1 + 640 + col, k);
                ld8(p.aa + (size_t)row * 512 + col, a0); ld8(p.aa + ((size_t)MT + row) * 512 + col, a1); ld8f(p.ka + l * 512 + col, kav); ld8f(p.rk + l * 512 + col, rkv);
#pragma unroll
                for (int e = 0; e < 8; ++e) { const float kd = k[e] * (2.0f + (a0[e] + a1[e] - 2.0f) * kav[e]); bs += r[e] * kd * rkv[e]; }
                bs += __shfl_xor(bs, 1); bs += __shfl_xor(bs, 2); bs += __shfl_xor(bs, 4); }
            __builtin_amdgcn_sched_barrier(0);
            float y0[8];
            {   float y1[8]; ld8(p.y + (size_t)row * 512 + col, y0); ld8(p.y + ((size_t)MT + row) * 512 + col, y1);
                float sm = 0.f;
#pragma unroll
                for (int e = 0; e < 8; ++e) { y0[e] += y1[e]; sm += y0[e]; }
                sm += __shfl_xor(sm, 1); sm += __shfl_xor(sm, 2); sm += __shfl_xor(sm, 4);
                const float mean = sm * (1.0f / 64.0f); float vs = 0.f;
#pragma unroll
                for (int e = 0; e < 8; ++e) { y0[e] -= mean; vs += y0[e] * y0[e]; }
                vs += __shfl_xor(vs, 1); vs += __shfl_xor(vs, 2); vs += __shfl_xor(vs, 4);
                const float rs = rsqrtf(vs * (1.0f / 64.0f) + 64e-5f);
#pragma unroll
                for (int e = 0; e < 8; ++e) y0[e] *= rs; }
            __builtin_amdgcn_sched_barrier(0);
            {   float v[8], lw[8], lb[8], gv[8], o[8];
                smix8(bp + 1024, hp, hn, mu0 + 1152 + col, mu1 + 1152 + col, v);
                ld8f(p.lnx_w + l * 512 + col, lw); ld8f(p.lnx_b + l * 512 + col, lb); ld8(p.gg + (size_t)row * 512 + col, gv);
#pragma unroll
                for (int e = 0; e < 8; ++e) o[e] = (y0[e] * lw[e] + lb[e] + bs * v[e]) * gv[e];
                st8(co + 512 + col, o); }
        }
        __builtin_amdgcn_sched_barrier(0);
    }
}

__device__ __forceinline__ void conv_phase(const Params& p, int l, int r0, int Mp) {
    const float* cw = p.conv_w + (size_t)l * 3 * DFF; const float* cb = p.conv_b + (size_t)l * DFF;
#pragma unroll 1
    for (int idx = blockIdx.x * 512 + otid(); idx < Mp * 704; idx += gridDim.x * 512) {
        const int rl = idx / 704, ch = (idx % 704) * 8; int t, L; seq_of(r0 + rl, t, L);
        const bf16_t* hp_ = p.h + (size_t)rl * 11264 + ch;
        float x[8], pv[8], nv[8], up[8], w0[8], w1[8], w2[8], bb[8], o[8];
        ld8(hp_, x); ld8(hp_ + DFF, up); ld8f(cw + ch, w0); ld8f(cw + DFF + ch, w1); ld8f(cw + 2 * DFF + ch, w2); ld8f(cb + ch, bb);
        if (t > 0) ld8(hp_ - 11264, pv); else {
#pragma unroll
            for (int e = 0; e < 8; ++e) pv[e] = 0.f; }
        if (t < L - 1) ld8(hp_ + 11264, nv); else {
#pragma unroll
            for (int e = 0; e < 8; ++e) nv[e] = 0.f; }
#pragma unroll
        for (int e = 0; e < 8; e += 2) { pg8::f32x2 gt; gt.x = pv[e] * w0[e] + x[e] * w1[e] + nv[e] * w2[e] + bb[e]; gt.y = pv[e + 1] * w0[e + 1] + x[e + 1] * w1[e + 1] + nv[e + 1] * w2[e + 1] + bb[e + 1];
            const pg8::f32x2 ge = pg8::gelu_pk(gt); o[e] = ge.x * up[e]; o[e + 1] = ge.y * up[e + 1]; }
        st8(p.act + (size_t)rl * DFF + ch, o);
    }
}

__device__ __forceinline__ void final_norm(const Params& p) {
    const int wave = otid() >> 6, lane = otid() & 63;
#pragma unroll 1
    for (int row = blockIdx.x * 8 + wave; row < ML; row += gridDim.x * 8) {
        float4* src = (float4*)(p.out + (size_t)row * 2048);
        float4 v[8]; float ss = 0.f;
#pragma unroll
        for (int i = 0; i < 8; ++i) { v[i] = src[lane + 64 * i]; ss += v[i].x * v[i].x + v[i].y * v[i].y + v[i].z * v[i].z + v[i].w * v[i].w; }
        ss = wave_sum(ss); const float rs = rsqrtf(ss * (1.0f / 2048.0f) + 1e-6f);
        const float4* g4 = (const float4*)p.final_g;
#pragma unroll
        for (int i = 0; i < 8; ++i) { const float4 g = g4[lane + 64 * i]; src[lane + 64 * i] = make_float4(v[i].x * rs * g.x, v[i].y * rs * g.y, v[i].z * rs * g.z, v[i].w * rs * g.w); }
    }
}

struct SkewOrder : StaticOrder {
    int skew;
    __device__ __forceinline__ bool next(int i, Unit& u) const {
        if (!skew) return StaticOrder::next(i, u);
        if (c < 64) return i < 8 ? StaticOrder::next(i, u) : false;
        if (i < 11) return StaticOrder::next(i, u);
        if (i == 11) { const int j = c - 64; StaticOrder t = *this; t.c = j & 63; return t.next(8 + (j >> 6), u); }
        return false;
    }
};
#define LDS_BYTES (131072 + 256)
#define GBAR() xcd_barrier(bar)
__device__ __forceinline__ int opq(int v) { asm volatile("" : "+s"(v)); return v; }
__global__ void __launch_bounds__(512, 2) hymba_fwd(Params p) {
    extern __shared__ __attribute__((aligned(16))) unsigned char shm[];
    PG8_LAS unsigned char* lds = (PG8_LAS unsigned char*)shm;
    volatile LAS unsigned* st = (volatile LAS unsigned*)(lds + 131072);
    if (threadIdx.x == 0) { st[0] = 0u; st[1] = 0u; st[2] = 0u; st[3] = 0u; }
    __syncthreads();
    XcdBarrier bar = xcd_barrier_post(p.bar, st);
    const int G = gridDim.x, bid = blockIdx.x;
#ifndef SK_PRO
    prologue(p, shm);
#endif
    GBAR();
#pragma unroll 1
    for (int l = 0; l < 4; ++l) {
        const float* modl = p.mod + (size_t)l * MODL;
        const float* xl_in = l == 0 ? p.x : p.out; const float* xc_in = l == 0 ? p.ctx : p.xc;
#ifndef SK_NORM
        norm_mod(xl_in, xc_in, p.norm1_g + l * 2048, modl, 0, 2048, p.u);
#endif
        GBAR();
        { EpiIn E; E.q = p.q; E.ak = p.ak; E.vt = p.vt; E.vtc = p.vtc; E.rw = p.rw; E.ft = p.ft; E.ftc = p.ftc; E.rope = p.rope;
          StaticOrder S; S.init(opq(MT), opq(NIN), G, bid); Gemm g; g.A = p.u; g.Bt = p.wt_in + (size_t)l * NIN * 2048; g.M = opq(MT); g.N = opq(NIN); g.K = opq(2048);

#ifndef SK_GIN
          pg8::gemm_phase<EpiIn, StaticOrder, false>(lds, g, S, E, nullptr);
#endif
 }
        GBAR();
#ifndef SK_PREP
        prep_phase(p, l);
#endif
        GBAR();
        { EpiLR E; E.dec = p.dec; E.aa = p.aa; E.gg = p.gg; E.w0 = p.w0 + l * 1024; E.a0 = p.a0 + l * 1024;
          StaticOrder S; S.init(opq(MT), opq(2560), G, bid); Gemm g; g.A = p.a2b; g.Bt = p.wt_lr + (size_t)l * 2560 * 384; g.M = opq(MT); g.N = opq(2560); g.K = opq(384);

#ifndef SK_GLR
          pg8::gemm_phase<EpiLR, StaticOrder, false>(lds, g, S, E, nullptr);
#endif
 }
        __syncthreads();
        { EpiFO E; E.fo = p.fo; E.base = 0; E.seqlen = 4096;
          StaticOrder S; S.init(opq(4096), opq(4096), G, bid); Gemm g; g.A = p.wf; g.Bt = p.ft; g.M = opq(4096); g.N = opq(4096); g.K = opq(8192);

#ifndef SK_GFO
          pg8::gemm_phase<EpiFO, StaticOrder, false>(lds, g, S, E, nullptr);
#endif
 }
        __syncthreads();
        { EpiFO E; E.fo = p.fo; E.base = ML; E.seqlen = 256;
          StaticOrder S; S.init(opq(256), opq(4096), G, (bid + G - (160 % G)) % G); Gemm g; g.A = p.wfc; g.Bt = p.ftc; g.M = opq(256); g.N = opq(4096); g.K = opq(512);

#ifndef SK_GFO
          pg8::gemm_phase<EpiFO, StaticOrder, false>(lds, g, S, E, nullptr);
#endif
 }
        __syncthreads();
#ifndef SK_ATT
        attn_phase(p, l, shm);
#endif
        GBAR();
#ifndef SK_SCAN
        scan_phase(p, l, shm);
#endif
        GBAR();
#ifndef SK_FIN
        fin_phase(p, l, p.u);
#endif
        GBAR();
        { EpiRes E; E.xl_in = xl_in; E.xc_in = xc_in; E.xl_out = p.out; E.xc_out = p.xc; E.ga = modl + 4096; E.row_off = 0;
          const int Mo = l == 3 ? ML : MT;
          StaticOrder S; S.init(opq(Mo), opq(2048), G, bid); Gemm g; g.A = p.u; g.Bt = p.wt_out + (size_t)l * 2048 * 2048; g.M = opq(Mo); g.N = opq(2048); g.K = opq(2048);

#ifndef SK_GRES
          pg8::gemm_phase<EpiRes, StaticOrder, false>(lds, g, S, E, nullptr);
#endif
 }
        GBAR();
        norm_mod(p.out, p.xc, p.norm2_g + l * 2048, modl, 6144, 8192, p.u);
        GBAR();
#pragma unroll 1
        for (int part = 0; part < 2; ++part) {
            const int r0 = part ? 0 : 16384, Mp = (!part && l != 3) ? 18432 : 16384;
            { EpiH E; E.o = p.h; E.ld = 11264;
              SkewOrder S; S.init(opq(Mp), opq(11264), G, bid); S.skew = (part == 1 && l != 3 && G == 256) ? 1 : 0;
              Gemm g; g.A = p.u + (size_t)r0 * 2048; g.Bt = p.wt_f1 + (size_t)l * 11264 * 2048; g.M = opq(Mp); g.N = opq(11264); g.K = opq(2048);

#ifndef SK_GH
              pg8::gemm_phase<EpiH, SkewOrder, false>(lds, g, S, E, nullptr);
#endif
 }
            GBAR();
#ifndef SK_CONV
            conv_phase(p, l, r0, Mp);
#endif
            GBAR();
            { EpiRes E; E.xl_in = p.out; E.xc_in = p.xc; E.xl_out = p.out; E.xc_out = p.xc; E.ga = modl + 10240; E.row_off = r0;
              StaticOrder S; S.init(opq(Mp), opq(2048), G, bid); Gemm g; g.A = p.act; g.Bt = p.wt_f2 + (size_t)l * 2048 * DFF; g.M = opq(Mp); g.N = opq(2048); g.K = opq(DFF);

#ifndef SK_GRES
          pg8::gemm_phase<EpiRes, StaticOrder, false>(lds, g, S, E, nullptr);
#endif
 }
            if (part) GBAR(); else __syncthreads();
        }
    }
    final_norm(p);
}

extern "C" void kernel_launch(void* const* d_in, const int* in_sizes, int n_in, void* d_out, int out_size, void* d_ws, size_t ws_size, hipStream_t stream) {
    (void)in_sizes; (void)n_in; (void)out_size; (void)ws_size;
    Params p{};
    const float** pf = (const float**)&p;
    for (int i = 0; i < 29; ++i) pf[i] = (const float*)d_in[i];
    p.out = (float*)d_out;
    char* w = (char*)d_ws; size_t off = 0;
    auto take = [&](size_t bytes) { char* r = w + off; off += (bytes + 255) & ~(size_t)255; return r; };
    p.bar = (unsigned*)take(XCD_BAR_WORDS * 4);
    p.mod = (float*)take((size_t)4 * MODL * 4);
    p.rope = (float*)take((size_t)4096 * 64 * 2 * 4);
    p.xc = (float*)take((size_t)2048 * 2048 * 4);
    p.wt_in = (bf16_t*)take((size_t)4 * NIN * 2048 * 2);
    p.wt_out = (bf16_t*)take((size_t)4 * 2048 * 2048 * 2);
    p.wt_f1 = (bf16_t*)take((size_t)4 * 11264 * 2048 * 2);
    p.wt_f2 = (bf16_t*)take((size_t)4 * 2048 * DFF * 2);
    p.wt_lr = (bf16_t*)take((size_t)4 * 2560 * 384 * 2);
    p.wf = (bf16_t*)take((size_t)4096 * 8192 * 2);
    p.wfc = (bf16_t*)take((size_t)256 * 512 * 2);
    p.u = (bf16_t*)take((size_t)MT * 2048 * 2);
    const size_t mix0 = off;
    p.q = (bf16_t*)take((size_t)MT * 1024 * 2);
    p.ak = (bf16_t*)take((size_t)MT * 256 * 2);
    p.vt = (bf16_t*)take((size_t)8 * 256 * 4096 * 2);
    p.vtc = (bf16_t*)take((size_t)8 * 256 * 256 * 2);
    p.rw = (bf16_t*)take((size_t)MT * 2048 * 2);
    p.ft = (bf16_t*)take((size_t)8 * 512 * 8192 * 2);
    p.ftc = (bf16_t*)take((size_t)8 * 512 * 512 * 2);
    p.dec = (bf16_t*)take((size_t)2 * MT * 512 * 2);
    p.aa = (bf16_t*)take((size_t)2 * MT * 512 * 2);
    p.gg = (bf16_t*)take((size_t)MT * 512 * 2);
    p.y = (bf16_t*)take((size_t)2 * MT * 512 * 2);
    p.a2b = p.y;
    p.fo = (bf16_t*)take((size_t)MT * 512 * 2);
    p.at = (bf16_t*)take((size_t)MT * 1024 * 2);
    p.h = (bf16_t*)(w + mix0);
    p.act = p.h + (size_t)18432 * 11264;
    static int grid = 0;
    if (!grid) {
        int dev = 0, cus = 0, per_cu = 0;
        hipGetDevice(&dev); hipDeviceGetAttribute(&cus, hipDeviceAttributeMultiprocessorCount, dev);
        if (hipFuncSetAttribute((const void*)hymba_fwd, hipFuncAttributeMaxDynamicSharedMemorySize, LDS_BYTES) != hipSuccess) fprintf(stderr, "hipFuncSetAttribute failed\n");
        if (hipOccupancyMaxActiveBlocksPerMultiprocessor(&per_cu, (const void*)hymba_fwd, 512, LDS_BYTES) != hipSuccess || per_cu < 1) { fprintf(stderr, "occupancy query failed\n"); per_cu = 1; }
        grid = cus > 0 ? cus : 256;
    }
    hipMemsetAsync(p.bar, 0, XCD_BAR_WORDS * 4, stream);
    hipLaunchKernelGGL(hymba_fwd, dim3(grid), dim3(512), LDS_BYTES, stream, p);
}
```

```cpp
#include <hip/hip_runtime.h>
#include <stdint.h>
#include <stdio.h>
#define XB_TMO      128
#define XB_XCNT(j)  (256  + 64 * (j))
#define XB_XSUB(j)  (1280 + 64 * (j))
#define XB_XGEN(j)  (2304 + 64 * (j))
#define XB_TOP      3328
#define XB_TOPGEN   3392
#define XCD_BAR_WORDS 3456
#define XB_SPIN_CAP (1u << 18)
#define LAS __attribute__((address_space(3)))

__device__ __forceinline__ unsigned xb_ld(unsigned* p)              { return __hip_atomic_load(p, __ATOMIC_RELAXED, __HIP_MEMORY_SCOPE_AGENT); }
__device__ __forceinline__ unsigned xb_add(unsigned* p, unsigned v) { return __hip_atomic_fetch_add(p, v, __ATOMIC_RELAXED, __HIP_MEMORY_SCOPE_AGENT); }
__device__ __forceinline__ unsigned xb_xcc_id() { return (unsigned)__builtin_amdgcn_s_getreg((3 << 11) | 20) & 0xFu; }
#define XB_SPIN(cond, bar) do { unsigned _sp = 0; while (cond) { __builtin_amdgcn_s_sleep(1); \
    if ((++_sp & 255u) == 0u) { if (xb_ld(&(bar)[XB_TMO])) break; if (_sp > XB_SPIN_CAP) { atomicAdd(&(bar)[XB_TMO], 1u); break; } } } } while (0)

struct XcdBarrier {
    unsigned* bar; unsigned x;
    volatile LAS unsigned* st;
};

__device__ __forceinline__ XcdBarrier xcd_barrier_post(unsigned* bar, volatile LAS unsigned* st) {
    XcdBarrier b; b.bar = bar; b.x = xb_xcc_id(); b.st = st;
    if (threadIdx.x == 0) (void)xb_add(&bar[XB_XCNT(b.x)], 1u);
    return b;
}
__device__ __forceinline__ void xcd_barrier_complete(unsigned* bar, unsigned x, unsigned& nloc, unsigned& nx) {
    const unsigned G = gridDim.x * gridDim.y * gridDim.z;
    unsigned sum, cnt, mine, sp = 0u;
    for (;;) {
        sum = 0u; cnt = 0u; mine = 0u;
#pragma unroll
        for (unsigned j = 0; j < 16; ++j) { const unsigned c = xb_ld(&bar[XB_XCNT(j)]); sum += c; cnt += (c > 0u) ? 1u : 0u; mine = (j == x) ? c : mine; }
        if (sum == G) break;
        __builtin_amdgcn_s_sleep(1);
        if ((++sp & 255u) == 0u) { if (xb_ld(&bar[XB_TMO])) break; if (sp > XB_SPIN_CAP) { atomicAdd(&bar[XB_TMO], 1u); break; } }
    }
    nloc = mine > 0u ? mine : 1u; nx = cnt > 0u ? cnt : 1u;
}

__device__ __forceinline__ void xcd_barrier(const XcdBarrier& b) {
    asm volatile("s_waitcnt vmcnt(0)" ::: "memory");
    __syncthreads();
    if (threadIdx.x == 0) {
        unsigned* bar = b.bar;
        __builtin_amdgcn_s_waitcnt(0);
        unsigned nloc = b.st[0], nx = b.st[1];
        if (nloc == 0u) { xcd_barrier_complete(bar, b.x, nloc, nx); b.st[0] = nloc; b.st[1] = nx; }
        const unsigned old = xb_add(&bar[XB_XSUB(b.x)], 1u);
        const unsigned gen = old / nloc;
        if (old + 1u == (gen + 1u) * nloc) {
            __builtin_amdgcn_fence(__ATOMIC_RELEASE, "agent");
            asm volatile("s_waitcnt vmcnt(0)" ::: "memory");
            const unsigned og = xb_add(&bar[XB_TOP], 1u);
            const unsigned tg = og / nx;
            if (og + 1u == (tg + 1u) * nx) xb_add(&bar[XB_TOPGEN], 1u);
            else XB_SPIN(xb_ld(&bar[XB_TOPGEN]) == tg, bar);
            __builtin_amdgcn_fence(__ATOMIC_ACQUIRE, "agent");
            xb_add(&bar[XB_XGEN(b.x)], 1u);
            asm volatile("s_waitcnt vmcnt(0)" ::: "memory");
        } else {
            XB_SPIN(xb_ld(&bar[XB_XGEN(b.x)]) == gen, bar);
            __builtin_amdgcn_fence(__ATOMIC_ACQUIRE, "agent");
            asm volatile("s_waitcnt vmcnt(0)" ::: "memory");
        }
    }
    __syncthreads();
}

namespace pg8 {
#define PG8_LAS __attribute__((address_space(3)))
typedef unsigned short bf16_t;
typedef short bf16x8 __attribute__((ext_vector_type(8)));
typedef float f32x4 __attribute__((ext_vector_type(4)));
typedef unsigned u32x4 __attribute__((ext_vector_type(4)));
constexpr int BM = 256, BK = 64, HALF = 128, HTB = HALF * BK * 2  , STAGE_BYTES = 8 * HTB, NXCD = 8, WGM = 8;

__host__ __device__ __forceinline__ int lds_byte(int r, int c) { const int st = (r >> 4) * 2 + (c >> 5), rr = r & 15, cc = c & 31, ob = rr * 64 + cc * 2; return st * 1024 + (ob ^ (((ob >> 9) & 1) << 5)); }
__host__ __device__ __forceinline__ void stage_rc(int b, int& R, int& C) { const int st = b / 1024, sb = b % 1024, swz = sb ^ (((sb >> 9) & 1) << 5); R = (st >> 1) * 16 + swz / 64; C = (st & 1) * 32 + (swz % 64) / 2; }
__host__ __device__ __forceinline__ int perm32(int rho) { const int n = rho >> 4, i = rho & 15; return 8 * (i >> 2) + 4 * n + (i & 3); }

struct Unit { int pm, pn; };
struct Gemm { const bf16_t* A; const bf16_t* Bt; int M, N, K; };

struct StaticOrder {
    int nM, nN, nwg, G, c;
    __host__ __device__ void init(int M, int N, int G_, int c_) { nM = M / BM; nN = N / BM; nwg = nM * nN; G = G_; c = c_; }
    __host__ __device__ bool next(int i, Unit& u) const {
        const long L = (long)i * G + c; if (L >= nwg) return false;
        int wgid = (int)L; { const int q = nwg / NXCD, r = nwg % NXCD, xcd = wgid % NXCD, off = wgid / NXCD; wgid = (xcd < r ? xcd * (q + 1) : r * (q + 1) + (xcd - r) * q) + off; }
        const int nig = WGM * nN, gid = wgid / nig, fm = gid * WGM, gsz = (nM - fm) < WGM ? (nM - fm) : WGM;
        u.pm = fm + ((wgid % nig) % gsz); u.pn = (wgid % nig) / gsz; return true;
    }
    __device__ __forceinline__ void a_ready(const Unit&) const {}
    __device__ __forceinline__ void done(const Unit&) const {}
};
__device__ __forceinline__ unsigned cvt_pk_bf16(float lo, float hi) { unsigned r; asm volatile("v_cvt_pk_bf16_f32 %0, %1, %2" : "=v"(r) : "v"(lo), "v"(hi)); return r; }
typedef float f32x2 __attribute__((ext_vector_type(2)));
__device__ __forceinline__ f32x2 gelu_pk(f32x2 v) {
    const f32x2 av = __builtin_elementwise_abs(v), d = av * 0.2316418882f + 1.0f;
    f32x2 t; t.x = __builtin_amdgcn_rcpf(d.x); t.y = __builtin_amdgcn_rcpf(d.y);
    f32x2 q = t * 0.5307027145f + (-0.7265760135f); q = q * t + 0.7107068705f; q = q * t + (-0.142248368f); q = q * t + 0.127414796f; q = q * t;
    const f32x2 s = (v * v) * (-0.72134752044f);
    f32x2 e; e.x = __builtin_amdgcn_exp2f(s.x); e.y = __builtin_amdgcn_exp2f(s.y);
    const f32x2 m = v * (q * e), r = v - m;
    f32x2 o; o.x = v.x < 0.f ? m.x : r.x; o.y = v.y < 0.f ? m.y : r.y; return o;
}

template <class Epi, class Sched, bool STAMP = false>
__device__ __forceinline__ void gemm_phase(PG8_LAS unsigned char* lds, const Gemm g, const Sched& S, const Epi& E, unsigned long long* stamps) {
    int tid_ = threadIdx.x; asm volatile("" : "+v"(tid_));
    const int tid = tid_, wid = __builtin_amdgcn_readfirstlane(tid >> 6), lane = tid & 63, wr = wid >> 2, wc = wid & 3, fr = lane & 15, fq = lane >> 4;
    const int K = g.K, nt = K / BK;
    int ts_lo = 0, ts_hi = 0, nts = 0; const unsigned long long rt_entry = STAMP ? (unsigned long long)wall_clock64() : 0ull;
#define PG8_STAMP() do { if (STAMP && wid == 0 && nts < 64) { const unsigned long long _c = (unsigned long long)clock64(); \
        ts_lo = (lane == nts) ? (int)(unsigned)_c : ts_lo; ts_hi = (lane == nts) ? (int)(unsigned)(_c >> 32) : ts_hi; ++nts; } } while (0)
    PG8_STAMP();
    unsigned voffA[2], voffB[2];
#pragma unroll
    for (int i = 0; i < 2; ++i) { int R, C; stage_rc(tid * 16 + i * 8192, R, C); const int Rb = Epi::PERM ? ((R & ~31) + perm32(R & 31)) : R;
        voffA[i] = (unsigned)(R * K + C) * 2u; voffB[i] = (unsigned)(Rb * K + C) * 2u; }
    const size_t kstep = (size_t)(BK * 2);
    const size_t hstep = (size_t)HALF * K * 2;
    const size_t tstep = 2 * hstep;
    const unsigned ldsw = (unsigned)wid * 1024u;
    const int aoff = lds_byte(wr * 64 + fr, fq * 8), boff = lds_byte(wc * 32 + fr, fq * 8);
#define PG8_SA(b, h) (((b) * 2 + (h)) * HTB)
#define PG8_SB(b, h) ((4 + (b) * 2 + (h)) * HTB)
#define PG8_STAGE(bufoff, gbase, voff) do { _Pragma("unroll") for (int _i = 0; _i < 2; ++_i) \
        __builtin_amdgcn_global_load_lds((const unsigned*)((const char*)(gbase) + (voff)[_i]), (PG8_LAS unsigned*)(lds + (bufoff) + ldsw + _i * 8192), 16, 0, 0); } while (0)
#define PG8_LDA(dst, b, h) do { _Pragma("unroll") for (int m = 0; m < 4; ++m) _Pragma("unroll") for (int k = 0; k < 2; ++k) dst[m][k] = *(const PG8_LAS bf16x8*)(lds + PG8_SA(b, h) + aoff + m * 2048 + k * 1024); } while (0)
#define PG8_LDB(dst, b, h) do { _Pragma("unroll") for (int n = 0; n < 2; ++n) _Pragma("unroll") for (int k = 0; k < 2; ++k) dst[n][k] = *(const PG8_LAS bf16x8*)(lds + PG8_SB(b, h) + boff + n * 2048 + k * 1024); } while (0)
#define PG8_MMA(ai, bj, At, Bt) do { __builtin_amdgcn_s_setprio(1); _Pragma("unroll") for (int m = 0; m < 4; ++m) _Pragma("unroll") for (int n = 0; n < 2; ++n) _Pragma("unroll") for (int k = 0; k < 2; ++k) \
        acc[ai][bj][m][n] = __builtin_amdgcn_mfma_f32_16x16x32_bf16(Bt[n][k], At[m][k], acc[ai][bj][m][n], 0, 0, 0); __builtin_amdgcn_s_setprio(0); } while (0)
#define PG8_WAIT_V(n) asm volatile("s_waitcnt vmcnt(" #n ")" ::: "memory")
#define PG8_WAIT_L(n) asm volatile("s_waitcnt lgkmcnt(" #n ")" ::: "memory")
#define PG8_BAR __builtin_amdgcn_s_barrier()
#define PG8_SCHED __builtin_amdgcn_sched_barrier(0)
    Unit cur, nxt; int ui = 0;
    if (!S.next(0, cur)) return;
    f32x4 acc[2][2][4][2];
#pragma unroll
    for (int a = 0; a < 2; ++a)
#pragma unroll
        for (int b = 0; b < 2; ++b)
#pragma unroll
            for (int m = 0; m < 4; ++m)
#pragma unroll
                for (int n = 0; n < 2; ++n) acc[a][b][m][n] = (f32x4){0.f, 0.f, 0.f, 0.f};
    bf16x8 At[4][2], B0[2][2], B1[2][2];
    const char* cA = (const char*)g.A + (size_t)cur.pm * tstep; const char* cB = (const char*)g.Bt + (size_t)cur.pn * tstep;
    S.a_ready(cur);
    PG8_STAGE(PG8_SB(0, 0), cB, voffB); PG8_STAGE(PG8_SA(0, 0), cA, voffA); PG8_STAGE(PG8_SB(0, 1), cB + hstep, voffB); PG8_STAGE(PG8_SA(0, 1), cA + hstep, voffA);
    if (wr == 1) PG8_BAR;
    PG8_WAIT_V(4); PG8_BAR;
    PG8_STAGE(PG8_SB(1, 0), cB + kstep, voffB); PG8_STAGE(PG8_SA(1, 0), cA + kstep, voffA); PG8_STAGE(PG8_SB(1, 1), cB + hstep + kstep, voffB);
    PG8_WAIT_V(6); PG8_BAR;
    PG8_STAMP();
    for (;;) {
        const bool has_next = S.next(ui + 1, nxt);
        const char* nA = has_next ? (const char*)g.A + (size_t)nxt.pm * tstep : cA; const char* nB = has_next ? (const char*)g.Bt + (size_t)nxt.pn * tstep : cB;
        for (int t = 0; t < nt; t += 2) {
            const bool last = (t == nt - 2);
            const char* a1 = cA + (size_t)(t + 1) * kstep;
            const char* a2 = last ? nA : cA + (size_t)(t + 2) * kstep; const char* b2 = last ? nB : cB + (size_t)(t + 2) * kstep;
            const char* a3 = a2 + kstep; const char* b3 = b2 + kstep;
            if (last && has_next) S.a_ready(nxt);
            PG8_LDB(B0, 0, 0); PG8_SCHED; PG8_LDA(At, 0, 0); PG8_STAGE(PG8_SA(1, 1), a1 + hstep, voffA);
            PG8_WAIT_L(8); PG8_BAR; PG8_WAIT_L(0); PG8_MMA(0, 0, At, B0); PG8_BAR; PG8_SCHED;
            PG8_LDB(B1, 0, 1); PG8_STAGE(PG8_SB(0, 0), b2, voffB);
            PG8_BAR; PG8_WAIT_L(0); PG8_MMA(0, 1, At, B1); PG8_BAR;
            PG8_LDA(At, 0, 1); PG8_STAGE(PG8_SA(0, 0), a2, voffA);
            PG8_BAR; PG8_WAIT_L(0); PG8_MMA(1, 0, At, B0); PG8_BAR; PG8_SCHED;
            PG8_STAGE(PG8_SB(0, 1), b2 + hstep, voffB);
            PG8_WAIT_V(6); PG8_BAR; PG8_MMA(1, 1, At, B1); PG8_BAR;
            PG8_LDB(B0, 1, 0); PG8_SCHED; PG8_LDA(At, 1, 0); PG8_STAGE(PG8_SA(0, 1), a2 + hstep, voffA);
            PG8_WAIT_L(8); PG8_BAR; PG8_WAIT_L(0); PG8_MMA(0, 0, At, B0); PG8_BAR; PG8_SCHED;
            PG8_LDB(B1, 1, 1); PG8_STAGE(PG8_SB(1, 0), b3, voffB);
            PG8_BAR; PG8_WAIT_L(0); PG8_MMA(0, 1, At, B1); PG8_BAR;
            PG8_LDA(At, 1, 1); PG8_STAGE(PG8_SA(1, 0), a3, voffA);
            PG8_BAR; PG8_WAIT_L(0); PG8_MMA(1, 0, At, B0); PG8_BAR; PG8_SCHED;
            PG8_STAGE(PG8_SB(1, 1), b3 + hstep, voffB);
            PG8_WAIT_V(6); PG8_BAR; PG8_MMA(1, 1, At, B1); PG8_BAR;
        }
        PG8_STAMP();
        if constexpr (!Epi::AFTER_DRAIN) { E(acc, cur, wr, wc, fr, fq); S.done(cur); }
        PG8_STAMP();
        if (!has_next) break;
#pragma unroll
        for (int a = 0; a < 2; ++a)
#pragma unroll
            for (int b = 0; b < 2; ++b)
#pragma unroll
                for (int m = 0; m < 4; ++m)
#pragma unroll
                    for (int n = 0; n < 2; ++n) acc[a][b][m][n] = (f32x4){0.f, 0.f, 0.f, 0.f};
        cur = nxt; cA = nA; cB = nB; ++ui;
    }
    PG8_WAIT_V(0);
    if (wr == 0) PG8_BAR;
    PG8_BAR;
    if constexpr (Epi::AFTER_DRAIN) { E.fused(acc, cur, wr, wc, fr, fq, lds, wid, lane); S.done(cur); }
    PG8_STAMP();
    if (STAMP && wid == 0) { stamps[lane] = lane < nts ? (((unsigned long long)(unsigned)ts_hi << 32) | (unsigned)ts_lo) : 0ull;
        if (lane == 62) stamps[62] = rt_entry; if (lane == 63) stamps[63] = (unsigned long long)wall_clock64(); }
#undef PG8_STAMP
#undef PG8_SA
#undef PG8_SB
#undef PG8_STAGE
#undef PG8_LDA
#undef PG8_LDB
#undef PG8_MMA
#undef PG8_WAIT_V
#undef PG8_WAIT_L
#undef PG8_BAR
#undef PG8_SCHED
}
}

using pg8::bf16_t; using pg8::f32x4; using pg8::bf16x8; using pg8::Unit; using pg8::Gemm; using pg8::StaticOrder;
#define MT 34816
#define ML 32768
#define NIN 4608
#define DFF 5632
#define MODL (9 * 12288)

struct Params {
    const float *x, *c, *ctx, *c_ctx, *norm1_g, *norm2_g, *w_ada, *b_ada, *w_in, *mu, *w0, *w2, *a0, *a2, *g2, *kk_scale, *ka, *rk, *lnx_w, *lnx_b, *sink, *f_g, *a_g, *w_out, *w_ffn_in, *conv_w, *conv_b, *w_ffn_out, *final_g;
    float* out; unsigned* bar; float* mod; float* rope; float* xc;
    bf16_t *wt_in, *wt_out, *wt_f1, *wt_f2, *wt_lr, *wf, *wfc, *u, *q, *ak, *vt, *vtc, *rw, *ft, *ftc, *dec, *aa, *gg, *y, *a2b, *fo, *at, *h, *act;
};

__device__ __forceinline__ int otid() { int t = threadIdx.x; asm volatile("" : "+v"(t)); return t; }
__device__ __forceinline__ bf16_t f2bf(float f) { unsigned u = __float_as_uint(f); u += 0x7FFFu + ((u >> 16) & 1u); return (bf16_t)(u >> 16); }
__device__ __forceinline__ float bf2f(bf16_t h) { return __uint_as_float(((unsigned)h) << 16); }
__device__ __forceinline__ unsigned pk2(float a, float b) { return (unsigned)f2bf(a) | ((unsigned)f2bf(b) << 16); }
__device__ __forceinline__ float lo_bf(unsigned w) { return __uint_as_float(w << 16); }
__device__ __forceinline__ float hi_bf(unsigned w) { return __uint_as_float(w & 0xffff0000u); }
__device__ __forceinline__ float wave_sum(float v) { v += __shfl_xor(v, 32); v += __shfl_xor(v, 16); v += __shfl_xor(v, 8); v += __shfl_xor(v, 4); v += __shfl_xor(v, 2); v += __shfl_xor(v, 1); return v; }
__device__ __forceinline__ float sigmoidf_(float x) { return 1.0f / (1.0f + __expf(-x)); }
template <int CTRL> __device__ __forceinline__ float dpp_add(float x) { return x + __int_as_float(__builtin_amdgcn_update_dpp(0, __float_as_int(x), CTRL, 0xf, 0xf, true)); }
__device__ __forceinline__ float sum8(float x) { x = dpp_add<0xB1>(x); x = dpp_add<0x4E>(x); x = dpp_add<0x141>(x); return x; }

__device__ __forceinline__ int srccol_in(int n) {
    if (n < 1024) return -1;
    if (n < 2304) { const int base = n < 2048 ? 512 : 3456; const int cq = n < 2048 ? n - 1024 : n - 2048; const int head = cq >> 7, pp = cq & 127, axis = pp >> 6, i = (pp & 63) >> 1, half = pp & 1; return base + head * 128 + axis * 64 + half * 32 + i; }
    if (n < 2560) return 3712 + (n - 2304);
    if (n < 3072) return 1536 + (n - 2560);
    if (n < 3584) return 2176 + (n - 3072);
    if (n < 4096) return 2688 + (n - 3584);
    if (n < 4224) return 2048 + (n - 4096);
    if (n < 4352) return 3200 + (n - 4224);
    if (n < 4480) return 3328 + (n - 4352);
    return -1;
}
__device__ __forceinline__ void xpose_tile(const float* src, int Nsrc, bf16_t* dst, int K, int n0, int k0, int mode, float* tile) {
    const int tid = otid(), nn = tid & 63, kk = tid >> 6;
    const int sc = mode ? srccol_in(n0 + nn) : (n0 + nn);
    float v[16];
#pragma unroll
    for (int pp = 0; pp < 16; ++pp) v[pp] = sc >= 0 ? src[(size_t)(k0 + kk + 8 * pp) * Nsrc + sc] : 0.f;
#pragma unroll
    for (int pp = 0; pp < 16; ++pp) tile[(kk + 8 * pp) * 65 + nn] = v[pp];
    __syncthreads();
    const int rn = tid >> 3, kc = tid & 7;
#pragma unroll
    for (int hh = 0; hh < 2; ++hh) { const int kb = hh * 64 + kc * 8; uint4 w;
        w.x = pk2(tile[(kb + 0) * 65 + rn], tile[(kb + 1) * 65 + rn]); w.y = pk2(tile[(kb + 2) * 65 + rn], tile[(kb + 3) * 65 + rn]);
        w.z = pk2(tile[(kb + 4) * 65 + rn], tile[(kb + 5) * 65 + rn]); w.w = pk2(tile[(kb + 6) * 65 + rn], tile[(kb + 7) * 65 + rn]);
        *(uint4*)(dst + (size_t)(n0 + rn) * K + k0 + kb) = w; }
    __syncthreads();
}

__device__ __forceinline__ void prologue(const Params& p, unsigned char* shm) {
    const int tid = otid(), G = gridDim.x, bid = blockIdx.x;
    float* fl = (float*)shm;
#pragma unroll 1
    for (int it = bid; it < 4 * 5632; it += G) {
        const int l = it / 5632; int r = it % 5632;
        if (r < 896) xpose_tile(p.w_in + (size_t)l * 2048 * 3968, 3968, p.wt_in + (size_t)l * NIN * 2048, 2048, 1024 + (r >> 4) * 64, (r & 15) * 128, 1, fl);
        else if (r < 1408) { r -= 896; xpose_tile(p.w_out + (size_t)l * 2048 * 2048, 2048, p.wt_out + (size_t)l * 2048 * 2048, 2048, (r >> 4) * 64, (r & 15) * 128, 0, fl); }
        else if (r < 4224) { r -= 1408; xpose_tile(p.w_ffn_in + (size_t)l * 2048 * 11264, 11264, p.wt_f1 + (size_t)l * 11264 * 2048, 2048, (r >> 4) * 64, (r & 15) * 128, 0, fl); }
        else { r -= 4224; xpose_tile(p.w_ffn_out + (size_t)l * DFF * 2048, 2048, p.wt_f2 + (size_t)l * 2048 * DFF, DFF, (r / 44) * 64, (r % 44) * 128, 0, fl); }
    }
    {
        float* wt = fl; float* ctab = fl + 64 * 129;
        if (tid < 128) ctab[tid] = cospif((float)tid / 64.0f) * 0.08838834764831845f;
        __syncthreads();
#pragma unroll 1
        for (int it = bid; it < 512; it += G) {
            const int l = it >> 7, g = (it >> 5) & 3, k0 = (it & 31) * 64;
            const float* src = p.w_in + (size_t)l * 2048 * 3968;
#pragma unroll
            for (int pp = 0; pp < 16; ++pp) { const int idx = tid + 512 * pp, kk = idx >> 7, c = idx & 127; wt[kk * 129 + c] = src[(size_t)(k0 + kk) * 3968 + g * 128 + c]; }
            __syncthreads();
            const int cp = tid & 127, kq = tid >> 7;
            unsigned oc[8], os[8];
#pragma unroll 1
            for (int k2 = 0; k2 < 8; ++k2) {
                float c0 = 0.f, s0 = 0.f, c1 = 0.f, s1 = 0.f;
                const float* r0 = wt + (kq * 16 + 2 * k2) * 129; const float* r1 = r0 + 129;
                for (int c = 0; c < 128; ++c) { const int j = (c * cp) & 127; const float cv = ctab[j], sv = ctab[(j - 32) & 127]; c0 += r0[c] * cv; s0 += r0[c] * sv; c1 += r1[c] * cv; s1 += r1[c] * sv; }
                oc[k2] = pk2(c0, c1); os[k2] = pk2(s0, s1);
            }
            bf16_t* dc = p.wt_in + (size_t)l * NIN * 2048 + (size_t)(g * 128 + cp) * 2048 + k0 + kq * 16;
            bf16_t* ds = dc + (size_t)512 * 2048;
            *(uint4*)dc = make_uint4(oc[0], oc[1], oc[2], oc[3]); *(uint4*)(dc + 8) = make_uint4(oc[4], oc[5], oc[6], oc[7]);
            *(uint4*)ds = make_uint4(os[0], os[1], os[2], os[3]); *(uint4*)(ds + 8) = make_uint4(os[4], os[5], os[6], os[7]);
            __syncthreads();
        }
    }
    {
        float* ct = fl;
        __syncthreads();
        for (int i = tid; i < 4096; i += 512) ct[i] = cospif((float)i / 2048.0f) * (1.0f / 64.0f);
        __syncthreads();
#pragma unroll 1
        for (int idx = bid * 512 + tid; idx < 4096 * 1024; idx += G * 512) {
            const int kf = idx >> 10, gi = idx & 1023, half = gi >> 9, t0 = (gi & 511) * 8;
            float v[8];
#pragma unroll
            for (int e = 0; e < 8; ++e) { const int j = (kf * (t0 + e)) & 4095; v[e] = half ? -ct[(j - 1024) & 4095] : ct[j]; }
            *(uint4*)(p.wf + (size_t)kf * 8192 + half * 4096 + t0) = make_uint4(pk2(v[0], v[1]), pk2(v[2], v[3]), pk2(v[4], v[5]), pk2(v[6], v[7]));
        }
#pragma unroll 1
        for (int idx = bid * 512 + tid; idx < 256 * 64; idx += G * 512) {
            const int kf = idx >> 6, gi = idx & 63, half = gi >> 5, t0 = (gi & 31) * 8;
            float v[8];
#pragma unroll
            for (int e = 0; e < 8; ++e) { const int j = ((kf * (t0 + e)) & 255) * 16; v[e] = 4.0f * (half ? -ct[(j - 1024) & 4095] : ct[j]); }
            *(uint4*)(p.wfc + (size_t)kf * 512 + half * 256 + t0) = make_uint4(pk2(v[0], v[1]), pk2(v[2], v[3]), pk2(v[4], v[5]), pk2(v[6], v[7]));
        }
#pragma unroll 1
        for (int idx = bid * 512 + tid; idx < 4096 * 64; idx += G * 512) {
            const int t = idx >> 6, axis = (idx >> 5) & 1, i = idx & 31;
            const float inv = powf(10000.0f, -(float)i / 32.0f); const float pos = (float)(axis ? (t & 63) : (t >> 6)); const float ang = pos * inv;
            p.rope[(size_t)idx * 2] = cosf(ang); p.rope[(size_t)idx * 2 + 1] = sinf(ang);
        }
#pragma unroll 1
        for (int idx = bid * 512 + tid; idx < 4 * 2560 * 384; idx += G * 512) {
            const int l = idx / (2560 * 384), rem = idx % (2560 * 384), n = rem / 384, k = rem % 384;
            float v = 0.f;
            if (n < 1024) { const int dir = n >> 9, ch = n & 511; if (k < 128 && (k >> 6) == dir) v = p.w2[(((size_t)l * 2 + dir) * 64 + (k & 63)) * 512 + ch]; }
            else if (n < 2048) { const int nn = n - 1024, dir = nn >> 9, ch = nn & 511; if (k >= 128 && k < 256 && ((k - 128) >> 6) == dir) v = p.a2[(((size_t)l * 2 + dir) * 64 + ((k - 128) & 63)) * 512 + ch]; }
            else { const int ch = n - 2048; if (k >= 256) v = p.g2[((size_t)l * 128 + (k - 256)) * 512 + ch]; }
            p.wt_lr[idx] = f2bf(v);
        }
        __syncthreads();
    }
    {
        float* sv = fl; float* red = fl + 9 * 2048;
        for (int i = tid; i < 9 * 2048; i += 512) { const int s = i >> 11, k = i & 2047; const float xv = s < 8 ? p.c[s * 2048 + k] : p.c_ctx[k]; sv[i] = xv / (1.0f + expf(-xv)); }
        __syncthreads();
#pragma unroll 1
        for (int it = bid; it < 768; it += G) {
            const int l = it / 192, col0 = (it % 192) * 64, cx = tid & 63, ks = tid >> 6;
            float acc[9];
#pragma unroll
            for (int s = 0; s < 9; ++s) acc[s] = 0.f;
            const float* wp = p.w_ada + (size_t)l * 2048 * 12288 + col0 + cx;
#pragma unroll 16
            for (int k = ks * 256; k < ks * 256 + 256; ++k) { const float w = wp[(size_t)k * 12288];
#pragma unroll
                for (int s = 0; s < 9; ++s) acc[s] += sv[s * 2048 + k] * w; }
#pragma unroll
            for (int s = 0; s < 9; ++s) red[(ks * 9 + s) * 64 + cx] = acc[s];
            __syncthreads();
            for (int o = tid; o < 576; o += 512) { const int s = o >> 6, cc = o & 63; float t = 0.f;
#pragma unroll
                for (int k8 = 0; k8 < 8; ++k8) t += red[(k8 * 9 + s) * 64 + cc];
                p.mod[((size_t)l * 9 + s) * 12288 + col0 + cc] = t + p.b_ada[(size_t)l * 12288 + col0 + cc]; }
            __syncthreads();
        }
    }
}

__device__ __forceinline__ void norm_mod(const float* xl, const float* xc, const float* gain, const float* modl, int shOff, int scOff, bf16_t* U) {
    const int wave = otid() >> 6, lane = otid() & 63;
#pragma unroll 1
    for (int row = blockIdx.x * 8 + wave; row < MT; row += gridDim.x * 8) {
        const float4* src = (const float4*)(row < ML ? xl + (size_t)row * 2048 : xc + (size_t)(row - ML) * 2048);
        const int s = row < ML ? (row >> 12) : 8;
        float4 v[8]; float ss = 0.f;
#pragma unroll
        for (int i = 0; i < 8; ++i) { v[i] = src[lane + 64 * i]; ss += v[i].x * v[i].x + v[i].y * v[i].y + v[i].z * v[i].z + v[i].w * v[i].w; }
        ss = wave_sum(ss);
        const float rs = rsqrtf(ss * (1.0f / 2048.0f) + 1e-6f);
        const float4* g4 = (const float4*)gain; const float4* sh4 = (const float4*)(modl + s * 12288 + shOff); const float4* sc4 = (const float4*)(modl + s * 12288 + scOff);
#pragma unroll
        for (int i = 0; i < 8; ++i) { const int ci = lane + 64 * i; const float4 g = g4[ci], sh = sh4[ci], sc = sc4[ci];
            const float o0 = v[i].x * rs * g.x * (1.0f + sc.x) + sh.x, o1 = v[i].y * rs * g.y * (1.0f + sc.y) + sh.y, o2 = v[i].z * rs * g.z * (1.0f + sc.z) + sh.z, o3 = v[i].w * rs * g.w * (1.0f + sc.w) + sh.w;
            *(uint2*)(U + (size_t)row * 2048 + ci * 4) = make_uint2(pk2(o0, o1), pk2(o2, o3)); }
    }
}

struct EpiIn {
    static constexpr bool PERM = false, AFTER_DRAIN = false;
    bf16_t *q, *ak, *vt, *vtc, *rw, *ft, *ftc; const float* rope;
    __device__ __forceinline__ void operator()(const f32x4 (&acc)[2][2][4][2], const Unit& u, int wr, int wc, int fr, int fq) const {
        asm volatile("" : "+v"(fr), "+v"(fq));
        const int pn = u.pn; const int cb = wc * 32 + 4 * fq;
#pragma unroll
        for (int ai = 0; ai < 2; ++ai)
#pragma unroll
            for (int m = 0; m < 4; ++m) {
                const int r = u.pm * 256 + ai * 128 + wr * 64 + m * 16 + fr;
                const bool lat = r < ML; const int b = lat ? (r >> 12) : ((r - ML) >> 8); const int t = lat ? (r & 4095) : ((r - ML) & 255);
                if (pn < 4) {
                    const int half = pn >> 1; const int ch0 = (pn & 1) * 256 + cb;
                    bf16_t* d = lat ? ft + ((unsigned)(b * 512 + ch0) * 8192u + half * 4096 + t) : ftc + ((unsigned)(b * 512 + ch0) * 512u + half * 256 + t);
                    const unsigned sd = lat ? 8192u : 512u;
#pragma unroll
                    for (int bj = 0; bj < 2; ++bj)
#pragma unroll
                        for (int n = 0; n < 2; ++n) { const f32x4 v = acc[ai][bj][m][n]; bf16_t* dd = d + (unsigned)(bj * 128 + n * 16) * sd;
                            dd[0] = f2bf(v[0]); dd[sd] = f2bf(v[1]); dd[2 * sd] = f2bf(v[2]); dd[3 * sd] = f2bf(v[3]); }
                } else if (pn < 9) {
                    bf16_t* d = pn < 8 ? q + ((unsigned)r * 1024u + (pn - 4) * 256 + cb) : ak + ((unsigned)r * 256u + cb);
                    const float* rp = rope + (unsigned)t * 128u;
#pragma unroll
                    for (int bj = 0; bj < 2; ++bj)
#pragma unroll
                        for (int n = 0; n < 2; ++n) { f32x4 v = acc[ai][bj][m][n];
                            if (lat) { const int pp = (cb + n * 16) & 127, axis = pp >> 6, i = (pp & 63) >> 1;
                                const float4 cs = *(const float4*)(rp + (axis * 32 + i) * 2);
                                const float a0 = v[0], b0 = v[1], a1 = v[2], b1 = v[3];
                                v[0] = a0 * cs.x - b0 * cs.y; v[1] = a0 * cs.y + b0 * cs.x; v[2] = a1 * cs.z - b1 * cs.w; v[3] = a1 * cs.w + b1 * cs.z; }
                            *(uint2*)(d + bj * 128 + n * 16) = make_uint2(pk2(v[0], v[1]), pk2(v[2], v[3])); }
                } else if (pn == 9) {
                    bf16_t* d = lat ? vt + ((unsigned)(b * 256 + cb) * 4096u + t) : vtc + ((unsigned)(b * 256 + cb) * 256u + t);
                    const unsigned sd = lat ? 4096u : 256u;
#pragma unroll
                    for (int bj = 0; bj < 2; ++bj)
#pragma unroll
                        for (int n = 0; n < 2; ++n) { const f32x4 v = acc[ai][bj][m][n]; bf16_t* dd = d + (unsigned)(bj * 128 + n * 16) * sd;
                            dd[0] = f2bf(v[0]); dd[sd] = f2bf(v[1]); dd[2 * sd] = f2bf(v[2]); dd[3 * sd] = f2bf(v[3]); }
                } else {
                    bf16_t* d = rw + ((unsigned)r * 2048u + (pn - 10) * 256 + cb);
#pragma unroll
                    for (int bj = 0; bj < 2; ++bj)
#pragma unroll
                        for (int n = 0; n < 2; ++n) { const f32x4 v = acc[ai][bj][m][n]; *(uint2*)(d + bj * 128 + n * 16) = make_uint2(pk2(v[0], v[1]), pk2(v[2], v[3])); }
                }
                __builtin_amdgcn_sched_barrier(0);
            }
    }
};
struct EpiLR {
    static constexpr bool PERM = false, AFTER_DRAIN = false;
    bf16_t *dec, *aa, *gg; const float *w0, *a0;
    __device__ __forceinline__ void operator()(const f32x4 (&acc)[2][2][4][2], const Unit& u, int wr, int wc, int fr, int fq) const {
        asm volatile("" : "+v"(fr), "+v"(fq));
        const int pn = u.pn; const int cb = wc * 32 + 4 * fq;
#pragma unroll
        for (int ai = 0; ai < 2; ++ai)
#pragma unroll
            for (int m = 0; m < 4; ++m) {
                const int r = u.pm * 256 + ai * 128 + wr * 64 + m * 16 + fr;
                if (pn < 8) {
                    const int c0 = (pn & 3) * 256 + cb;
                    const float* bias = (pn < 4 ? w0 : a0) + c0;
                    bf16_t* d = (pn < 4 ? dec : aa) + ((unsigned)((c0 >> 9) * MT + r) * 512u + (c0 & 511));
#pragma unroll
                    for (int bj = 0; bj < 2; ++bj)
#pragma unroll
                        for (int n = 0; n < 2; ++n) { f32x4 v = acc[ai][bj][m][n]; const float4 wb = *(const float4*)(bias + bj * 128 + n * 16);
                            v[0] += wb.x; v[1] += wb.y; v[2] += wb.z; v[3] += wb.w;
#pragma unroll
                            for (int e = 0; e < 4; ++e) { const float ex = __expf(-v[e]);
                                v[e] = pn < 4 ? -__expf(-(v[e] < -20.f ? -v[e] : __logf(1.0f + ex)) - 0.5f) : 1.0f / (1.0f + ex); }
                            *(uint2*)(d + bj * 128 + n * 16) = make_uint2(pk2(v[0], v[1]), pk2(v[2], v[3])); }
                } else {
                    bf16_t* d = gg + ((unsigned)r * 512u + (pn - 8) * 256 + cb);
#pragma unroll
                    for (int bj = 0; bj < 2; ++bj)
#pragma unroll
                        for (int n = 0; n < 2; ++n) { const f32x4 v = acc[ai][bj][m][n]; *(uint2*)(d + bj * 128 + n * 16) = make_uint2(pk2(v[0], v[1]), pk2(v[2], v[3])); }
                }
                __builtin_amdgcn_sched_barrier(0);
            }
    }
};
struct EpiFO {
    static constexpr bool PERM = false, AFTER_DRAIN = false;
    bf16_t* fo; int base, seqlen;
    __device__ __forceinline__ void operator()(const f32x4 (&acc)[2][2][4][2], const Unit& u, int wr, int wc, int fr, int fq) const {
        asm volatile("" : "+v"(fr), "+v"(fq));
#pragma unroll
        for (int ai = 0; ai < 2; ++ai)
#pragma unroll
            for (int m = 0; m < 4; ++m) {
                const int r = u.pm * 256 + ai * 128 + wr * 64 + m * 16 + fr;
#pragma unroll
                for (int bj = 0; bj < 2; ++bj)
#pragma unroll
                    for (int n = 0; n < 2; ++n) {
                        const int c = u.pn * 256 + bj * 128 + wc * 32 + n * 16 + 4 * fq; const f32x4 v = acc[ai][bj][m][n];
                        *(uint2*)(fo + (unsigned)(base + (c >> 9) * seqlen + r) * 512u + (c & 511)) = make_uint2(pk2(v[0], v[1]), pk2(v[2], v[3]));
                    }
                __builtin_amdgcn_sched_barrier(0);
            }
    }
};
struct EpiRes {
    static constexpr bool PERM = false, AFTER_DRAIN = false;
    const float *xl_in, *xc_in; float *xl_out, *xc_out; const float* ga; int row_off;
    __device__ __forceinline__ void operator()(const f32x4 (&acc)[2][2][4][2], const Unit& u, int wr, int wc, int fr, int fq) const {
        asm volatile("" : "+v"(fr), "+v"(fq));
#pragma unroll
        for (int ai = 0; ai < 2; ++ai)
#pragma unroll
            for (int m = 0; m < 4; ++m) {
                const int r = row_off + u.pm * 256 + ai * 128 + wr * 64 + m * 16 + fr;
                const bool lat = r < ML; const int s = lat ? (r >> 12) : 8;
                const float* xi = lat ? xl_in + (size_t)r * 2048 : xc_in + (size_t)(r - ML) * 2048;
                float* xo = lat ? xl_out + (size_t)r * 2048 : xc_out + (size_t)(r - ML) * 2048;
#pragma unroll
                for (int bj = 0; bj < 2; ++bj)
#pragma unroll
                    for (int n = 0; n < 2; ++n) {
                        const int c = u.pn * 256 + bj * 128 + wc * 32 + n * 16 + 4 * fq; const f32x4 v = acc[ai][bj][m][n];
                        const float4 xv = *(const float4*)(xi + c); const float4 g = *(const float4*)(ga + s * 12288 + c);
                        *(float4*)(xo + c) = make_float4(xv.x + g.x * v[0], xv.y + g.y * v[1], xv.z + g.z * v[2], xv.w + g.w * v[3]);
                    }
                __builtin_amdgcn_sched_barrier(0);
            }
    }
};
struct EpiH {
    static constexpr bool PERM = false, AFTER_DRAIN = false;
    bf16_t* o; int ld;
    __device__ __forceinline__ void operator()(const f32x4 (&acc)[2][2][4][2], const Unit& u, int wr, int wc, int fr, int fq) const {
        asm volatile("" : "+v"(fr), "+v"(fq));
#pragma unroll
        for (int ai = 0; ai < 2; ++ai)
#pragma unroll
            for (int m = 0; m < 4; ++m) {
                const int r = u.pm * 256 + ai * 128 + wr * 64 + m * 16 + fr;
#pragma unroll
                for (int bj = 0; bj < 2; ++bj)
#pragma unroll
                    for (int n = 0; n < 2; ++n) {
                        const int c = u.pn * 256 + bj * 128 + wc * 32 + n * 16 + 4 * fq; const f32x4 v = acc[ai][bj][m][n];
                        *(uint2*)(o + (size_t)r * ld + c) = make_uint2(pk2(v[0], v[1]), pk2(v[2], v[3]));
                    }
                __builtin_amdgcn_sched_barrier(0);
            }
    }
};

__device__ __forceinline__ void ld8(const bf16_t* ptr, float (&o)[8]) { const uint4 w = *(const uint4*)ptr; o[0] = lo_bf(w.x); o[1] = hi_bf(w.x); o[2] = lo_bf(w.y); o[3] = hi_bf(w.y); o[4] = lo_bf(w.z); o[5] = hi_bf(w.z); o[6] = lo_bf(w.w); o[7] = hi_bf(w.w); }
__device__ __forceinline__ void ld8f(const float* ptr, float (&o)[8]) { const float4 a = *(const float4*)ptr, b = *(const float4*)(ptr + 4); o[0] = a.x; o[1] = a.y; o[2] = a.z; o[3] = a.w; o[4] = b.x; o[5] = b.y; o[6] = b.z; o[7] = b.w; }
__device__ __forceinline__ void st8(bf16_t* ptr, const float (&o)[8]) { *(uint4*)ptr = make_uint4(pk2(o[0], o[1]), pk2(o[2], o[3]), pk2(o[4], o[5]), pk2(o[6], o[7])); }
__device__ __forceinline__ void smix8(const bf16_t* bp, bool hp, bool hn, const float* m0, const float* m1, float (&o)[8]) {
    float x[8], pv[8], nv[8], a[8], b[8]; ld8(bp, x); ld8f(m0, a); ld8f(m1, b);
    if (hp) ld8(bp - 2048, pv); else {
#pragma unroll
        for (int e = 0; e < 8; ++e) pv[e] = 0.f; }
    if (hn) ld8(bp + 2048, nv); else {
#pragma unroll
        for (int e = 0; e < 8; ++e) nv[e] = 0.f; }
#pragma unroll
    for (int e = 0; e < 8; ++e) o[e] = x[e] + a[e] * (pv[e] - x[e]) + b[e] * (nv[e] - x[e]);
}
__device__ __forceinline__ void seq_of(int row, int& t, int& L) { if (row < ML) { t = row & 4095; L = 4096; } else { t = (row - ML) & 255; L = 256; } }
__device__ __forceinline__ void prep_phase(const Params& p, int l) {
    const float* mu0 = p.mu + (size_t)l * 2 * 1920; const float* mu1 = mu0 + 1920;
#pragma unroll 1
    for (int idx = blockIdx.x * 512 + otid(); idx < MT * 48; idx += gridDim.x * 512) {
        const int row = idx / 48, cc = (idx % 48) * 8; int t, L; seq_of(row, t, L);
        int rc, mc; if (cc < 128) { rc = 1664 + cc; mc = 1664 + cc; } else if (cc < 256) { rc = 1792 + (cc - 128); mc = 1792 + (cc - 128); } else { rc = 1536 + (cc - 256); mc = 512 + (cc - 256); }
        float sm[8]; smix8(p.rw + (size_t)row * 2048 + rc, t > 0, t < L - 1, mu0 + mc, mu1 + mc, sm);
#pragma unroll
        for (int e = 0; e < 8; ++e) sm[e] = cc < 128 ? tanhf(sm[e]) : (cc < 256 ? sm[e] : sigmoidf_(sm[e]));
        st8(p.a2b + (size_t)row * 384 + cc, sm);
    }
}

__device__ __forceinline__ int scan_row(int st, int dir, int b, int& t, int& L) {
    if (st < 256) { t = dir ? 255 - st : st; L = 256; return ML + b * 256 + t; }
    const int s2 = st - 256; t = dir ? 4095 - s2 : s2; L = 4096; return b * 4096 + t;
}
struct ScanRaw { uint4 r0, rp, rn, k0, kp, kn, v0, vp, vn, a, e; float mp, mn; };
__device__ __forceinline__ void up8(const uint4& w, float (&o)[8]) { o[0] = lo_bf(w.x); o[1] = hi_bf(w.x); o[2] = lo_bf(w.y); o[3] = hi_bf(w.y); o[4] = lo_bf(w.z); o[5] = hi_bf(w.z); o[6] = lo_bf(w.w); o[7] = hi_bf(w.w); }
__device__ __forceinline__ void scan_load(const Params& p, int chunk, int dir, int b, int h, int pw, int lane, ScanRaw& R) {
    const int sl = pw * 8 + (lane >> 3), col = h * 64 + (lane & 7) * 8;
    int t, L; const int row = scan_row(chunk * 32 + sl, dir, b, t, L);
    const bool hp = t > 0, hn = t < L - 1; const int op = hp ? -2048 : 0, on = hn ? 2048 : 0;
    const bf16_t* bp = p.rw + (size_t)row * 2048 + col;
    R.r0 = *(const uint4*)bp; R.rp = *(const uint4*)(bp + op); R.rn = *(const uint4*)(bp + on);
    R.k0 = *(const uint4*)(bp + 512); R.kp = *(const uint4*)(bp + 512 + op); R.kn = *(const uint4*)(bp + 512 + on);
    R.v0 = *(const uint4*)(bp + 1024); R.vp = *(const uint4*)(bp + 1024 + op); R.vn = *(const uint4*)(bp + 1024 + on);
    R.a = *(const uint4*)(p.aa + ((size_t)dir * MT + row) * 512 + col); R.e = *(const uint4*)(p.dec + ((size_t)dir * MT + row) * 512 + col);
    R.mp = hp ? 1.0f : 0.0f; R.mn = hn ? 1.0f : 0.0f;
}
__device__ __forceinline__ void scan_emit(const ScanRaw& R, const float* cb, float* buf, int pw, int lane) {
    const int sl = pw * 8 + (lane >> 3), cg = lane & 7;
    float x[8], pv[8], nv[8], r[8], k[8], v[8], a[8], e[8], kk[8], m0[8], m1[8];
    up8(R.r0, x); up8(R.rp, pv); up8(R.rn, nv); ld8f(cb + cg * 8, m0); ld8f(cb + 64 + cg * 8, m1);
#pragma unroll
    for (int i = 0; i < 8; ++i) r[i] = x[i] + m0[i] * (pv[i] * R.mp - x[i]) + m1[i] * (nv[i] * R.mn - x[i]);
    up8(R.k0, x); up8(R.kp, pv); up8(R.kn, nv); ld8f(cb + 128 + cg * 8, m0); ld8f(cb + 192 + cg * 8, m1);
#pragma unroll
    for (int i = 0; i < 8; ++i) k[i] = x[i] + m0[i] * (pv[i] * R.mp - x[i]) + m1[i] * (nv[i] * R.mn - x[i]);
    up8(R.v0, x); up8(R.vp, pv); up8(R.vn, nv); ld8f(cb + 256 + cg * 8, m0); ld8f(cb + 320 + cg * 8, m1);
#pragma unroll
    for (int i = 0; i < 8; ++i) v[i] = x[i] + m0[i] * (pv[i] * R.mp - x[i]) + m1[i] * (nv[i] * R.mn - x[i]);
    up8(R.a, a); up8(R.e, e); ld8f(cb + 384 + cg * 8, m0); ld8f(cb + 448 + cg * 8, m1);
    float n2 = 0.f;
#pragma unroll
    for (int i = 0; i < 8; ++i) { kk[i] = k[i] * m0[i]; n2 += kk[i] * kk[i]; }
    n2 += __shfl_xor(n2, 1); n2 += __shfl_xor(n2, 2); n2 += __shfl_xor(n2, 4);
    const float inv = 1.0f / fmaxf(sqrtf(n2), 1e-12f);
    float* o = buf + sl * 384 + cg * 8;
#pragma unroll
    for (int i = 0; i < 8; ++i) { kk[i] *= inv; e[i] = __expf(e[i]); k[i] = k[i] * (1.0f + (a[i] - 1.0f) * m1[i]); a[i] = kk[i] * a[i]; }
    *(float4*)(o) = make_float4(e[0], e[1], e[2], e[3]); *(float4*)(o + 4) = make_float4(e[4], e[5], e[6], e[7]);
    *(float4*)(o + 64) = make_float4(kk[0], kk[1], kk[2], kk[3]); *(float4*)(o + 68) = make_float4(kk[4], kk[5], kk[6], kk[7]);
    *(float4*)(o + 128) = make_float4(a[0], a[1], a[2], a[3]); *(float4*)(o + 132) = make_float4(a[4], a[5], a[6], a[7]);
    *(float4*)(o + 192) = make_float4(k[0], k[1], k[2], k[3]); *(float4*)(o + 196) = make_float4(k[4], k[5], k[6], k[7]);
    *(float4*)(o + 256) = make_float4(r[0], r[1], r[2], r[3]); *(float4*)(o + 260) = make_float4(r[4], r[5], r[6], r[7]);
    *(float4*)(o + 320) = make_float4(v[0], v[1], v[2], v[3]); *(float4*)(o + 324) = make_float4(v[4], v[5], v[6], v[7]);
}
__device__ __forceinline__ void scan_phase(const Params& p, int l, unsigned char* shm) {
    const int tid = otid(), wave = tid >> 6, lane = tid & 63;
    float* buf0 = (float*)shm; float* buf1 = buf0 + 32 * 384;
#pragma unroll 1
    for (int wi = blockIdx.x; wi < 256; wi += gridDim.x) {
        const int dir = wi >> 7, b = (wi >> 4) & 7, h = (wi >> 1) & 7, half = wi & 1;
        const int ri = lane >> 3, cj = lane & 7, irow = half * 32 + (wave & 3) * 8 + ri;
        pg8::f32x2 s0 = {0.f, 0.f}, s1 = {0.f, 0.f}, s2 = {0.f, 0.f}, s3 = {0.f, 0.f};
        ScanRaw R; float* cb = buf0 + 2 * 32 * 384;
        __syncthreads();
        if (wave == 4) { const float* mu0 = p.mu + (size_t)l * 2 * 1920; const float* mu1 = mu0 + 1920; const int col = h * 64 + lane;
            cb[lane] = mu0[col]; cb[64 + lane] = mu1[col]; cb[128 + lane] = mu0[640 + col]; cb[192 + lane] = mu1[640 + col]; cb[256 + lane] = mu0[1152 + col]; cb[320 + lane] = mu1[1152 + col];
            cb[384 + lane] = p.kk_scale[l * 512 + col]; cb[448 + lane] = p.ka[l * 512 + col]; }
        __syncthreads();
        if (wave >= 4) {
            scan_load(p, 0, dir, b, h, wave - 4, lane, R); scan_emit(R, cb, buf0, wave - 4, lane); scan_load(p, 1, dir, b, h, wave - 4, lane, R);
        }
        __syncthreads();
        if (wave < 4) __builtin_amdgcn_s_setprio(2);
#pragma unroll 1
        for (int c = 0; c < 136; ++c) {
            float* cur = (c & 1) ? buf1 : buf0; float* nxt = (c & 1) ? buf0 : buf1;
            if (wave >= 4) { if (c + 1 < 136) { scan_emit(R, cb, nxt, wave - 4, lane); if (c + 2 < 136) scan_load(p, c + 2, dir, b, h, wave - 4, lane, R); } }
            else {
#define SC_LOAD(X, SL) { const float* o_ = cur + (SL) * 384 + cj * 8; X##w0 = *(const f32x4*)(o_); X##w1 = *(const f32x4*)(o_ + 4); X##k0 = *(const f32x4*)(o_ + 64); X##k1 = *(const f32x4*)(o_ + 68); \
                    X##b0 = *(const f32x4*)(o_ + 128); X##b1 = *(const f32x4*)(o_ + 132); X##d0 = *(const f32x4*)(o_ + 192); X##d1 = *(const f32x4*)(o_ + 196); X##r0 = *(const f32x4*)(o_ + 256); X##r1 = *(const f32x4*)(o_ + 260); \
                    X##vv = cur[(SL) * 384 + 320 + irow]; }
#define SC_STEP(X, SL) { pg8::f32x2 ac = s0 * X##k0.xy; ac += s1 * X##k0.zw; ac += s2 * X##k1.xy; ac += s3 * X##k1.zw; \
                    float sa = ac.x + ac.y; sa = sum8(sa); const pg8::f32x2 sa2 = {-sa, -sa}, vv2 = {X##vv, X##vv}; \
                    s0 = s0 * X##w0.xy + sa2 * X##b0.xy + vv2 * X##d0.xy; s1 = s1 * X##w0.zw + sa2 * X##b0.zw + vv2 * X##d0.zw; s2 = s2 * X##w1.xy + sa2 * X##b1.xy + vv2 * X##d1.xy; s3 = s3 * X##w1.zw + sa2 * X##b1.zw + vv2 * X##d1.zw; \
                    pg8::f32x2 yc = s0 * X##r0.xy; yc += s1 * X##r0.zw; yc += s2 * X##r1.xy; yc += s3 * X##r1.zw; \
                    float yv = yc.x + yc.y; yv = sum8(yv); \
                    yk = (cj == ((SL) & 7)) ? yv : yk; }
                const int st0 = c * 32, row0 = c < 8 ? ML + b * 256 + (dir ? 255 - st0 : st0) : b * 4096 + (dir ? 4095 - (st0 - 256) : st0 - 256);
                bf16_t* yp = p.y + ((size_t)dir * MT + row0) * 512 + h * 64 + irow; const int ystep = dir ? -512 : 512;
                f32x4 Aw0, Aw1, Ak0, Ak1, Ab0, Ab1, Ad0, Ad1, Ar0, Ar1, Bw0, Bw1, Bk0, Bk1, Bb0, Bb1, Bd0, Bd1, Br0, Br1; float Avv, Bvv;
                SC_LOAD(A, 0)
                bf16_t* ypl = yp + cj * ystep;
#pragma unroll 1
                for (int s8 = 0; s8 < 32; s8 += 8) {
                    float yk = 0.f;
#pragma unroll
                    for (int j = 0; j < 8; j += 2) {
                        SC_LOAD(B, s8 + j + 1)
                        SC_STEP(A, j)
                        SC_LOAD(A, s8 + j + 2)
                        SC_STEP(B, j + 1)
                    }
                    ypl[s8 * ystep] = f2bf(yk);
                }
#undef SC_LOAD
#undef SC_STEP
            }
            __syncthreads();
        }
        __builtin_amdgcn_s_setprio(0);
    }
}

__device__ __forceinline__ void attn_phase(const Params& p, int l, unsigned char* shm) {
    const int tid = otid(), wave = tid >> 6, lane = tid & 63, fr = lane & 15, fq = lane >> 4;
    const int g = wave >> 1, qh = wave & 1;
    bf16_t* Ks = (bf16_t*)shm;
    bf16_t* Vs = (bf16_t*)(shm + 64 * 136 * 2);
    const float scale = 0.08838834764831845f;
#pragma unroll 1
    for (int un = (int)((blockIdx.x + gridDim.x - (80u % gridDim.x)) % gridDim.x); un < (l == 3 ? 1024 : 1088); un += gridDim.x) {
        const bool lat = un < 1024; int b, qb, hk;
        if (lat) { b = un >> 7; qb = (un >> 1) & 63; hk = un & 1; } else { const int v = un - 1024; b = v >> 3; qb = (v >> 1) & 3; hk = v & 1; }
        const int q0 = qb * 64, rowbase = lat ? b * 4096 : ML + b * 256, hq = hk * 4 + g;
        bf16x8 Qf[2][4];
#pragma unroll
        for (int qt = 0; qt < 2; ++qt)
#pragma unroll
            for (int ks = 0; ks < 4; ++ks) Qf[qt][ks] = *(const bf16x8*)(p.q + (size_t)(rowbase + q0 + qh * 32 + qt * 16 + fr) * 1024 + hq * 128 + ks * 32 + fq * 8);
        const float sinkv = p.sink[l * 8 + hq];
        float mrun[2] = {sinkv, sinkv}, lsum[2]; lsum[0] = lsum[1] = (fq == 0) ? 1.0f : 0.0f;
        f32x4 O[8][2];
#pragma unroll
        for (int dt = 0; dt < 8; ++dt) { O[dt][0] = (f32x4){0.f, 0.f, 0.f, 0.f}; O[dt][1] = (f32x4){0.f, 0.f, 0.f, 0.f}; }
        const int jlo = lat ? (qb < 2 ? 2 - qb : 0) : 0, jhi = lat ? (65 - qb < 4 ? 65 - qb : 4) : -1;
        const int nloc = lat ? jhi - jlo + 1 : 0, nkb = nloc + 4;
        uint4 ra, rc, rv0, rv1;
#define AT_LOAD(I) { const int i_ = (I); const bool loc_ = i_ < nloc; const int kp_ = loc_ ? q0 - 128 + 64 * (jlo + i_) : 0, cb_ = i_ - nloc; \
            const int krow_ = loc_ ? b * 4096 + kp_ : ML + b * 256 + cb_ * 64; \
            const bf16_t* vsrc_ = loc_ ? p.vt + (size_t)(b * 256 + hk * 128) * 4096 + kp_ : p.vtc + (size_t)(b * 256 + hk * 128) * 256 + cb_ * 64; const int vstr_ = loc_ ? 4096 : 256; \
            const uint4* s1_ = (const uint4*)(p.ak + (size_t)(krow_ + (tid >> 3)) * 256 + hk * 128 + (tid & 7) * 16); ra = s1_[0]; rc = s1_[1]; \
            const uint4* s2_ = (const uint4*)(vsrc_ + (size_t)(tid >> 2) * vstr_ + (tid & 3) * 16); rv0 = s2_[0]; rv1 = s2_[1]; }
        AT_LOAD(0)
#pragma unroll 1
        for (int kb = 0; kb < nkb; ++kb) {
            const bool local = kb < nloc; const int kp0 = local ? q0 - 128 + 64 * (jlo + kb) : 0;
            __syncthreads();
            {
                const int key = tid >> 3, ch = tid & 7, dd = tid >> 2, c4 = tid & 3;
                uint4* d1 = (uint4*)(Ks + key * 136 + ch * 16); d1[0] = ra; d1[1] = rc;
                uint2* d2 = (uint2*)(Vs + dd * 68 + c4 * 16); d2[0] = make_uint2(rv0.x, rv0.y); d2[1] = make_uint2(rv0.z, rv0.w); d2[2] = make_uint2(rv1.x, rv1.y); d2[3] = make_uint2(rv1.z, rv1.w);
            }
            __syncthreads();
            if (kb + 1 < nkb) AT_LOAD(kb + 1)
            f32x4 S[4][2];
#pragma unroll
            for (int kt = 0; kt < 4; ++kt) { S[kt][0] = (f32x4){0.f, 0.f, 0.f, 0.f}; S[kt][1] = (f32x4){0.f, 0.f, 0.f, 0.f};
#pragma unroll
                for (int ks = 0; ks < 4; ++ks) { const bf16x8 Kf = *(const bf16x8*)(Ks + (kt * 16 + fr) * 136 + ks * 32 + fq * 8);
                    S[kt][0] = __builtin_amdgcn_mfma_f32_16x16x32_bf16(Kf, Qf[0][ks], S[kt][0], 0, 0, 0); S[kt][1] = __builtin_amdgcn_mfma_f32_16x16x32_bf16(Kf, Qf[1][ks], S[kt][1], 0, 0, 0); } }
#pragma unroll
            for (int qt = 0; qt < 2; ++qt) {
                const int qp = q0 + qh * 32 + qt * 16 + fr; float mx = -1e30f;
#pragma unroll
                for (int kt = 0; kt < 4; ++kt)
#pragma unroll
                    for (int e = 0; e < 4; ++e) { float sv = S[kt][qt][e] * scale; if (local) { const int dlt = kp0 + kt * 16 + 4 * fq + e - qp; if (dlt > 128 || dlt < -128) sv = -1e30f; } S[kt][qt][e] = sv; mx = fmaxf(mx, sv); }
                mx = fmaxf(mx, __shfl_xor(mx, 16)); mx = fmaxf(mx, __shfl_xor(mx, 32));
                const float mnew = fmaxf(mrun[qt], mx), alpha = __expf(mrun[qt] - mnew); mrun[qt] = mnew;
                float ps = 0.f;
#pragma unroll
                for (int kt = 0; kt < 4; ++kt)
#pragma unroll
                    for (int e = 0; e < 4; ++e) { const float pv = __expf(S[kt][qt][e] - mnew); S[kt][qt][e] = pv; ps += pv; }
                lsum[qt] = lsum[qt] * alpha + ps;
#pragma unroll
                for (int dt = 0; dt < 8; ++dt) O[dt][qt] *= alpha;
            }
#pragma unroll
            for (int kg = 0; kg < 2; ++kg) {
                bf16x8 Pf[2];
#pragma unroll
                for (int qt = 0; qt < 2; ++qt) { const uint4 w = make_uint4(pk2(S[2 * kg][qt][0], S[2 * kg][qt][1]), pk2(S[2 * kg][qt][2], S[2 * kg][qt][3]), pk2(S[2 * kg + 1][qt][0], S[2 * kg + 1][qt][1]), pk2(S[2 * kg + 1][qt][2], S[2 * kg + 1][qt][3])); Pf[qt] = *(const bf16x8*)&w; }
#pragma unroll
                for (int dt = 0; dt < 8; ++dt) {
                    const uint2 lo = *(const uint2*)(Vs + (dt * 16 + fr) * 68 + kg * 32 + 4 * fq), hi = *(const uint2*)(Vs + (dt * 16 + fr) * 68 + kg * 32 + 16 + 4 * fq);
                    const uint4 w = make_uint4(lo.x, lo.y, hi.x, hi.y); const bf16x8 Vf = *(const bf16x8*)&w;
                    O[dt][0] = __builtin_amdgcn_mfma_f32_16x16x32_bf16(Vf, Pf[0], O[dt][0], 0, 0, 0); O[dt][1] = __builtin_amdgcn_mfma_f32_16x16x32_bf16(Vf, Pf[1], O[dt][1], 0, 0, 0);
                }
            }
        }
#pragma unroll
        for (int qt = 0; qt < 2; ++qt) {
            float lt = lsum[qt]; lt += __shfl_xor(lt, 16); lt += __shfl_xor(lt, 32); const float inv = 1.0f / lt;
            bf16_t* d = p.at + (size_t)(rowbase + q0 + qh * 32 + qt * 16 + fr) * 1024 + hq * 128 + 4 * fq;
#pragma unroll
            for (int dt = 0; dt < 8; ++dt) { const f32x4 o = O[dt][qt] * inv; *(uint2*)(d + dt * 16) = make_uint2(pk2(o[0], o[1]), pk2(o[2], o[3])); }
        }
    }
#undef AT_LOAD
    __syncthreads();
}

__device__ __forceinline__ void fin_phase(const Params& p, int l, bf16_t* cat) {
    const int wave = otid() >> 6, lane = otid() & 63;
    const float* mu0 = p.mu + (size_t)l * 2 * 1920; const float* mu1 = mu0 + 1920;
#pragma unroll 1
    for (int row = blockIdx.x * 8 + wave; row < MT; row += gridDim.x * 8) {
        int t, L; seq_of(row, t, L); const bool hp = t > 0, hn = t < L - 1;
        bf16_t* co = cat + (size_t)row * 2048;
        {
            float v[8], g[8]; ld8(p.fo + (size_t)row * 512 + lane * 8, v); ld8f(p.f_g + l * 512 + lane * 8, g);
            float ss = 0.f;
#pragma unroll
            for (int e = 0; e < 8; ++e) ss += v[e] * v[e];
            ss = wave_sum(ss); const float rs = rsqrtf(ss * (1.0f / 512.0f) + 1e-6f);
#pragma unroll
            for (int e = 0; e < 8; ++e) v[e] = v[e] * rs * g[e];
            st8(co + lane * 8, v);
        }
        __builtin_amdgcn_sched_barrier(0);
        {
            float v0[8], v1[8], g0[8], g1[8]; ld8(p.at + (size_t)row * 1024 + lane * 16, v0); ld8(p.at + (size_t)row * 1024 + lane * 16 + 8, v1); ld8f(p.a_g + l * 1024 + lane * 16, g0); ld8f(p.a_g + l * 1024 + lane * 16 + 8, g1);
            float ss = 0.f;
#pragma unroll
            for (int e = 0; e < 8; ++e) ss += v0[e] * v0[e] + v1[e] * v1[e];
            ss = wave_sum(ss); const float rs = rsqrtf(ss * (1.0f / 1024.0f) + 1e-6f);
#pragma unroll
            for (int e = 0; e < 8; ++e) { v0[e] = v0[e] * rs * g0[e]; v1[e] = v1[e] * rs * g1[e]; }
            st8(co + 1024 + lane * 16, v0); st8(co + 1024 + lane * 16 + 8, v1);
        }
        __builtin_amdgcn_sched_barrier(0);
        {
            const int col = lane * 8;
            const bf16_t* bp = p.rw + (size_t)row * 2048 + col;
            float bs = 0.f;
            {   float r[8], k[8], a0[8], a1[8], kav[8], rkv[8];
                smix8(bp, hp, hn, mu0 + col, mu1 + col, r); smix8(bp + 512, hp, hn, mu0 + 640 + col, mu1 + 640 + col, k);
                ld8(p.aa + (size_t)row * 512 + col, a0); ld8(p.aa + ((size_t)MT + row) * 512 + col, a1); ld8f(p.ka + l * 512 + col, kav); ld8f(p.rk + l * 512 + col, rkv);
#pragma unroll
                for (int e = 0; e < 8; ++e) { const float kd = k[e] * (2.0f + (a0[e] + a1[e] - 2.0f) * kav[e]); bs += r[e] * kd * rkv[e]; }
                bs += __shfl_xor(bs, 1); bs += __shfl_xor(bs, 2); bs += __shfl_xor(bs, 4); }
            __builtin_amdgcn_sched_barrier(0);
            float y0[8];
            {   float y1[8]; ld8(p.y + (size_t)row * 512 + col, y0); ld8(p.y + ((size_t)MT + row) * 512 + col, y1);
                float sm = 0.f;
#pragma unroll
                for (int e = 0; e < 8; ++e) { y0[e] += y1[e]; sm += y0[e]; }
                sm += __shfl_xor(sm, 1); sm += __shfl_xor(sm, 2); sm += __shfl_xor(sm, 4);
                const float mean = sm * (1.0f / 64.0f); float vs = 0.f;
#pragma unroll
                for (int e = 0; e < 8; ++e) { y0[e] -= mean; vs += y0[e] * y0[e]; }
                vs += __shfl_xor(vs, 1); vs += __shfl_xor(vs, 2); vs += __shfl_xor(vs, 4);
                const float rs = rsqrtf(vs * (1.0f / 64.0f) + 64e-5f);
#pragma unroll
                for (int e = 0; e < 8; ++e) y0[e] *= rs; }
            __builtin_amdgcn_sched_barrier(0);
            {   float v[8], lw[8], lb[8], gv[8], o[8];
                smix8(bp + 1024, hp, hn, mu0 + 1152 + col, mu1 + 1152 + col, v);
                ld8f(p.lnx_w + l * 512 + col, lw); ld8f(p.lnx_b + l * 512 + col, lb); ld8(p.gg + (size_t)row * 512 + col, gv);
#pragma unroll
                for (int e = 0; e < 8; ++e) o[e] = (y0[e] * lw[e] + lb[e] + bs * v[e]) * gv[e];
                st8(co + 512 + col, o); }
        }
        __builtin_amdgcn_sched_barrier(0);
    }
}

__device__ __forceinline__ void conv_phase(const Params& p, int l, int r0, int Mp) {
    const float* cw = p.conv_w + (size_t)l * 3 * DFF; const float* cb = p.conv_b + (size_t)l * DFF;
#pragma unroll 1
    for (int idx = blockIdx.x * 512 + otid(); idx < Mp * 704; idx += gridDim.x * 512) {
        const int rl = idx / 704, ch = (idx % 704) * 8; int t, L; seq_of(r0 + rl, t, L);
        const bf16_t* hp_ = p.h + (size_t)rl * 11264 + ch;
        float x[8], pv[8], nv[8], up[8], w0[8], w1[8], w2[8], bb[8], o[8];
        ld8(hp_, x); ld8(hp_ + DFF, up); ld8f(cw + ch, w0); ld8f(cw + DFF + ch, w1); ld8f(cw + 2 * DFF + ch, w2); ld8f(cb + ch, bb);
        if (t > 0) ld8(hp_ - 11264, pv); else {
#pragma unroll
            for (int e = 0; e < 8; ++e) pv[e] = 0.f; }
        if (t < L - 1) ld8(hp_ + 11264, nv); else {
#pragma unroll
            for (int e = 0; e < 8; ++e) nv[e] = 0.f; }
#pragma unroll
        for (int e = 0; e < 8; e += 2) { pg8::f32x2 gt; gt.x = pv[e] * w0[e] + x[e] * w1[e] + nv[e] * w2[e] + bb[e]; gt.y = pv[e + 1] * w0[e + 1] + x[e + 1] * w1[e + 1] + nv[e + 1] * w2[e + 1] + bb[e + 1];
            const pg8::f32x2 ge = pg8::gelu_pk(gt); o[e] = ge.x * up[e]; o[e + 1] = ge.y * up[e + 1]; }
        st8(p.act + (size_t)rl * DFF + ch, o);
    }
}

__device__ __forceinline__ void final_norm(const Params& p) {
    const int wave = otid() >> 6, lane = otid() & 63;
#pragma unroll 1
    for (int row = blockIdx.x * 8 + wave; row < ML; row += gridDim.x * 8) {
        float4* src = (float4*)(p.out + (size_t)row * 2048);
        float4 v[8]; float ss = 0.f;
#pragma unroll
        for (int i = 0; i < 8; ++i) { v[i] = src[lane + 64 * i]; ss += v[i].x * v[i].x + v[i].y * v[i].y + v[i].z * v[i].z + v[i].w * v[i].w; }
        ss = wave_sum(ss); const float rs = rsqrtf(ss * (1.0f / 2048.0f) + 1e-6f);
        const float4* g4 = (const float4*)p.final_g;
#pragma unroll
        for (int i = 0; i < 8; ++i) { const float4 g = g4[lane + 64 * i]; src[lane + 64 * i] = make_float4(v[i].x * rs * g.x, v[i].y * rs * g.y, v[i].z * rs * g.z, v[i].w * rs * g.w); }
    }
}

struct SkewOrder : StaticOrder {
    int skew;
    __device__ __forceinline__ bool next(int i, Unit& u) const {
        if (!skew) return StaticOrder::next(i, u);
        if (c < 64) return i < 8 ? StaticOrder::next(i, u) : false;
        if (i < 11) return StaticOrder::next(i, u);
        if (i == 11) { const int j = c - 64; StaticOrder t = *this; t.c = j & 63; return t.next(8 + (j >> 6), u); }
        return false;
    }
};
#define LDS_BYTES (131072 + 256)
#define GBAR() xcd_barrier(bar)
__device__ __forceinline__ int opq(int v) { asm volatile("" : "+s"(v)); return v; }
__global__ void __launch_bounds__(512, 2) hymba_fwd(Params p) {
    extern __shared__ __attribute__((aligned(16))) unsigned char shm[];
    PG8_LAS unsigned char* lds = (PG8_LAS unsigned char*)shm;
    volatile LAS unsigned* st = (volatile LAS unsigned*)(lds + 131072);
    if (threadIdx.x == 0) { st[0] = 0u; st[1] = 0u; st[2] = 0u; st[3] = 0u; }
    __syncthreads();
    XcdBarrier bar = xcd_barrier_post(p.bar, st);
    const int G = gridDim.x, bid = blockIdx.x;
#ifndef SK_PRO
    prologue(p, shm);
#endif
    GBAR();
#pragma unroll 1
    for (int l = 0; l < 4; ++l) {
        const float* modl = p.mod + (size_t)l * MODL;
        const float* xl_in = l == 0 ? p.x : p.out; const float* xc_in = l == 0 ? p.ctx : p.xc;
#ifndef SK_NORM
        norm_mod(xl_in, xc_in, p.norm1_g + l * 2048, modl, 0, 2048, p.u);
#endif
        GBAR();
        { EpiIn E; E.q = p.q; E.ak = p.ak; E.vt = p.vt; E.vtc = p.vtc; E.rw = p.rw; E.ft = p.ft; E.ftc = p.ftc; E.rope = p.rope;
          StaticOrder S; S.init(opq(MT), opq(NIN), G, bid); Gemm g; g.A = p.u; g.Bt = p.wt_in + (size_t)l * NIN * 2048; g.M = opq(MT); g.N = opq(NIN); g.K = opq(2048);

#ifndef SK_GIN
          pg8::gemm_phase<EpiIn, StaticOrder, false>(lds, g, S, E, nullptr);
#endif
 }
        GBAR();
#ifndef SK_PREP
        prep_phase(p, l);
#endif
        GBAR();
        { EpiLR E; E.dec = p.dec; E.aa = p.aa; E.gg = p.gg; E.w0 = p.w0 + l * 1024; E.a0 = p.a0 + l * 1024;
          StaticOrder S; S.init(opq(MT), opq(2560), G, bid); Gemm g; g.A = p.a2b; g.Bt = p.wt_lr + (size_t)l * 2560 * 384; g.M = opq(MT); g.N = opq(2560); g.K = opq(384);

#ifndef SK_GLR
          pg8::gemm_phase<EpiLR, StaticOrder, false>(lds, g, S, E, nullptr);
#endif
 }
        __syncthreads();
        { EpiFO E; E.fo = p.fo; E.base = 0; E.seqlen = 4096;
          StaticOrder S; S.init(opq(4096), opq(4096), G, bid); Gemm g; g.A = p.wf; g.Bt = p.ft; g.M = opq(4096); g.N = opq(4096); g.K = opq(8192);

#ifndef SK_GFO
          pg8::gemm_phase<EpiFO, StaticOrder, false>(lds, g, S, E, nullptr);
#endif
 }
        __syncthreads();
        { EpiFO E; E.fo = p.fo; E.base = ML; E.seqlen = 256;
          StaticOrder S; S.init(opq(256), opq(4096), G, (bid + G - (160 % G)) % G); Gemm g; g.A = p.wfc; g.Bt = p.ftc; g.M = opq(256); g.N = opq(4096); g.K = opq(512);

#ifndef SK_GFO
          pg8::gemm_phase<EpiFO, StaticOrder, false>(lds, g, S, E, nullptr);
#endif
 }
        __syncthreads();
#ifndef SK_ATT
        attn_phase(p, l, shm);
#endif
        GBAR();
#ifndef SK_SCAN
        scan_phase(p, l, shm);
#endif
        GBAR();
#ifndef SK_FIN
        fin_phase(p, l, p.u);
#endif
        GBAR();
        { EpiRes E; E.xl_in = xl_in; E.xc_in = xc_in; E.xl_out = p.out; E.xc_out = p.xc; E.ga = modl + 4096; E.row_off = 0;
          const int Mo = l == 3 ? ML : MT;
          StaticOrder S; S.init(opq(Mo), opq(2048), G, bid); Gemm g; g.A = p.u; g.Bt = p.wt_out + (size_t)l * 2048 * 2048; g.M = opq(Mo); g.N = opq(2048); g.K = opq(2048);

#ifndef SK_GRES
          pg8::gemm_phase<EpiRes, StaticOrder, false>(lds, g, S, E, nullptr);
#endif
 }
        GBAR();
        norm_mod(p.out, p.xc, p.norm2_g + l * 2048, modl, 6144, 8192, p.u);
        GBAR();
#pragma unroll 1
        for (int part = 0; part < 2; ++part) {
            const int r0 = part ? 0 : 16384, Mp = (!part && l != 3) ? 18432 : 16384;
            { EpiH E; E.o = p.h; E.ld = 11264;
              SkewOrder S; S.init(opq(Mp), opq(11264), G, bid); S.skew = (part == 1 && l != 3 && G == 256) ? 1 : 0;
              Gemm g; g.A = p.u + (size_t)r0 * 2048; g.Bt = p.wt_f1 + (size_t)l * 11264 * 2048; g.M = opq(Mp); g.N = opq(11264); g.K = opq(2048);

#ifndef SK_GH
              pg8::gemm_phase<EpiH, SkewOrder, false>(lds, g, S, E, nullptr);
#endif
 }
            GBAR();
#ifndef SK_CONV
            conv_phase(p, l, r0, Mp);
#endif
            GBAR();
            { EpiRes E; E.xl_in = p.out; E.xc_in = p.xc; E.xl_out = p.out; E.xc_out = p.xc; E.ga = modl + 10240; E.row_off = r0;
              StaticOrder S; S.init(opq(Mp), opq(2048), G, bid); Gemm g; g.A = p.act; g.Bt = p.wt_f2 + (size_t)l * 2048 * DFF; g.M = opq(Mp); g.N = opq(2048); g.K = opq(DFF);

#ifndef SK_GRES
          pg8::gemm_phase<EpiRes, StaticOrder, false>(lds, g, S, E, nullptr);
#endif
 }
            if (part) GBAR(); else __syncthreads();
        }
    }
    final_norm(p);
}

extern "C" void kernel_launch(void* const* d_in, const int* in_sizes, int n_in, void* d_out, int out_size, void* d_ws, size_t ws_size, hipStream_t stream) {
    (void)in_sizes; (void)n_in; (void)out_size; (void)ws_size;
    Params p{};
    const float** pf = (const float**)&p;
    for (int i = 0; i < 29; ++i) pf[i] = (const float*)d_in[i];
    p.out = (float*)d_out;
    char* w = (char*)d_ws; size_t off = 0;
    auto take = [&](size_t bytes) { char* r = w + off; off += (bytes + 255) & ~(size_t)255; return r; };
    p.bar = (unsigned*)take(XCD_BAR_WORDS * 4);
    p.mod = (float*)take((size_t)4 * MODL * 4);
    p.rope = (float*)take((size_t)4096 * 64 * 2 * 4);
    p.xc = (float*)take((size_t)2048 * 2048 * 4);
    p.wt_in = (bf16_t*)take((size_t)4 * NIN * 2048 * 2);
    p.wt_out = (bf16_t*)take((size_t)4 * 2048 * 2048 * 2);
    p.wt_f1 = (bf16_t*)take((size_t)4 * 11264 * 2048 * 2);
    p.wt_f2 = (bf16_t*)take((size_t)4 * 2048 * DFF * 2);
    p.wt_lr = (bf16_t*)take((size_t)4 * 2560 * 384 * 2);
    p.wf = (bf16_t*)take((size_t)4096 * 8192 * 2);
    p.wfc = (bf16_t*)take((size_t)256 * 512 * 2);
    p.u = (bf16_t*)take((size_t)MT * 2048 * 2);
    const size_t mix0 = off;
    p.q = (bf16_t*)take((size_t)MT * 1024 * 2);
    p.ak = (bf16_t*)take((size_t)MT * 256 * 2);
    p.vt = (bf16_t*)take((size_t)8 * 256 * 4096 * 2);
    p.vtc = (bf16_t*)take((size_t)8 * 256 * 256 * 2);
    p.rw = (bf16_t*)take((size_t)MT * 2048 * 2);
    p.ft = (bf16_t*)take((size_t)8 * 512 * 8192 * 2);
    p.ftc = (bf16_t*)take((size_t)8 * 512 * 512 * 2);
    p.dec = (bf16_t*)take((size_t)2 * MT * 512 * 2);
    p.aa = (bf16_t*)take((size_t)2 * MT * 512 * 2);
    p.gg = (bf16_t*)take((size_t)MT * 512 * 2);
    p.y = (bf16_t*)take((size_t)2 * MT * 512 * 2);
    p.a2b = p.y;
    p.fo = (bf16_t*)take((size_t)MT * 512 * 2);
    p.at = (bf16_t*)take((size_t)MT * 1024 * 2);
    p.h = (bf16_t*)(w + mix0);
    p.act = p.h + (size_t)18432 * 11264;
    static int grid = 0;
    if (!grid) {
        int dev = 0, cus = 0, per_cu = 0;
        hipGetDevice(&dev); hipDeviceGetAttribute(&cus, hipDeviceAttributeMultiprocessorCount, dev);
        if (hipFuncSetAttribute((const void*)hymba_fwd, hipFuncAttributeMaxDynamicSharedMemorySize, LDS_BYTES) != hipSuccess) fprintf(stderr, "hipFuncSetAttribute failed\n");
        if (hipOccupancyMaxActiveBlocksPerMultiprocessor(&per_cu, (const void*)hymba_fwd, 512, LDS_BYTES) != hipSuccess || per_cu < 1) { fprintf(stderr, "occupancy query failed\n"); per_cu = 1; }
        grid = cus > 0 ? cus : 256;
    }
    hipMemsetAsync(p.bar, 0, XCD_BAR_WORDS * 4, stream);
    hipLaunchKernelGGL(hymba_fwd, dim3(grid), dim3(512), LDS_BYTES, stream, p);
}
```

```cpp
#include <hip/hip_runtime.h>
#include <stdint.h>
#include <stdio.h>
#define XB_TMO      128
#define XB_XCNT(j)  (256  + 64 * (j))
#define XB_XSUB(j)  (1280 + 64 * (j))
#define XB_XGEN(j)  (2304 + 64 * (j))
#define XB_TOP      3328
#define XB_TOPGEN   3392
#define XCD_BAR_WORDS 3456
#define XB_SPIN_CAP (1u << 18)
#define LAS __attribute__((address_space(3)))

__device__ __forceinline__ unsigned xb_ld(unsigned* p)              { return __hip_atomic_load(p, __ATOMIC_RELAXED, __HIP_MEMORY_SCOPE_AGENT); }
__device__ __forceinline__ unsigned xb_add(unsigned* p, unsigned v) { return __hip_atomic_fetch_add(p, v, __ATOMIC_RELAXED, __HIP_MEMORY_SCOPE_AGENT); }
__device__ __forceinline__ unsigned xb_xcc_id() { return (unsigned)__builtin_amdgcn_s_getreg((3 << 11) | 20) & 0xFu; }
#define XB_SPIN(cond, bar) do { unsigned _sp = 0; while (cond) { __builtin_amdgcn_s_sleep(1); \
    if ((++_sp & 255u) == 0u) { if (xb_ld(&(bar)[XB_TMO])) break; if (_sp > XB_SPIN_CAP) { atomicAdd(&(bar)[XB_TMO], 1u); break; } } } } while (0)

struct XcdBarrier {
    unsigned* bar; unsigned x;
    volatile LAS unsigned* st;
};

__device__ __forceinline__ XcdBarrier xcd_barrier_post(unsigned* bar, volatile LAS unsigned* st) {
    XcdBarrier b; b.bar = bar; b.x = xb_xcc_id(); b.st = st;
    if (threadIdx.x == 0) (void)xb_add(&bar[XB_XCNT(b.x)], 1u);
    return b;
}
__device__ __forceinline__ void xcd_barrier_complete(unsigned* bar, unsigned x, unsigned& nloc, unsigned& nx) {
    const unsigned G = gridDim.x * gridDim.y * gridDim.z;
    unsigned sum, cnt, mine, sp = 0u;
    for (;;) {
        sum = 0u; cnt = 0u; mine = 0u;
#pragma unroll
        for (unsigned j = 0; j < 16; ++j) { const unsigned c = xb_ld(&bar[XB_XCNT(j)]); sum += c; cnt += (c > 0u) ? 1u : 0u; mine = (j == x) ? c : mine; }
        if (sum == G) break;
        __builtin_amdgcn_s_sleep(1);
        if ((++sp & 255u) == 0u) { if (xb_ld(&bar[XB_TMO])) break; if (sp > XB_SPIN_CAP) { atomicAdd(&bar[XB_TMO], 1u); break; } }
    }
    nloc = mine > 0u ? mine : 1u; nx = cnt > 0u ? cnt : 1u;
}

__device__ __forceinline__ void xcd_barrier(const XcdBarrier& b) {
    asm volatile("s_waitcnt vmcnt(0)" ::: "memory");
    __syncthreads();
    if (threadIdx.x == 0) {
        unsigned* bar = b.bar;
        __builtin_amdgcn_s_waitcnt(0);
        unsigned nloc = b.st[0], nx = b.st[1];
        if (nloc == 0u) { xcd_barrier_complete(bar, b.x, nloc, nx); b.st[0] = nloc; b.st[1] = nx; }
        const unsigned old = xb_add(&bar[XB_XSUB(b.x)], 1u);
        const unsigned gen = old / nloc;
        if (old + 1u == (gen + 1u) * nloc) {
            __builtin_amdgcn_fence(__ATOMIC_RELEASE, "agent");
            asm volatile("s_waitcnt vmcnt(0)" ::: "memory");
            const unsigned og = xb_add(&bar[XB_TOP], 1u);
            const unsigned tg = og / nx;
            if (og + 1u == (tg + 1u) * nx) xb_add(&bar[XB_TOPGEN], 1u);
            else XB_SPIN(xb_ld(&bar[XB_TOPGEN]) == tg, bar);
            __builtin_amdgcn_fence(__ATOMIC_ACQUIRE, "agent");
            xb_add(&bar[XB_XGEN(b.x)], 1u);
            asm volatile("s_waitcnt vmcnt(0)" ::: "memory");
        } else {
            XB_SPIN(xb_ld(&bar[XB_XGEN(b.x)]) == gen, bar);
            __builtin_amdgcn_fence(__ATOMIC_ACQUIRE, "agent");
            asm volatile("s_waitcnt vmcnt(0)" ::: "memory");
        }
    }
    __syncthreads();
}

namespace pg8 {
#define PG8_LAS __attribute__((address_space(3)))
typedef unsigned short bf16_t;
typedef short bf16x8 __attribute__((ext_vector_type(8)));
typedef float f32x4 __attribute__((ext_vector_type(4)));
typedef unsigned u32x4 __attribute__((ext_vector_type(4)));
constexpr int BM = 256, BK = 64, HALF = 128, HTB = HALF * BK * 2  , STAGE_BYTES = 8 * HTB, NXCD = 8, WGM = 8;

__host__ __device__ __forceinline__ int lds_byte(int r, int c) { const int st = (r >> 4) * 2 + (c >> 5), rr = r & 15, cc = c & 31, ob = rr * 64 + cc * 2; return st * 1024 + (ob ^ (((ob >> 9) & 1) << 5)); }
__host__ __device__ __forceinline__ void stage_rc(int b, int& R, int& C) { const int st = b / 1024, sb = b % 1024, swz = sb ^ (((sb >> 9) & 1) << 5); R = (st >> 1) * 16 + swz / 64; C = (st & 1) * 32 + (swz % 64) / 2; }
__host__ __device__ __forceinline__ int perm32(int rho) { const int n = rho >> 4, i = rho & 15; return 8 * (i >> 2) + 4 * n + (i & 3); }

struct Unit { int pm, pn; };
struct Gemm { const bf16_t* A; const bf16_t* Bt; int M, N, K; };

struct StaticOrder {
    int nM, nN, nwg, G, c;
    __host__ __device__ void init(int M, int N, int G_, int c_) { nM = M / BM; nN = N / BM; nwg = nM * nN; G = G_; c = c_; }
    __host__ __device__ bool next(int i, Unit& u) const {
        const long L = (long)i * G + c; if (L >= nwg) return false;
        int wgid = (int)L; { const int q = nwg / NXCD, r = nwg % NXCD, xcd = wgid % NXCD, off = wgid / NXCD; wgid = (xcd < r ? xcd * (q + 1) : r * (q + 1) + (xcd - r) * q) + off; }
        const int nig = WGM * nN, gid = wgid / nig, fm = gid * WGM, gsz = (nM - fm) < WGM ? (nM - fm) : WGM;
        u.pm = fm + ((wgid % nig) % gsz); u.pn = (wgid % nig) / gsz; return true;
    }
    __device__ __forceinline__ void a_ready(const Unit&) const {}
    __device__ __forceinline__ void done(const Unit&) const {}
};
__device__ __forceinline__ unsigned cvt_pk_bf16(float lo, float hi) { unsigned r; asm volatile("v_cvt_pk_bf16_f32 %0, %1, %2" : "=v"(r) : "v"(lo), "v"(hi)); return r; }
typedef float f32x2 __attribute__((ext_vector_type(2)));
__device__ __forceinline__ f32x2 gelu_pk(f32x2 v) {
    const f32x2 av = __builtin_elementwise_abs(v), d = av * 0.2316418882f + 1.0f;
    f32x2 t; t.x = __builtin_amdgcn_rcpf(d.x); t.y = __builtin_amdgcn_rcpf(d.y);
    f32x2 q = t * 0.5307027145f + (-0.7265760135f); q = q * t + 0.7107068705f; q = q * t + (-0.142248368f); q = q * t + 0.127414796f; q = q * t;
    const f32x2 s = (v * v) * (-0.72134752044f);
    f32x2 e; e.x = __builtin_amdgcn_exp2f(s.x); e.y = __builtin_amdgcn_exp2f(s.y);
    const f32x2 m = v * (q * e), r = v - m;
    f32x2 o; o.x = v.x < 0.f ? m.x : r.x; o.y = v.y < 0.f ? m.y : r.y; return o;
}

template <class Epi, class Sched, bool STAMP = false>
__device__ __forceinline__ void gemm_phase(PG8_LAS unsigned char* lds, const Gemm g, const Sched& S, const Epi& E, unsigned long long* stamps) {
    int tid_ = threadIdx.x; asm volatile("" : "+v"(tid_));
    const int tid = tid_, wid = __builtin_amdgcn_readfirstlane(tid >> 6), lane = tid & 63, wr = wid >> 2, wc = wid & 3, fr = lane & 15, fq = lane >> 4;
    const int K = g.K, nt = K / BK;
    int ts_lo = 0, ts_hi = 0, nts = 0; const unsigned long long rt_entry = STAMP ? (unsigned long long)wall_clock64() : 0ull;
#define PG8_STAMP() do { if (STAMP && wid == 0 && nts < 64) { const unsigned long long _c = (unsigned long long)clock64(); \
        ts_lo = (lane == nts) ? (int)(unsigned)_c : ts_lo; ts_hi = (lane == nts) ? (int)(unsigned)(_c >> 32) : ts_hi; ++nts; } } while (0)
    PG8_STAMP();
    unsigned voffA[2], voffB[2];
#pragma unroll
    for (int i = 0; i < 2; ++i) { int R, C; stage_rc(tid * 16 + i * 8192, R, C); const int Rb = Epi::PERM ? ((R & ~31) + perm32(R & 31)) : R;
        voffA[i] = (unsigned)(R * K + C) * 2u; voffB[i] = (unsigned)(Rb * K + C) * 2u; }
    const size_t kstep = (size_t)(BK * 2);
    const size_t hstep = (size_t)HALF * K * 2;
    const size_t tstep = 2 * hstep;
    const unsigned ldsw = (unsigned)wid * 1024u;
    const int aoff = lds_byte(wr * 64 + fr, fq * 8), boff = lds_byte(wc * 32 + fr, fq * 8);
#define PG8_SA(b, h) (((b) * 2 + (h)) * HTB)
#define PG8_SB(b, h) ((4 + (b) * 2 + (h)) * HTB)
#define PG8_STAGE(bufoff, gbase, voff) do { _Pragma("unroll") for (int _i = 0; _i < 2; ++_i) \
        __builtin_amdgcn_global_load_lds((const unsigned*)((const char*)(gbase) + (voff)[_i]), (PG8_LAS unsigned*)(lds + (bufoff) + ldsw + _i * 8192), 16, 0, 0); } while (0)
#define PG8_LDA(dst, b, h) do { _Pragma("unroll") for (int m = 0; m < 4; ++m) _Pragma("unroll") for (int k = 0; k < 2; ++k) dst[m][k] = *(const PG8_LAS bf16x8*)(lds + PG8_SA(b, h) + aoff + m * 2048 + k * 1024); } while (0)
#define PG8_LDB(dst, b, h) do { _Pragma("unroll") for (int n = 0; n < 2; ++n) _Pragma("unroll") for (int k = 0; k < 2; ++k) dst[n][k] = *(const PG8_LAS bf16x8*)(lds + PG8_SB(b, h) + boff + n * 2048 + k * 1024); } while (0)
#define PG8_MMA(ai, bj, At, Bt) do { __builtin_amdgcn_s_setprio(1); _Pragma("unroll") for (int m = 0; m < 4; ++m) _Pragma("unroll") for (int n = 0; n < 2; ++n) _Pragma("unroll") for (int k = 0; k < 2; ++k) \
        acc[ai][bj][m][n] = __builtin_amdgcn_mfma_f32_16x16x32_bf16(Bt[n][k], At[m][k], acc[ai][bj][m][n], 0, 0, 0); __builtin_amdgcn_s_setprio(0); } while (0)
#define PG8_WAIT_V(n) asm volatile("s_waitcnt vmcnt(" #n ")" ::: "memory")
#define PG8_WAIT_L(n) asm volatile("s_waitcnt lgkmcnt(" #n ")" ::: "memory")
#define PG8_BAR __builtin_amdgcn_s_barrier()
#define PG8_SCHED __builtin_amdgcn_sched_barrier(0)
    Unit cur, nxt; int ui = 0;
    if (!S.next(0, cur)) return;
    f32x4 acc[2][2][4][2];
#pragma unroll
    for (int a = 0; a < 2; ++a)
#pragma unroll
        for (int b = 0; b < 2; ++b)
#pragma unroll
            for (int m = 0; m < 4; ++m)
#pragma unroll
                for (int n = 0; n < 2; ++n) acc[a][b][m][n] = (f32x4){0.f, 0.f, 0.f, 0.f};
    bf16x8 At[4][2], B0[2][2], B1[2][2];
    const char* cA = (const char*)g.A + (size_t)cur.pm * tstep; const char* cB = (const char*)g.Bt + (size_t)cur.pn * tstep;
    S.a_ready(cur);
    PG8_STAGE(PG8_SB(0, 0), cB, voffB); PG8_STAGE(PG8_SA(0, 0), cA, voffA); PG8_STAGE(PG8_SB(0, 1), cB + hstep, voffB); PG8_STAGE(PG8_SA(0, 1), cA + hstep, voffA);
    if (wr == 1) PG8_BAR;
    PG8_WAIT_V(4); PG8_BAR;
    PG8_STAGE(PG8_SB(1, 0), cB + kstep, voffB); PG8_STAGE(PG8_SA(1, 0), cA + kstep, voffA); PG8_STAGE(PG8_SB(1, 1), cB + hstep + kstep, voffB);
    PG8_WAIT_V(6); PG8_BAR;
    PG8_STAMP();
    for (;;) {
        const bool has_next = S.next(ui + 1, nxt);
        const char* nA = has_next ? (const char*)g.A + (size_t)nxt.pm * tstep : cA; const char* nB = has_next ? (const char*)g.Bt + (size_t)nxt.pn * tstep : cB;
        for (int t = 0; t < nt; t += 2) {
            const bool last = (t == nt - 2);
            const char* a1 = cA + (size_t)(t + 1) * kstep;
            const char* a2 = last ? nA : cA + (size_t)(t + 2) * kstep; const char* b2 = last ? nB : cB + (size_t)(t + 2) * kstep;
            const char* a3 = a2 + kstep; const char* b3 = b2 + kstep;
            if (last && has_next) S.a_ready(nxt);
            PG8_LDB(B0, 0, 0); PG8_SCHED; PG8_LDA(At, 0, 0); PG8_STAGE(PG8_SA(1, 1), a1 + hstep, voffA);
            PG8_WAIT_L(8); PG8_BAR; PG8_WAIT_L(0); PG8_MMA(0, 0, At, B0); PG8_BAR; PG8_SCHED;
            PG8_LDB(B1, 0, 1); PG8_STAGE(PG8_SB(0, 0), b2, voffB);
            PG8_BAR; PG8_WAIT_L(0); PG8_MMA(0, 1, At, B1); PG8_BAR;
            PG8_LDA(At, 0, 1); PG8_STAGE(PG8_SA(0, 0), a2, voffA);
            PG8_BAR; PG8_WAIT_L(0); PG8_MMA(1, 0, At, B0); PG8_BAR; PG8_SCHED;
            PG8_STAGE(PG8_SB(0, 1), b2 + hstep, voffB);
            PG8_WAIT_V(6); PG8_BAR; PG8_MMA(1, 1, At, B1); PG8_BAR;
            PG8_LDB(B0, 1, 0); PG8_SCHED; PG8_LDA(At, 1, 0); PG8_STAGE(PG8_SA(0, 1), a2 + hstep, voffA);
            PG8_WAIT_L(8); PG8_BAR; PG8_WAIT_L(0); PG8_MMA(0, 0, At, B0); PG8_BAR; PG8_SCHED;
            PG8_LDB(B1, 1, 1); PG8_STAGE(PG8_SB(1, 0), b3, voffB);
            PG8_BAR; PG8_WAIT_L(0); PG8_MMA(0, 1, At, B1); PG8_BAR;
            PG8_LDA(At, 1, 1); PG8_STAGE(PG8_SA(1, 0), a3, voffA);
            PG8_BAR; PG8_WAIT_L(0); PG8_MMA(1, 0, At, B0); PG8_BAR; PG8_SCHED;
            PG8_STAGE(PG8_SB(1, 1), b3 + hstep, voffB);
            PG8_WAIT_V(6); PG8_BAR; PG8_MMA(1, 1, At, B1); PG8_BAR;
        }
        PG8_STAMP();
        if constexpr (!Epi::AFTER_DRAIN) { E(acc, cur, wr, wc, fr, fq); S.done(cur); }
        PG8_STAMP();
        if (!has_next) break;
#pragma unroll
        for (int a = 0; a < 2; ++a)
#pragma unroll
            for (int b = 0; b < 2; ++b)
#pragma unroll
                for (int m = 0; m < 4; ++m)
#pragma unroll
                    for (int n = 0; n < 2; ++n) acc[a][b][m][n] = (f32x4){0.f, 0.f, 0.f, 0.f};
        cur = nxt; cA = nA; cB = nB; ++ui;
    }
    PG8_WAIT_V(0);
    if (wr == 0) PG8_BAR;
    PG8_BAR;
    if constexpr (Epi::AFTER_DRAIN) { E.fused(acc, cur, wr, wc, fr, fq, lds, wid, lane); S.done(cur); }
    PG8_STAMP();
    if (STAMP && wid == 0) { stamps[lane] = lane < nts ? (((unsigned long long)(unsigned)ts_hi << 32) | (unsigned)ts_lo) : 0ull;
        if (lane == 62) stamps[62] = rt_entry; if (lane == 63) stamps[63] = (unsigned long long)wall_clock64(); }
#undef PG8_STAMP
#undef PG8_SA
#undef PG8_SB
#undef PG8_STAGE
#undef PG8_LDA
#undef PG8_LDB
#undef PG8_MMA
#undef PG8_WAIT_V
#undef PG8_WAIT_L
#undef PG8_BAR
#undef PG8_SCHED
}
}

using pg8::bf16_t; using pg8::f32x4; using pg8::bf16x8; using pg8::Unit; using pg8::Gemm; using pg8::StaticOrder;
#define MT 34816
#define ML 32768
#define NIN 4608
#define DFF 5632
#define MODL (9 * 12288)

struct Params {
    const float *x, *c, *ctx, *c_ctx, *norm1_g, *norm2_g, *w_ada, *b_ada, *w_in, *mu, *w0, *w2, *a0, *a2, *g2, *kk_scale, *ka, *rk, *lnx_w, *lnx_b, *sink, *f_g, *a_g, *w_out, *w_ffn_in, *conv_w, *conv_b, *w_ffn_out, *final_g;
    float* out; unsigned* bar; float* mod; float* rope; float* xc;
    bf16_t *wt_in, *wt_out, *wt_f1, *wt_f2, *wt_lr, *wf, *wfc, *u, *q, *ak, *vt, *vtc, *rw, *ft, *ftc, *dec, *aa, *gg, *y, *a2b, *fo, *at, *h, *act;
};

__device__ __forceinline__ int otid() { int t = threadIdx.x; asm volatile("" : "+v"(t)); return t; }
__device__ __forceinline__ bf16_t f2bf(float f) { unsigned u = __float_as_uint(f); u += 0x7FFFu + ((u >> 16) & 1u); return (bf16_t)(u >> 16); }
__device__ __forceinline__ float bf2f(bf16_t h) { return __uint_as_float(((unsigned)h) << 16); }
__device__ __forceinline__ unsigned pk2(float a, float b) { return (unsigned)f2bf(a) | ((unsigned)f2bf(b) << 16); }
__device__ __forceinline__ float lo_bf(unsigned w) { return __uint_as_float(w << 16); }
__device__ __forceinline__ float hi_bf(unsigned w) { return __uint_as_float(w & 0xffff0000u); }
__device__ __forceinline__ float wave_sum(float v) { v += __shfl_xor(v, 32); v += __shfl_xor(v, 16); v += __shfl_xor(v, 8); v += __shfl_xor(v, 4); v += __shfl_xor(v, 2); v += __shfl_xor(v, 1); return v; }
__device__ __forceinline__ float sigmoidf_(float x) { return 1.0f / (1.0f + __expf(-x)); }
template <int CTRL> __device__ __forceinline__ float dpp_add(float x) { return x + __int_as_float(__builtin_amdgcn_update_dpp(0, __float_as_int(x), CTRL, 0xf, 0xf, true)); }
__device__ __forceinline__ float sum8(float x) { x = dpp_add<0xB1>(x); x = dpp_add<0x4E>(x); x = dpp_add<0x141>(x); return x; }

__device__ __forceinline__ int srccol_in(int n) {
    if (n < 1024) return -1;
    if (n < 2304) { const int base = n < 2048 ? 512 : 3456; const int cq = n < 2048 ? n - 1024 : n - 2048; const int head = cq >> 7, pp = cq & 127, axis = pp >> 6, i = (pp & 63) >> 1, half = pp & 1; return base + head * 128 + axis * 64 + half * 32 + i; }
    if (n < 2560) return 3712 + (n - 2304);
    if (n < 3072) return 1536 + (n - 2560);
    if (n < 3584) return 2176 + (n - 3072);
    if (n < 4096) return 2688 + (n - 3584);
    if (n < 4224) return 2048 + (n - 4096);
    if (n < 4352) return 3200 + (n - 4224);
    if (n < 4480) return 3328 + (n - 4352);
    return -1;
}
__device__ __forceinline__ void xpose_tile(const float* src, int Nsrc, bf16_t* dst, int K, int n0, int k0, int mode, float* tile) {
    const int tid = otid(), nn = tid & 63, kk = tid >> 6;
    const int sc = mode ? srccol_in(n0 + nn) : (n0 + nn);
    float v[16];
#pragma unroll
    for (int pp = 0; pp < 16; ++pp) v[pp] = sc >= 0 ? src[(size_t)(k0 + kk + 8 * pp) * Nsrc + sc] : 0.f;
#pragma unroll
    for (int pp = 0; pp < 16; ++pp) tile[(kk + 8 * pp) * 65 + nn] = v[pp];
    __syncthreads();
    const int rn = tid >> 3, kc = tid & 7;
#pragma unroll
    for (int hh = 0; hh < 2; ++hh) { const int kb = hh * 64 + kc * 8; uint4 w;
        w.x = pk2(tile[(kb + 0) * 65 + rn], tile[(kb + 1) * 65 + rn]); w.y = pk2(tile[(kb + 2) * 65 + rn], tile[(kb + 3) * 65 + rn]);
        w.z = pk2(tile[(kb + 4) * 65 + rn], tile[(kb + 5) * 65 + rn]); w.w = pk2(tile[(kb + 6) * 65 + rn], tile[(kb + 7) * 65 + rn]);
        *(uint4*)(dst + (size_t)(n0 + rn) * K + k0 + kb) = w; }
    __syncthreads();
}

__device__ __forceinline__ void prologue(const Params& p, unsigned char* shm) {
    const int tid = otid(), G = gridDim.x, bid = blockIdx.x;
    float* fl = (float*)shm;
#pragma unroll 1
    for (int it = bid; it < 4 * 5632; it += G) {
        const int l = it / 5632; int r = it % 5632;
        if (r < 896) xpose_tile(p.w_in + (size_t)l * 2048 * 3968, 3968, p.wt_in + (size_t)l * NIN * 2048, 2048, 1024 + (r >> 4) * 64, (r & 15) * 128, 1, fl);
        else if (r < 1408) { r -= 896; xpose_tile(p.w_out + (size_t)l * 2048 * 2048, 2048, p.wt_out + (size_t)l * 2048 * 2048, 2048, (r >> 4) * 64, (r & 15) * 128, 0, fl); }
        else if (r < 4224) { r -= 1408; xpose_tile(p.w_ffn_in + (size_t)l * 2048 * 11264, 11264, p.wt_f1 + (size_t)l * 11264 * 2048, 2048, (r >> 4) * 64, (r & 15) * 128, 0, fl); }
        else { r -= 4224; xpose_tile(p.w_ffn_out + (size_t)l * DFF * 2048, 2048, p.wt_f2 + (size_t)l * 2048 * DFF, DFF, (r / 44) * 64, (r % 44) * 128, 0, fl); }
    }
    {
        float* wt = fl; float* ctab = fl + 64 * 129;
        if (tid < 128) ctab[tid] = cospif((float)tid / 64.0f) * 0.08838834764831845f;
        __syncthreads();
#pragma unroll 1
        for (int it = bid; it < 512; it += G) {
            const int l = it >> 7, g = (it >> 5) & 3, k0 = (it & 31) * 64;
            const float* src = p.w_in + (size_t)l * 2048 * 3968;
#pragma unroll
            for (int pp = 0; pp < 16; ++pp) { const int idx = tid + 512 * pp, kk = idx >> 7, c = idx & 127; wt[kk * 129 + c] = src[(size_t)(k0 + kk) * 3968 + g * 128 + c]; }
            __syncthreads();
            const int cp = tid & 127, kq = tid >> 7;
            unsigned oc[8], os[8];
#pragma unroll 1
            for (int k2 = 0; k2 < 8; ++k2) {
                float c0 = 0.f, s0 = 0.f, c1 = 0.f, s1 = 0.f;
                const float* r0 = wt + (kq * 16 + 2 * k2) * 129; const float* r1 = r0 + 129;
                for (int c = 0; c < 128; ++c) { const int j = (c * cp) & 127; const float cv = ctab[j], sv = ctab[(j - 32) & 127]; c0 += r0[c] * cv; s0 += r0[c] * sv; c1 += r1[c] * cv; s1 += r1[c] * sv; }
                oc[k2] = pk2(c0, c1); os[k2] = pk2(s0, s1);
            }
            bf16_t* dc = p.wt_in + (size_t)l * NIN * 2048 + (size_t)(g * 128 + cp) * 2048 + k0 + kq * 16;
            bf16_t* ds = dc + (size_t)512 * 2048;
            *(uint4*)dc = make_uint4(oc[0], oc[1], oc[2], oc[3]); *(uint4*)(dc + 8) = make_uint4(oc[4], oc[5], oc[6], oc[7]);
            *(uint4*)ds = make_uint4(os[0], os[1], os[2], os[3]); *(uint4*)(ds + 8) = make_uint4(os[4], os[5], os[6], os[7]);
            __syncthreads();
        }
    }
    {
        float* ct = fl;
        __syncthreads();
        for (int i = tid; i < 4096; i += 512) ct[i] = cospif((float)i / 2048.0f) * (1.0f / 64.0f);
        __syncthreads();
#pragma unroll 1
        for (int idx = bid * 512 + tid; idx < 4096 * 1024; idx += G * 512) {
            const int kf = idx >> 10, gi = idx & 1023, half = gi >> 9, t0 = (gi & 511) * 8;
            float v[8];
#pragma unroll
            for (int e = 0; e < 8; ++e) { const int j = (kf * (t0 + e)) & 4095; v[e] = half ? -ct[(j - 1024) & 4095] : ct[j]; }
            *(uint4*)(p.wf + (size_t)kf * 8192 + half * 4096 + t0) = make_uint4(pk2(v[0], v[1]), pk2(v[2], v[3]), pk2(v[4], v[5]), pk2(v[6], v[7]));
        }
#pragma unroll 1
        for (int idx = bid * 512 + tid; idx < 256 * 64; idx += G * 512) {
            const int kf = idx >> 6, gi = idx & 63, half = gi >> 5, t0 = (gi & 31) * 8;
            float v[8];
#pragma unroll
            for (int e = 0; e < 8; ++e) { const int j = ((kf * (t0 + e)) & 255) * 16; v[e] = 4.0f * (half ? -ct[(j - 1024) & 4095] : ct[j]); }
            *(uint4*)(p.wfc + (size_t)kf * 512 + half * 256 + t0) = make_uint4(pk2(v[0], v[1]), pk2(v[2], v[3]), pk2(v[4], v[5]), pk2(v[6], v[7]));
        }
#pragma unroll 1
        for (int idx = bid * 512 + tid; idx < 4096 * 64; idx += G * 512) {
            const int t = idx >> 6, axis = (idx >> 5) & 1, i = idx & 31;
            const float inv = powf(10000.0f, -(float)i / 32.0f); const float pos = (float)(axis ? (t & 63) : (t >> 6)); const float ang = pos * inv;
            p.rope[(size_t)idx * 2] = cosf(ang); p.rope[(size_t)idx * 2 + 1] = sinf(ang);
        }
#pragma unroll 1
        for (int idx = bid * 512 + tid; idx < 4 * 2560 * 384; idx += G * 512) {
            const int l = idx / (2560 * 384), rem = idx % (2560 * 384), n = rem / 384, k = rem % 384;
            float v = 0.f;
            if (n < 1024) { const int dir = n >> 9, ch = n & 511; if (k < 128 && (k >> 6) == dir) v = p.w2[(((size_t)l * 2 + dir) * 64 + (k & 63)) * 512 + ch]; }
            else if (n < 2048) { const int nn = n - 1024, dir = nn >> 9, ch = nn & 511; if (k >= 128 && k < 256 && ((k - 128) >> 6) == dir) v = p.a2[(((size_t)l * 2 + dir) * 64 + ((k - 128) & 63)) * 512 + ch]; }
            else { const int ch = n - 2048; if (k >= 256) v = p.g2[((size_t)l * 128 + (k - 256)) * 512 + ch]; }
            p.wt_lr[idx] = f2bf(v);
        }
        __syncthreads();
    }
    {
        float* sv = fl; float* red = fl + 9 * 2048;
        for (int i = tid; i < 9 * 2048; i += 512) { const int s = i >> 11, k = i & 2047; const float xv = s < 8 ? p.c[s * 2048 + k] : p.c_ctx[k]; sv[i] = xv / (1.0f + expf(-xv)); }
        __syncthreads();
#pragma unroll 1
        for (int it = bid; it < 768; it += G) {
            const int l = it / 192, col0 = (it % 192) * 64, cx = tid & 63, ks = tid >> 6;
            float acc[9];
#pragma unroll
            for (int s = 0; s < 9; ++s) acc[s] = 0.f;
            const float* wp = p.w_ada + (size_t)l * 2048 * 12288 + col0 + cx;
#pragma unroll 16
            for (int k = ks * 256; k < ks * 256 + 256; ++k) { const float w = wp[(size_t)k * 12288];
#pragma unroll
                for (int s = 0; s < 9; ++s) acc[s] += sv[s * 2048 + k] * w; }
#pragma unroll
            for (int s = 0; s < 9; ++s) red[(ks * 9 + s) * 64 + cx] = acc[s];
            __syncthreads();
            for (int o = tid; o < 576; o += 512) { const int s = o >> 6, cc = o & 63; float t = 0.f;
#pragma unroll
                for (int k8 = 0; k8 < 8; ++k8) t += red[(k8 * 9 + s) * 64 + cc];
                p.mod[((size_t)l * 9 + s) * 12288 + col0 + cc] = t + p.b_ada[(size_t)l * 12288 + col0 + cc]; }
            __syncthreads();
        }
    }
}

__device__ __forceinline__ void norm_mod(const float* xl, const float* xc, const float* gain, const float* modl, int shOff, int scOff, bf16_t* U, int nrows) {
    const int wave = otid() >> 6, lane = otid() & 63;
#pragma unroll 1
    for (int row = blockIdx.x * 8 + wave; row < nrows; row += gridDim.x * 8) {
        const float4* src = (const float4*)(row < ML ? xl + (size_t)row * 2048 : xc + (size_t)(row - ML) * 2048);
        const int s = row < ML ? (row >> 12) : 8;
        float4 v[8]; float ss = 0.f;
#pragma unroll
        for (int i = 0; i < 8; ++i) { v[i] = src[lane + 64 * i]; ss += v[i].x * v[i].x + v[i].y * v[i].y + v[i].z * v[i].z + v[i].w * v[i].w; }
        ss = wave_sum(ss);
        const float rs = rsqrtf(ss * (1.0f / 2048.0f) + 1e-6f);
        const float4* g4 = (const float4*)gain; const float4* sh4 = (const float4*)(modl + s * 12288 + shOff); const float4* sc4 = (const float4*)(modl + s * 12288 + scOff);
#pragma unroll
        for (int i = 0; i < 8; ++i) { const int ci = lane + 64 * i; const float4 g = g4[ci], sh = sh4[ci], sc = sc4[ci];
            const float o0 = v[i].x * rs * g.x * (1.0f + sc.x) + sh.x, o1 = v[i].y * rs * g.y * (1.0f + sc.y) + sh.y, o2 = v[i].z * rs * g.z * (1.0f + sc.z) + sh.z, o3 = v[i].w * rs * g.w * (1.0f + sc.w) + sh.w;
            *(uint2*)(U + (size_t)row * 2048 + ci * 4) = make_uint2(pk2(o0, o1), pk2(o2, o3)); }
    }
}

struct EpiIn {
    static constexpr bool PERM = false, AFTER_DRAIN = false;
    bf16_t *q, *ak, *vt, *vtc, *rw, *ft, *ftc; const float* rope;
    __device__ __forceinline__ void operator()(const f32x4 (&acc)[2][2][4][2], const Unit& u, int wr, int wc, int fr, int fq) const {
        asm volatile("" : "+v"(fr), "+v"(fq));
        const int pn = u.pn; const int cb = wc * 32 + 4 * fq;
#pragma unroll
        for (int ai = 0; ai < 2; ++ai)
#pragma unroll
            for (int m = 0; m < 4; ++m) {
                const int r = u.pm * 256 + ai * 128 + wr * 64 + m * 16 + fr;
                const bool lat = r < ML; const int b = lat ? (r >> 12) : ((r - ML) >> 8); const int t = lat ? (r & 4095) : ((r - ML) & 255);
                if (pn < 4) {
                    const int half = pn >> 1; const int ch0 = (pn & 1) * 256 + cb;
                    bf16_t* d = lat ? ft + ((unsigned)(b * 512 + ch0) * 8192u + half * 4096 + t) : ftc + ((unsigned)(b * 512 + ch0) * 512u + half * 256 + t);
                    const unsigned sd = lat ? 8192u : 512u;
#pragma unroll
                    for (int bj = 0; bj < 2; ++bj)
#pragma unroll
                        for (int n = 0; n < 2; ++n) { const f32x4 v = acc[ai][bj][m][n]; bf16_t* dd = d + (unsigned)(bj * 128 + n * 16) * sd;
                            dd[0] = f2bf(v[0]); dd[sd] = f2bf(v[1]); dd[2 * sd] = f2bf(v[2]); dd[3 * sd] = f2bf(v[3]); }
                } else if (pn < 9) {
                    bf16_t* d = pn < 8 ? q + ((unsigned)r * 1024u + (pn - 4) * 256 + cb) : ak + ((unsigned)r * 256u + cb);
                    const float* rp = rope + (unsigned)t * 128u;
#pragma unroll
                    for (int bj = 0; bj < 2; ++bj)
#pragma unroll
                        for (int n = 0; n < 2; ++n) { f32x4 v = acc[ai][bj][m][n];
                            if (lat) { const int pp = (cb + n * 16) & 127, axis = pp >> 6, i = (pp & 63) >> 1;
                                const float4 cs = *(const float4*)(rp + (axis * 32 + i) * 2);
                                const float a0 = v[0], b0 = v[1], a1 = v[2], b1 = v[3];
                                v[0] = a0 * cs.x - b0 * cs.y; v[1] = a0 * cs.y + b0 * cs.x; v[2] = a1 * cs.z - b1 * cs.w; v[3] = a1 * cs.w + b1 * cs.z; }
                            *(uint2*)(d + bj * 128 + n * 16) = make_uint2(pk2(v[0], v[1]), pk2(v[2], v[3])); }
                } else if (pn == 9) {
                    bf16_t* d = lat ? vt + ((unsigned)(b * 256 + cb) * 4096u + t) : vtc + ((unsigned)(b * 256 + cb) * 256u + t);
                    const unsigned sd = lat ? 4096u : 256u;
#pragma unroll
                    for (int bj = 0; bj < 2; ++bj)
#pragma unroll
                        for (int n = 0; n < 2; ++n) { const f32x4 v = acc[ai][bj][m][n]; bf16_t* dd = d + (unsigned)(bj * 128 + n * 16) * sd;
                            dd[0] = f2bf(v[0]); dd[sd] = f2bf(v[1]); dd[2 * sd] = f2bf(v[2]); dd[3 * sd] = f2bf(v[3]); }
                } else {
                    bf16_t* d = rw + ((unsigned)r * 2048u + (pn - 10) * 256 + cb);
#pragma unroll
                    for (int bj = 0; bj < 2; ++bj)
#pragma unroll
                        for (int n = 0; n < 2; ++n) { const f32x4 v = acc[ai][bj][m][n]; *(uint2*)(d + bj * 128 + n * 16) = make_uint2(pk2(v[0], v[1]), pk2(v[2], v[3])); }
                }
                __builtin_amdgcn_sched_barrier(0);
            }
    }
};
struct EpiLR {
    static constexpr bool PERM = false, AFTER_DRAIN = false;
    bf16_t *dec, *aa, *gg; const float *w0, *a0;
    __device__ __forceinline__ void operator()(const f32x4 (&acc)[2][2][4][2], const Unit& u, int wr, int wc, int fr, int fq) const {
        asm volatile("" : "+v"(fr), "+v"(fq));
        const int pn = u.pn; const int cb = wc * 32 + 4 * fq;
#pragma unroll
        for (int ai = 0; ai < 2; ++ai)
#pragma unroll
            for (int m = 0; m < 4; ++m) {
                const int r = u.pm * 256 + ai * 128 + wr * 64 + m * 16 + fr;
                if (pn < 8) {
                    const int c0 = (pn & 3) * 256 + cb;
                    const float* bias = (pn < 4 ? w0 : a0) + c0;
                    bf16_t* d = (pn < 4 ? dec : aa) + ((unsigned)((c0 >> 9) * MT + r) * 512u + (c0 & 511));
#pragma unroll
                    for (int bj = 0; bj < 2; ++bj)
#pragma unroll
                        for (int n = 0; n < 2; ++n) { f32x4 v = acc[ai][bj][m][n]; const float4 wb = *(const float4*)(bias + bj * 128 + n * 16);
                            v[0] += wb.x; v[1] += wb.y; v[2] += wb.z; v[3] += wb.w;
#pragma unroll
                            for (int e = 0; e < 4; ++e) { const float ex = __expf(-v[e]);
                                v[e] = pn < 4 ? -__expf(-(v[e] < -20.f ? -v[e] : __logf(1.0f + ex)) - 0.5f) : 1.0f / (1.0f + ex); }
                            *(uint2*)(d + bj * 128 + n * 16) = make_uint2(pk2(v[0], v[1]), pk2(v[2], v[3])); }
                } else {
                    bf16_t* d = gg + ((unsigned)r * 512u + (pn - 8) * 256 + cb);
#pragma unroll
                    for (int bj = 0; bj < 2; ++bj)
#pragma unroll
                        for (int n = 0; n < 2; ++n) { const f32x4 v = acc[ai][bj][m][n]; *(uint2*)(d + bj * 128 + n * 16) = make_uint2(pk2(v[0], v[1]), pk2(v[2], v[3])); }
                }
                __builtin_amdgcn_sched_barrier(0);
            }
    }
};
struct EpiFO {
    static constexpr bool PERM = false, AFTER_DRAIN = false;
    bf16_t* fo; int base, seqlen;
    __device__ __forceinline__ void operator()(const f32x4 (&acc)[2][2][4][2], const Unit& u, int wr, int wc, int fr, int fq) const {
        asm volatile("" : "+v"(fr), "+v"(fq));
#pragma unroll
        for (int ai = 0; ai < 2; ++ai)
#pragma unroll
            for (int m = 0; m < 4; ++m) {
                const int r = u.pm * 256 + ai * 128 + wr * 64 + m * 16 + fr;
#pragma unroll
                for (int bj = 0; bj < 2; ++bj)
#pragma unroll
                    for (int n = 0; n < 2; ++n) {
                        const int c = u.pn * 256 + bj * 128 + wc * 32 + n * 16 + 4 * fq; const f32x4 v = acc[ai][bj][m][n];
                        *(uint2*)(fo + (unsigned)(base + (c >> 9) * seqlen + r) * 512u + (c & 511)) = make_uint2(pk2(v[0], v[1]), pk2(v[2], v[3]));
                    }
                __builtin_amdgcn_sched_barrier(0);
            }
    }
};
struct EpiRes {
    static constexpr bool PERM = false, AFTER_DRAIN = false;
    const float *xl_in, *xc_in; float *xl_out, *xc_out; const float* ga; int row_off;
    __device__ __forceinline__ void operator()(const f32x4 (&acc)[2][2][4][2], const Unit& u, int wr, int wc, int fr, int fq) const {
        asm volatile("" : "+v"(fr), "+v"(fq));
#pragma unroll
        for (int ai = 0; ai < 2; ++ai)
#pragma unroll
            for (int m = 0; m < 4; ++m) {
                const int r = row_off + u.pm * 256 + ai * 128 + wr * 64 + m * 16 + fr;
                const bool lat = r < ML; const int s = lat ? (r >> 12) : 8;
                const float* xi = lat ? xl_in + (size_t)r * 2048 : xc_in + (size_t)(r - ML) * 2048;
                float* xo = lat ? xl_out + (size_t)r * 2048 : xc_out + (size_t)(r - ML) * 2048;
#pragma unroll
                for (int bj = 0; bj < 2; ++bj)
#pragma unroll
                    for (int n = 0; n < 2; ++n) {
                        const int c = u.pn * 256 + bj * 128 + wc * 32 + n * 16 + 4 * fq; const f32x4 v = acc[ai][bj][m][n];
                        const float4 xv = *(const float4*)(xi + c); const float4 g = *(const float4*)(ga + s * 12288 + c);
                        *(float4*)(xo + c) = make_float4(xv.x + g.x * v[0], xv.y + g.y * v[1], xv.z + g.z * v[2], xv.w + g.w * v[3]);
                    }
                __builtin_amdgcn_sched_barrier(0);
            }
    }
};
struct EpiH {
    static constexpr bool PERM = false, AFTER_DRAIN = false;
    bf16_t* o; int ld;
    __device__ __forceinline__ void operator()(const f32x4 (&acc)[2][2][4][2], const Unit& u, int wr, int wc, int fr, int fq) const {
        asm volatile("" : "+v"(fr), "+v"(fq));
#pragma unroll
        for (int ai = 0; ai < 2; ++ai)
#pragma unroll
            for (int m = 0; m < 4; ++m) {
                const int r = u.pm * 256 + ai * 128 + wr * 64 + m * 16 + fr;
#pragma unroll
                for (int bj = 0; bj < 2; ++bj)
#pragma unroll
                    for (int n = 0; n < 2; ++n) {
                        const int c = u.pn * 256 + bj * 128 + wc * 32 + n * 16 + 4 * fq; const f32x4 v = acc[ai][bj][m][n];
                        *(uint2*)(o + (size_t)r * ld + c) = make_uint2(pk2(v[0], v[1]), pk2(v[2], v[3]));
                    }
                __builtin_amdgcn_sched_barrier(0);
            }
    }
};

__device__ __forceinline__ void ld8(const bf16_t* ptr, float (&o)[8]) { const uint4 w = *(const uint4*)ptr; o[0] = lo_bf(w.x); o[1] = hi_bf(w.x); o[2] = lo_bf(w.y); o[3] = hi_bf(w.y); o[4] = lo_bf(w.z); o[5] = hi_bf(w.z); o[6] = lo_bf(w.w); o[7] = hi_bf(w.w); }
__device__ __forceinline__ void ld8f(const float* ptr, float (&o)[8]) { const float4 a = *(const float4*)ptr, b = *(const float4*)(ptr + 4); o[0] = a.x; o[1] = a.y; o[2] = a.z; o[3] = a.w; o[4] = b.x; o[5] = b.y; o[6] = b.z; o[7] = b.w; }
__device__ __forceinline__ void st8(bf16_t* ptr, const float (&o)[8]) { *(uint4*)ptr = make_uint4(pk2(o[0], o[1]), pk2(o[2], o[3]), pk2(o[4], o[5]), pk2(o[6], o[7])); }
__device__ __forceinline__ void smix8(const bf16_t* bp, bool hp, bool hn, const float* m0, const float* m1, float (&o)[8]) {
    float x[8], pv[8], nv[8], a[8], b[8]; ld8(bp, x); ld8f(m0, a); ld8f(m1, b);
    if (hp) ld8(bp - 2048, pv); else {
#pragma unroll
        for (int e = 0; e < 8; ++e) pv[e] = 0.f; }
    if (hn) ld8(bp + 2048, nv); else {
#pragma unroll
        for (int e = 0; e < 8; ++e) nv[e] = 0.f; }
#pragma unroll
    for (int e = 0; e < 8; ++e) o[e] = x[e] + a[e] * (pv[e] - x[e]) + b[e] * (nv[e] - x[e]);
}
__device__ __forceinline__ void seq_of(int row, int& t, int& L) { if (row < ML) { t = row & 4095; L = 4096; } else { t = (row - ML) & 255; L = 256; } }
__device__ __forceinline__ void prep_phase(const Params& p, int l) {
    const float* mu0 = p.mu + (size_t)l * 2 * 1920; const float* mu1 = mu0 + 1920;
#pragma unroll 1
    for (int idx = blockIdx.x * 512 + otid(); idx < MT * 48; idx += gridDim.x * 512) {
        const int row = idx / 48, cc = (idx % 48) * 8; int t, L; seq_of(row, t, L);
        int rc, mc; if (cc < 128) { rc = 1664 + cc; mc = 1664 + cc; } else if (cc < 256) { rc = 1792 + (cc - 128); mc = 1792 + (cc - 128); } else { rc = 1536 + (cc - 256); mc = 512 + (cc - 256); }
        float sm[8]; smix8(p.rw + (size_t)row * 2048 + rc, t > 0, t < L - 1, mu0 + mc, mu1 + mc, sm);
#pragma unroll
        for (int e = 0; e < 8; ++e) sm[e] = cc < 128 ? tanhf(sm[e]) : (cc < 256 ? sm[e] : sigmoidf_(sm[e]));
        st8(p.a2b + (size_t)row * 384 + cc, sm);
    }
}

__device__ __forceinline__ int scan_row(int st, int dir, int b, int& t, int& L) {
    if (st < 256) { t = dir ? 255 - st : st; L = 256; return ML + b * 256 + t; }
    const int s2 = st - 256; t = dir ? 4095 - s2 : s2; L = 4096; return b * 4096 + t;
}
struct ScanRaw { uint4 r0, rp, rn, k0, kp, kn, v0, vp, vn, a, e; float mp, mn; };
__device__ __forceinline__ void up8(const uint4& w, float (&o)[8]) { o[0] = lo_bf(w.x); o[1] = hi_bf(w.x); o[2] = lo_bf(w.y); o[3] = hi_bf(w.y); o[4] = lo_bf(w.z); o[5] = hi_bf(w.z); o[6] = lo_bf(w.w); o[7] = hi_bf(w.w); }
__device__ __forceinline__ void scan_load(const Params& p, int chunk, int dir, int b, int h, int pw, int lane, ScanRaw& R) {
    const int sl = pw * 8 + (lane >> 3), col = h * 64 + (lane & 7) * 8;
    int t, L; const int row = scan_row(chunk * 32 + sl, dir, b, t, L);
    const bool hp = t > 0, hn = t < L - 1; const int op = hp ? -2048 : 0, on = hn ? 2048 : 0;
    const bf16_t* bp = p.rw + (size_t)row * 2048 + col;
    R.r0 = *(const uint4*)bp; R.rp = *(const uint4*)(bp + op); R.rn = *(const uint4*)(bp + on);
    R.k0 = *(const uint4*)(bp + 512); R.kp = *(const uint4*)(bp + 512 + op); R.kn = *(const uint4*)(bp + 512 + on);
    R.v0 = *(const uint4*)(bp + 1024); R.vp = *(const uint4*)(bp + 1024 + op); R.vn = *(const uint4*)(bp + 1024 + on);
    R.a = *(const uint4*)(p.aa + ((size_t)dir * MT + row) * 512 + col); R.e = *(const uint4*)(p.dec + ((size_t)dir * MT + row) * 512 + col);
    R.mp = hp ? 1.0f : 0.0f; R.mn = hn ? 1.0f : 0.0f;
}
__device__ __forceinline__ void scan_emit(const ScanRaw& R, const float* cb, float* buf, int pw, int lane) {
    const int sl = pw * 8 + (lane >> 3), cg = lane & 7;
    float x[8], pv[8], nv[8], r[8], k[8], v[8], a[8], e[8], kk[8], m0[8], m1[8];
    up8(R.r0, x); up8(R.rp, pv); up8(R.rn, nv); ld8f(cb + cg * 8, m0); ld8f(cb + 64 + cg * 8, m1);
#pragma unroll
    for (int i = 0; i < 8; ++i) r[i] = x[i] + m0[i] * (pv[i] * R.mp - x[i]) + m1[i] * (nv[i] * R.mn - x[i]);
    up8(R.k0, x); up8(R.kp, pv); up8(R.kn, nv); ld8f(cb + 128 + cg * 8, m0); ld8f(cb + 192 + cg * 8, m1);
#pragma unroll
    for (int i = 0; i < 8; ++i) k[i] = x[i] + m0[i] * (pv[i] * R.mp - x[i]) + m1[i] * (nv[i] * R.mn - x[i]);
    up8(R.v0, x); up8(R.vp, pv); up8(R.vn, nv); ld8f(cb + 256 + cg * 8, m0); ld8f(cb + 320 + cg * 8, m1);
#pragma unroll
    for (int i = 0; i < 8; ++i) v[i] = x[i] + m0[i] * (pv[i] * R.mp - x[i]) + m1[i] * (nv[i] * R.mn - x[i]);
    up8(R.a, a); up8(R.e, e); ld8f(cb + 384 + cg * 8, m0); ld8f(cb + 448 + cg * 8, m1);
    float n2 = 0.f;
#pragma unroll
    for (int i = 0; i < 8; ++i) { kk[i] = k[i] * m0[i]; n2 += kk[i] * kk[i]; }
    n2 += __shfl_xor(n2, 1); n2 += __shfl_xor(n2, 2); n2 += __shfl_xor(n2, 4);
    const float inv = 1.0f / fmaxf(sqrtf(n2), 1e-12f);
    float* o = buf + sl * 384 + cg * 8;
#pragma unroll
    for (int i = 0; i < 8; ++i) { kk[i] *= inv; e[i] = __expf(e[i]); k[i] = k[i] * (1.0f + (a[i] - 1.0f) * m1[i]); a[i] = kk[i] * a[i]; }
    *(float4*)(o) = make_float4(e[0], e[1], e[2], e[3]); *(float4*)(o + 4) = make_float4(e[4], e[5], e[6], e[7]);
    *(float4*)(o + 64) = make_float4(kk[0], kk[1], kk[2], kk[3]); *(float4*)(o + 68) = make_float4(kk[4], kk[5], kk[6], kk[7]);
    *(float4*)(o + 128) = make_float4(a[0], a[1], a[2], a[3]); *(float4*)(o + 132) = make_float4(a[4], a[5], a[6], a[7]);
    *(float4*)(o + 192) = make_float4(k[0], k[1], k[2], k[3]); *(float4*)(o + 196) = make_float4(k[4], k[5], k[6], k[7]);
    *(float4*)(o + 256) = make_float4(r[0], r[1], r[2], r[3]); *(float4*)(o + 260) = make_float4(r[4], r[5], r[6], r[7]);
    *(float4*)(o + 320) = make_float4(v[0], v[1], v[2], v[3]); *(float4*)(o + 324) = make_float4(v[4], v[5], v[6], v[7]);
}
__device__ __forceinline__ void scan_phase(const Params& p, int l, unsigned char* shm) {
    const int tid = otid(), wave = tid >> 6, lane = tid & 63;
    float* buf0 = (float*)shm; float* buf1 = buf0 + 32 * 384;
#pragma unroll 1
    for (int wi = blockIdx.x; wi < 256; wi += gridDim.x) {
        const int dir = wi >> 7, b = (wi >> 4) & 7, h = (wi >> 1) & 7, half = wi & 1;
        const int ri = lane >> 3, cj = lane & 7, irow = half * 32 + (wave & 3) * 8 + ri;
        pg8::f32x2 s0 = {0.f, 0.f}, s1 = {0.f, 0.f}, s2 = {0.f, 0.f}, s3 = {0.f, 0.f};
        ScanRaw R; float* cb = buf0 + 2 * 32 * 384;
        __syncthreads();
        if (wave == 4) { const float* mu0 = p.mu + (size_t)l * 2 * 1920; const float* mu1 = mu0 + 1920; const int col = h * 64 + lane;
            cb[lane] = mu0[col]; cb[64 + lane] = mu1[col]; cb[128 + lane] = mu0[640 + col]; cb[192 + lane] = mu1[640 + col]; cb[256 + lane] = mu0[1152 + col]; cb[320 + lane] = mu1[1152 + col];
            cb[384 + lane] = p.kk_scale[l * 512 + col]; cb[448 + lane] = p.ka[l * 512 + col]; }
        __syncthreads();
        if (wave >= 4) {
            scan_load(p, 0, dir, b, h, wave - 4, lane, R); scan_emit(R, cb, buf0, wave - 4, lane); scan_load(p, 1, dir, b, h, wave - 4, lane, R);
        }
        __syncthreads();
        if (wave < 4) __builtin_amdgcn_s_setprio(2);
#pragma unroll 1
        for (int c = 0; c < 136; ++c) {
            float* cur = (c & 1) ? buf1 : buf0; float* nxt = (c & 1) ? buf0 : buf1;
            if (wave >= 4) { if (c + 1 < 136) { scan_emit(R, cb, nxt, wave - 4, lane); if (c + 2 < 136) scan_load(p, c + 2, dir, b, h, wave - 4, lane, R); } }
            else {
#define SC_LOAD(X, SL) { const float* o_ = cur + (SL) * 384 + cj * 8; X##w0 = *(const f32x4*)(o_); X##w1 = *(const f32x4*)(o_ + 4); X##k0 = *(const f32x4*)(o_ + 64); X##k1 = *(const f32x4*)(o_ + 68); \
                    X##b0 = *(const f32x4*)(o_ + 128); X##b1 = *(const f32x4*)(o_ + 132); X##d0 = *(const f32x4*)(o_ + 192); X##d1 = *(const f32x4*)(o_ + 196); X##r0 = *(const f32x4*)(o_ + 256); X##r1 = *(const f32x4*)(o_ + 260); \
                    X##vv = cur[(SL) * 384 + 320 + irow]; }
#define SC_STEP(X, SL) { pg8::f32x2 ac = s0 * X##k0.xy; ac += s1 * X##k0.zw; ac += s2 * X##k1.xy; ac += s3 * X##k1.zw; \
                    float sa = ac.x + ac.y; sa = sum8(sa); const pg8::f32x2 sa2 = {-sa, -sa}, vv2 = {X##vv, X##vv}; \
                    s0 = s0 * X##w0.xy + sa2 * X##b0.xy + vv2 * X##d0.xy; s1 = s1 * X##w0.zw + sa2 * X##b0.zw + vv2 * X##d0.zw; s2 = s2 * X##w1.xy + sa2 * X##b1.xy + vv2 * X##d1.xy; s3 = s3 * X##w1.zw + sa2 * X##b1.zw + vv2 * X##d1.zw; \
                    pg8::f32x2 yc = s0 * X##r0.xy; yc += s1 * X##r0.zw; yc += s2 * X##r1.xy; yc += s3 * X##r1.zw; \
                    float yv = yc.x + yc.y; yv = sum8(yv); \
                    yk = (cj == ((SL) & 7)) ? yv : yk; }
                const int st0 = c * 32, row0 = c < 8 ? ML + b * 256 + (dir ? 255 - st0 : st0) : b * 4096 + (dir ? 4095 - (st0 - 256) : st0 - 256);
                bf16_t* yp = p.y + ((size_t)dir * MT + row0) * 512 + h * 64 + irow; const int ystep = dir ? -512 : 512;
                f32x4 Aw0, Aw1, Ak0, Ak1, Ab0, Ab1, Ad0, Ad1, Ar0, Ar1, Bw0, Bw1, Bk0, Bk1, Bb0, Bb1, Bd0, Bd1, Br0, Br1; float Avv, Bvv;
                SC_LOAD(A, 0)
                bf16_t* ypl = yp + cj * ystep;
#pragma unroll 1
                for (int s8 = 0; s8 < 32; s8 += 8) {
                    float yk = 0.f;
#pragma unroll
                    for (int j = 0; j < 8; j += 2) {
                        SC_LOAD(B, s8 + j + 1)
                        SC_STEP(A, j)
                        SC_LOAD(A, s8 + j + 2)
                        SC_STEP(B, j + 1)
                    }
                    ypl[s8 * ystep] = f2bf(yk);
                }
#undef SC_LOAD
#undef SC_STEP
            }
            __syncthreads();
        }
        __builtin_amdgcn_s_setprio(0);
    }
}

__device__ __forceinline__ void attn_phase(const Params& p, int l, unsigned char* shm) {
    const int tid = otid(), wave = tid >> 6, lane = tid & 63, fr = lane & 15, fq = lane >> 4;
    const int g = wave >> 1, qh = wave & 1;
    bf16_t* Ks = (bf16_t*)shm;
    bf16_t* Vs = (bf16_t*)(shm + 64 * 136 * 2);
    const float scale = 0.08838834764831845f;
#pragma unroll 1
    for (int un = (int)((blockIdx.x + gridDim.x - (80u % gridDim.x)) % gridDim.x); un < (l == 3 ? 1024 : 1088); un += gridDim.x) {
        const bool lat = un < 1024; int b, qb, hk;
        if (lat) { b = un >> 7; qb = (un >> 1) & 63; hk = un & 1; } else { const int v = un - 1024; b = v >> 3; qb = (v >> 1) & 3; hk = v & 1; }
        const int q0 = qb * 64, rowbase = lat ? b * 4096 : ML + b * 256, hq = hk * 4 + g;
        bf16x8 Qf[2][4];
#pragma unroll
        for (int qt = 0; qt < 2; ++qt)
#pragma unroll
            for (int ks = 0; ks < 4; ++ks) Qf[qt][ks] = *(const bf16x8*)(p.q + (size_t)(rowbase + q0 + qh * 32 + qt * 16 + fr) * 1024 + hq * 128 + ks * 32 + fq * 8);
        const float sinkv = p.sink[l * 8 + hq];
        float mrun[2] = {sinkv, sinkv}, lsum[2]; lsum[0] = lsum[1] = (fq == 0) ? 1.0f : 0.0f;
        f32x4 O[8][2];
#pragma unroll
        for (int dt = 0; dt < 8; ++dt) { O[dt][0] = (f32x4){0.f, 0.f, 0.f, 0.f}; O[dt][1] = (f32x4){0.f, 0.f, 0.f, 0.f}; }
        const int jlo = lat ? (qb < 2 ? 2 - qb : 0) : 0, jhi = lat ? (65 - qb < 4 ? 65 - qb : 4) : -1;
        const int nloc = lat ? jhi - jlo + 1 : 0, nkb = nloc + 4;
        uint4 ra, rc, rv0, rv1;
#define AT_LOAD(I) { const int i_ = (I); const bool loc_ = i_ < nloc; const int kp_ = loc_ ? q0 - 128 + 64 * (jlo + i_) : 0, cb_ = i_ - nloc; \
            const int krow_ = loc_ ? b * 4096 + kp_ : ML + b * 256 + cb_ * 64; \
            const bf16_t* vsrc_ = loc_ ? p.vt + (size_t)(b * 256 + hk * 128) * 4096 + kp_ : p.vtc + (size_t)(b * 256 + hk * 128) * 256 + cb_ * 64; const int vstr_ = loc_ ? 4096 : 256; \
            const uint4* s1_ = (const uint4*)(p.ak + (size_t)(krow_ + (tid >> 3)) * 256 + hk * 128 + (tid & 7) * 16); ra = s1_[0]; rc = s1_[1]; \
            const uint4* s2_ = (const uint4*)(vsrc_ + (size_t)(tid >> 2) * vstr_ + (tid & 3) * 16); rv0 = s2_[0]; rv1 = s2_[1]; }
        AT_LOAD(0)
#pragma unroll 1
        for (int kb = 0; kb < nkb; ++kb) {
            const bool local = kb < nloc; const int kp0 = local ? q0 - 128 + 64 * (jlo + kb) : 0;
            __syncthreads();
            {
                const int key = tid >> 3, ch = tid & 7, dd = tid >> 2, c4 = tid & 3;
                uint4* d1 = (uint4*)(Ks + key * 136 + ch * 16); d1[0] = ra; d1[1] = rc;
                uint2* d2 = (uint2*)(Vs + dd * 68 + c4 * 16); d2[0] = make_uint2(rv0.x, rv0.y); d2[1] = make_uint2(rv0.z, rv0.w); d2[2] = make_uint2(rv1.x, rv1.y); d2[3] = make_uint2(rv1.z, rv1.w);
            }
            __syncthreads();
            if (kb + 1 < nkb) AT_LOAD(kb + 1)
            f32x4 S[4][2];
#pragma unroll
            for (int kt = 0; kt < 4; ++kt) { S[kt][0] = (f32x4){0.f, 0.f, 0.f, 0.f}; S[kt][1] = (f32x4){0.f, 0.f, 0.f, 0.f};
#pragma unroll
                for (int ks = 0; ks < 4; ++ks) { const bf16x8 Kf = *(const bf16x8*)(Ks + (kt * 16 + fr) * 136 + ks * 32 + fq * 8);
                    S[kt][0] = __builtin_amdgcn_mfma_f32_16x16x32_bf16(Kf, Qf[0][ks], S[kt][0], 0, 0, 0); S[kt][1] = __builtin_amdgcn_mfma_f32_16x16x32_bf16(Kf, Qf[1][ks], S[kt][1], 0, 0, 0); } }
#pragma unroll
            for (int qt = 0; qt < 2; ++qt) {
                const int qp = q0 + qh * 32 + qt * 16 + fr; float mx = -1e30f;
#pragma unroll
                for (int kt = 0; kt < 4; ++kt)
#pragma unroll
                    for (int e = 0; e < 4; ++e) { float sv = S[kt][qt][e] * scale; if (local) { const int dlt = kp0 + kt * 16 + 4 * fq + e - qp; if (dlt > 128 || dlt < -128) sv = -1e30f; } S[kt][qt][e] = sv; mx = fmaxf(mx, sv); }
                mx = fmaxf(mx, __shfl_xor(mx, 16)); mx = fmaxf(mx, __shfl_xor(mx, 32));
                const float mnew = fmaxf(mrun[qt], mx), alpha = __expf(mrun[qt] - mnew); mrun[qt] = mnew;
                float ps = 0.f;
#pragma unroll
                for (int kt = 0; kt < 4; ++kt)
#pragma unroll
                    for (int e = 0; e < 4; ++e) { const float pv = __expf(S[kt][qt][e] - mnew); S[kt][qt][e] = pv; ps += pv; }
                lsum[qt] = lsum[qt] * alpha + ps;
#pragma unroll
                for (int dt = 0; dt < 8; ++dt) O[dt][qt] *= alpha;
            }
#pragma unroll
            for (int kg = 0; kg < 2; ++kg) {
                bf16x8 Pf[2];
#pragma unroll
                for (int qt = 0; qt < 2; ++qt) { const uint4 w = make_uint4(pk2(S[2 * kg][qt][0], S[2 * kg][qt][1]), pk2(S[2 * kg][qt][2], S[2 * kg][qt][3]), pk2(S[2 * kg + 1][qt][0], S[2 * kg + 1][qt][1]), pk2(S[2 * kg + 1][qt][2], S[2 * kg + 1][qt][3])); Pf[qt] = *(const bf16x8*)&w; }
#pragma unroll
                for (int dt = 0; dt < 8; ++dt) {
                    const uint2 lo = *(const uint2*)(Vs + (dt * 16 + fr) * 68 + kg * 32 + 4 * fq), hi = *(const uint2*)(Vs + (dt * 16 + fr) * 68 + kg * 32 + 16 + 4 * fq);
                    const uint4 w = make_uint4(lo.x, lo.y, hi.x, hi.y); const bf16x8 Vf = *(const bf16x8*)&w;
                    O[dt][0] = __builtin_amdgcn_mfma_f32_16x16x32_bf16(Vf, Pf[0], O[dt][0], 0, 0, 0); O[dt][1] = __builtin_amdgcn_mfma_f32_16x16x32_bf16(Vf, Pf[1], O[dt][1], 0, 0, 0);
                }
            }
        }
#pragma unroll
        for (int qt = 0; qt < 2; ++qt) {
            float lt = lsum[qt]; lt += __shfl_xor(lt, 16); lt += __shfl_xor(lt, 32); const float inv = 1.0f / lt;
            bf16_t* d = p.at + (size_t)(rowbase + q0 + qh * 32 + qt * 16 + fr) * 1024 + hq * 128 + 4 * fq;
#pragma unroll
            for (int dt = 0; dt < 8; ++dt) { const f32x4 o = O[dt][qt] * inv; *(uint2*)(d + dt * 16) = make_uint2(pk2(o[0], o[1]), pk2(o[2], o[3])); }
        }
    }
#undef AT_LOAD
    __syncthreads();
}

__device__ __forceinline__ void fin_phase(const Params& p, int l, bf16_t* cat) {
    const int wave = otid() >> 6, lane = otid() & 63;
    const float* mu0 = p.mu + (size_t)l * 2 * 1920; const float* mu1 = mu0 + 1920;
#pragma unroll 1
    for (int row = blockIdx.x * 8 + wave; row < (l == 3 ? ML : MT); row += gridDim.x * 8) {
        int t, L; seq_of(row, t, L); const bool hp = t > 0, hn = t < L - 1;
        bf16_t* co = cat + (size_t)row * 2048;
        {
            float v[8], g[8]; ld8(p.fo + (size_t)row * 512 + lane * 8, v); ld8f(p.f_g + l * 512 + lane * 8, g);
            float ss = 0.f;
#pragma unroll
            for (int e = 0; e < 8; ++e) ss += v[e] * v[e];
            ss = wave_sum(ss); const float rs = rsqrtf(ss * (1.0f / 512.0f) + 1e-6f);
#pragma unroll
            for (int e = 0; e < 8; ++e) v[e] = v[e] * rs * g[e];
            st8(co + lane * 8, v);
        }
        __builtin_amdgcn_sched_barrier(0);
        {
            float v0[8], v1[8], g0[8], g1[8]; ld8(p.at + (size_t)row * 1024 + lane * 16, v0); ld8(p.at + (size_t)row * 1024 + lane * 16 + 8, v1); ld8f(p.a_g + l * 1024 + lane * 16, g0); ld8f(p.a_g + l * 1024 + lane * 16 + 8, g1);
            float ss = 0.f;
#pragma unroll
            for (int e = 0; e < 8; ++e) ss += v0[e] * v0[e] + v1[e] * v1[e];
            ss = wave_sum(ss); const float rs = rsqrtf(ss * (1.0f / 1024.0f) + 1e-6f);
#pragma unroll
            for (int e = 0; e < 8; ++e) { v0[e] = v0[e] * rs * g0[e]; v1[e] = v1[e] * rs * g1[e]; }
            st8(co + 1024 + lane * 16, v0); st8(co + 1024 + lane * 16 + 8, v1);
        }
        __builtin_amdgcn_sched_barrier(0);
        {
            const int col = lane * 8;
            const bf16_t* bp = p.rw + (size_t)row * 2048 + col;
            float bs = 0.f;
            {   float r[8], k[8], a0[8], a1[8], kav[8], rkv[8];
                smix8(bp, hp, hn, mu0 + col, mu1 + col, r); smix8(bp + 512, hp, hn, mu0 + 640 + col, mu1 + 640 + col, k);
                ld8(p.aa + (size_t)row * 512 + col, a0); ld8(p.aa + ((size_t)MT + row) * 512 + col, a1); ld8f(p.ka + l * 512 + col, kav); ld8f(p.rk + l * 512 + col, rkv);
#pragma unroll
                for (int e = 0; e < 8; ++e) { const float kd = k[e] * (2.0f + (a0[e] + a1[e] - 2.0f) * kav[e]); bs += r[e] * kd * rkv[e]; }
                bs += __shfl_xor(bs, 1); bs += __shfl_xor(bs, 2); bs += __shfl_xor(bs, 4); }
            __builtin_amdgcn_sched_barrier(0);
            float y0[8];
            {   float y1[8]; ld8(p.y + (size_t)row * 512 + col, y0); ld8(p.y + ((size_t)MT + row) * 512 + col, y1);
                float sm = 0.f;
#pragma unroll
                for (int e = 0; e < 8; ++e) { y0[e] += y1[e]; sm += y0[e]; }
                sm += __shfl_xor(sm, 1); sm += __shfl_xor(sm, 2); sm += __shfl_xor(sm, 4);
                const float mean = sm * (1.0f / 64.0f); float vs = 0.f;
#pragma unroll
                for (int e = 0; e < 8; ++e) { y0[e] -= mean; vs += y0[e] * y0[e]; }
                vs += __shfl_xor(vs, 1); vs += __shfl_xor(vs, 2); vs += __shfl_xor(vs, 4);
                const float rs = rsqrtf(vs * (1.0f / 64.0f) + 64e-5f);
#pragma unroll
                for (int e = 0; e < 8; ++e) y0[e] *= rs; }
            __builtin_amdgcn_sched_barrier(0);
            {   float v[8], lw[8], lb[8], gv[8], o[8];
                smix8(bp + 1024, hp, hn, mu0 + 1152 + col, mu1 + 1152 + col, v);
                ld8f(p.lnx_w + l * 512 + col, lw); ld8f(p.lnx_b + l * 512 + col, lb); ld8(p.gg + (size_t)row * 512 + col, gv);
#pragma unroll
                for (int e = 0; e < 8; ++e) o[e] = (y0[e] * lw[e] + lb[e] + bs * v[e]) * gv[e];
                st8(co + 512 + col, o); }
        }
        __builtin_amdgcn_sched_barrier(0);
    }
}

__device__ __forceinline__ void conv_phase(const Params& p, int l, int r0, int Mp) {
    const float* cw = p.conv_w + (size_t)l * 3 * DFF; const float* cb = p.conv_b + (size_t)l * DFF;
#pragma unroll 1
    for (int idx = blockIdx.x * 512 + otid(); idx < Mp * 704; idx += gridDim.x * 512) {
        const int rl = idx / 704, ch = (idx % 704) * 8; int t, L; seq_of(r0 + rl, t, L);
        const bf16_t* hp_ = p.h + (size_t)rl * 11264 + ch;
        float x[8], pv[8], nv[8], up[8], w0[8], w1[8], w2[8], bb[8], o[8];
        ld8(hp_, x); ld8(hp_ + DFF, up); ld8f(cw + ch, w0); ld8f(cw + DFF + ch, w1); ld8f(cw + 2 * DFF + ch, w2); ld8f(cb + ch, bb);
        if (t > 0) ld8(hp_ - 11264, pv); else {
#pragma unroll
            for (int e = 0; e < 8; ++e) pv[e] = 0.f; }
        if (t < L - 1) ld8(hp_ + 11264, nv); else {
#pragma unroll
            for (int e = 0; e < 8; ++e) nv[e] = 0.f; }
#pragma unroll
        for (int e = 0; e < 8; e += 2) { pg8::f32x2 gt; gt.x = pv[e] * w0[e] + x[e] * w1[e] + nv[e] * w2[e] + bb[e]; gt.y = pv[e + 1] * w0[e + 1] + x[e + 1] * w1[e + 1] + nv[e + 1] * w2[e + 1] + bb[e + 1];
            const pg8::f32x2 ge = pg8::gelu_pk(gt); o[e] = ge.x * up[e]; o[e + 1] = ge.y * up[e + 1]; }
        st8(p.act + (size_t)rl * DFF + ch, o);
    }
}

__device__ __forceinline__ void final_norm(const Params& p) {
    const int wave = otid() >> 6, lane = otid() & 63;
#pragma unroll 1
    for (int row = blockIdx.x * 8 + wave; row < ML; row += gridDim.x * 8) {
        float4* src = (float4*)(p.out + (size_t)row * 2048);
        float4 v[8]; float ss = 0.f;
#pragma unroll
        for (int i = 0; i < 8; ++i) { v[i] = src[lane + 64 * i]; ss += v[i].x * v[i].x + v[i].y * v[i].y + v[i].z * v[i].z + v[i].w * v[i].w; }
        ss = wave_sum(ss); const float rs = rsqrtf(ss * (1.0f / 2048.0f) + 1e-6f);
        const float4* g4 = (const float4*)p.final_g;
#pragma unroll
        for (int i = 0; i < 8; ++i) { const float4 g = g4[lane + 64 * i]; src[lane + 64 * i] = make_float4(v[i].x * rs * g.x, v[i].y * rs * g.y, v[i].z * rs * g.z, v[i].w * rs * g.w); }
    }
}

struct SkewOrder : StaticOrder {
    int skew;
    __device__ __forceinline__ bool next(int i, Unit& u) const {
        if (!skew) return StaticOrder::next(i, u);
        if (c < 64) return i < 8 ? StaticOrder::next(i, u) : false;
        if (i < 11) return StaticOrder::next(i, u);
        if (i == 11) { const int j = c - 64; StaticOrder t = *this; t.c = j & 63; return t.next(8 + (j >> 6), u); }
        return false;
    }
};
#define LDS_BYTES (131072 + 256)
#define GBAR() xcd_barrier(bar)
__device__ __forceinline__ int opq(int v) { asm volatile("" : "+s"(v)); return v; }
__global__ void __launch_bounds__(512, 2) hymba_fwd(Params p) {
    extern __shared__ __attribute__((aligned(16))) unsigned char shm[];
    PG8_LAS unsigned char* lds = (PG8_LAS unsigned char*)shm;
    volatile LAS unsigned* st = (volatile LAS unsigned*)(lds + 131072);
    if (threadIdx.x == 0) { st[0] = 0u; st[1] = 0u; st[2] = 0u; st[3] = 0u; }
    __syncthreads();
    XcdBarrier bar = xcd_barrier_post(p.bar, st);
    const int G = gridDim.x, bid = blockIdx.x;
#ifndef SK_PRO
    prologue(p, shm);
#endif
    GBAR();
#pragma unroll 1
    for (int l = 0; l < 4; ++l) {
        const float* modl = p.mod + (size_t)l * MODL;
        const float* xl_in = l == 0 ? p.x : p.out; const float* xc_in = l == 0 ? p.ctx : p.xc;
#ifndef SK_NORM
        norm_mod(xl_in, xc_in, p.norm1_g + l * 2048, modl, 0, 2048, p.u, MT);
#endif
        GBAR();
        { EpiIn E; E.q = p.q; E.ak = p.ak; E.vt = p.vt; E.vtc = p.vtc; E.rw = p.rw; E.ft = p.ft; E.ftc = p.ftc; E.rope = p.rope;
          StaticOrder S; S.init(opq(MT), opq(NIN), G, bid); Gemm g; g.A = p.u; g.Bt = p.wt_in + (size_t)l * NIN * 2048; g.M = opq(MT); g.N = opq(NIN); g.K = opq(2048);

#ifndef SK_GIN
          pg8::gemm_phase<EpiIn, StaticOrder, false>(lds, g, S, E, nullptr);
#endif
 }
        GBAR();
#ifndef SK_PREP
        prep_phase(p, l);
#endif
        GBAR();
        { EpiLR E; E.dec = p.dec; E.aa = p.aa; E.gg = p.gg; E.w0 = p.w0 + l * 1024; E.a0 = p.a0 + l * 1024;
          StaticOrder S; S.init(opq(MT), opq(2560), G, bid); Gemm g; g.A = p.a2b; g.Bt = p.wt_lr + (size_t)l * 2560 * 384; g.M = opq(MT); g.N = opq(2560); g.K = opq(384);

#ifndef SK_GLR
          pg8::gemm_phase<EpiLR, StaticOrder, false>(lds, g, S, E, nullptr);
#endif
 }
        __syncthreads();
        { EpiFO E; E.fo = p.fo; E.base = 0; E.seqlen = 4096;
          StaticOrder S; S.init(opq(4096), opq(4096), G, bid); Gemm g; g.A = p.wf; g.Bt = p.ft; g.M = opq(4096); g.N = opq(4096); g.K = opq(8192);

#ifndef SK_GFO
          pg8::gemm_phase<EpiFO, StaticOrder, false>(lds, g, S, E, nullptr);
#endif
 }
        __syncthreads();
        if (l != 3) { EpiFO E; E.fo = p.fo; E.base = ML; E.seqlen = 256;
          StaticOrder S; S.init(opq(256), opq(4096), G, (bid + G - (160 % G)) % G); Gemm g; g.A = p.wfc; g.Bt = p.ftc; g.M = opq(256); g.N = opq(4096); g.K = opq(512);

#ifndef SK_GFO
          pg8::gemm_phase<EpiFO, StaticOrder, false>(lds, g, S, E, nullptr);
#endif
 }
        __syncthreads();
#ifndef SK_ATT
        attn_phase(p, l, shm);
#endif
        GBAR();
#ifndef SK_SCAN
        scan_phase(p, l, shm);
#endif
        GBAR();
#ifndef SK_FIN
        fin_phase(p, l, p.u);
#endif
        GBAR();
        { EpiRes E; E.xl_in = xl_in; E.xc_in = xc_in; E.xl_out = p.out; E.xc_out = p.xc; E.ga = modl + 4096; E.row_off = 0;
          const int Mo = l == 3 ? ML : MT;
          StaticOrder S; S.init(opq(Mo), opq(2048), G, bid); Gemm g; g.A = p.u; g.Bt = p.wt_out + (size_t)l * 2048 * 2048; g.M = opq(Mo); g.N = opq(2048); g.K = opq(2048);

#ifndef SK_GRES
          pg8::gemm_phase<EpiRes, StaticOrder, false>(lds, g, S, E, nullptr);
#endif
 }
        GBAR();
        norm_mod(p.out, p.xc, p.norm2_g + l * 2048, modl, 6144, 8192, p.u, l == 3 ? ML : MT);
        GBAR();
#pragma unroll 1
        for (int part = 0; part < 2; ++part) {
            const int r0 = part ? 0 : 16384, Mp = (!part && l != 3) ? 18432 : 16384;
            { EpiH E; E.o = p.h; E.ld = 11264;
              SkewOrder S; S.init(opq(Mp), opq(11264), G, bid); S.skew = (part == 1 && l != 3 && G == 256) ? 1 : 0;
              Gemm g; g.A = p.u + (size_t)r0 * 2048; g.Bt = p.wt_f1 + (size_t)l * 11264 * 2048; g.M = opq(Mp); g.N = opq(11264); g.K = opq(2048);

#ifndef SK_GH
              pg8::gemm_phase<EpiH, SkewOrder, false>(lds, g, S, E, nullptr);
#endif
 }
            GBAR();
#ifndef SK_CONV
            conv_phase(p, l, r0, Mp);
#endif
            GBAR();
            { EpiRes E; E.xl_in = p.out; E.xc_in = p.xc; E.xl_out = p.out; E.xc_out = p.xc; E.ga = modl + 10240; E.row_off = r0;
              StaticOrder S; S.init(opq(Mp), opq(2048), G, bid); Gemm g; g.A = p.act; g.Bt = p.wt_f2 + (size_t)l * 2048 * DFF; g.M = opq(Mp); g.N = opq(2048); g.K = opq(DFF);

#ifndef SK_GRES
          pg8::gemm_phase<EpiRes, StaticOrder, false>(lds, g, S, E, nullptr);
#endif
 }
            if (part) GBAR(); else __syncthreads();
        }
    }
    final_norm(p);
}

extern "C" void kernel_launch(void* const* d_in, const int* in_sizes, int n_in, void* d_out, int out_size, void* d_ws, size_t ws_size, hipStream_t stream) {
    (void)in_sizes; (void)n_in; (void)out_size; (void)ws_size;
    Params p{};
    const float** pf = (const float**)&p;
    for (int i = 0; i < 29; ++i) pf[i] = (const float*)d_in[i];
    p.out = (float*)d_out;
    char* w = (char*)d_ws; size_t off = 0;
    auto take = [&](size_t bytes) { char* r = w + off; off += (bytes + 255) & ~(size_t)255; return r; };
    p.bar = (unsigned*)take(XCD_BAR_WORDS * 4);
    p.mod = (float*)take((size_t)4 * MODL * 4);
    p.rope = (float*)take((size_t)4096 * 64 * 2 * 4);
    p.xc = (float*)take((size_t)2048 * 2048 * 4);
    p.wt_in = (bf16_t*)take((size_t)4 * NIN * 2048 * 2);
    p.wt_out = (bf16_t*)take((size_t)4 * 2048 * 2048 * 2);
    p.wt_f1 = (bf16_t*)take((size_t)4 * 11264 * 2048 * 2);
    p.wt_f2 = (bf16_t*)take((size_t)4 * 2048 * DFF * 2);
    p.wt_lr = (bf16_t*)take((size_t)4 * 2560 * 384 * 2);
    p.wf = (bf16_t*)take((size_t)4096 * 8192 * 2);
    p.wfc = (bf16_t*)take((size_t)256 * 512 * 2);
    p.u = (bf16_t*)take((size_t)MT * 2048 * 2);
    const size_t mix0 = off;
    p.q = (bf16_t*)take((size_t)MT * 1024 * 2);
    p.ak = (bf16_t*)take((size_t)MT * 256 * 2);
    p.vt = (bf16_t*)take((size_t)8 * 256 * 4096 * 2);
    p.vtc = (bf16_t*)take((size_t)8 * 256 * 256 * 2);
    p.rw = (bf16_t*)take((size_t)MT * 2048 * 2);
    p.ft = (bf16_t*)take((size_t)8 * 512 * 8192 * 2);
    p.ftc = (bf16_t*)take((size_t)8 * 512 * 512 * 2);
    p.dec = (bf16_t*)take((size_t)2 * MT * 512 * 2);
    p.aa = (bf16_t*)take((size_t)2 * MT * 512 * 2);
    p.gg = (bf16_t*)take((size_t)MT * 512 * 2);
    p.y = (bf16_t*)take((size_t)2 * MT * 512 * 2);
    p.a2b = p.y;
    p.fo = (bf16_t*)take((size_t)MT * 512 * 2);
    p.at = (bf16_t*)take((size_t)MT * 1024 * 2);
    p.h = (bf16_t*)(w + mix0);
    p.act = p.h + (size_t)18432 * 11264;
    static int grid = 0;
    if (!grid) {
        int dev = 0, cus = 0, per_cu = 0;
        hipGetDevice(&dev); hipDeviceGetAttribute(&cus, hipDeviceAttributeMultiprocessorCount, dev);
        if (hipFuncSetAttribute((const void*)hymba_fwd, hipFuncAttributeMaxDynamicSharedMemorySize, LDS_BYTES) != hipSuccess) fprintf(stderr, "hipFuncSetAttribute failed\n");
        if (hipOccupancyMaxActiveBlocksPerMultiprocessor(&per_cu, (const void*)hymba_fwd, 512, LDS_BYTES) != hipSuccess || per_cu < 1) { fprintf(stderr, "occupancy query failed\n"); per_cu = 1; }
        grid = cus > 0 ? cus : 256;
    }
    hipMemsetAsync(p.bar, 0, XCD_BAR_WORDS * 4, stream);
    hipLaunchKernelGGL(hymba_fwd, dim3(grid), dim3(512), LDS_BYTES, stream, p);
}
```
